# Optimizing an MI355X kernel written in HIP

```python
import jax, jax.numpy as jnp
from jax import lax
import numpy as np

D_MODEL = 2048
BATCH = 4
SEQ = 8192
DEPTH = 1

CHUNK = 64
HG_HEADS = 8
HG_DK = 128
HG_DV = 128
HG_WIDTH = HG_HEADS * HG_DK
HG_VWIDTH = HG_HEADS * HG_DV
FOX_HEADS = 8
FOX_HD = 128
FOX_WIDTH = FOX_HEADS * FOX_HD
Q_BLOCK = 128
N_EXPERTS = 32
TOP_K = 4
D_EXPERT = D_MODEL
SWIGLU_LIMIT = 7.0
SWIGLU_ALPHA = 1.702
EXPERT_BLOCK = 512
EPS = 1e-6
SPLIT_WIDTHS = (HG_WIDTH, HG_WIDTH, HG_VWIDTH, HG_VWIDTH, FOX_WIDTH, FOX_WIDTH, FOX_WIDTH, FOX_HEADS, D_MODEL, D_MODEL)
IN_COLS = sum(SPLIT_WIDTHS)
SPLIT_POINTS = tuple(int(v) for v in np.cumsum(SPLIT_WIDTHS)[:-1])

kernel_name = "hgrn2_fox_gated_merge_moe_block"


def rms_norm(x, gain):
    xf = x.astype(jnp.float32)
    y = xf * lax.rsqrt(jnp.mean(xf * xf, axis=-1, keepdims=True) + EPS)
    return (y * gain.astype(jnp.float32)).astype(x.dtype)


def hgrn2_mixer(q, f_logit, i, g, lb, norm_gain):
    B, S = q.shape[0], q.shape[1]
    n_chunks = S // CHUNK
    qf = jax.nn.silu(q.astype(jnp.float32)) * (HG_DK ** -0.5)
    lbh = lb.reshape(HG_HEADS, HG_DK)
    f = lbh + (1.0 - lbh) * jax.nn.sigmoid(f_logit.astype(jnp.float32))
    k = 1.0 - f
    logf = jnp.log(f)

    def to_chunks(t):
        return t.reshape(B, n_chunks, CHUNK, HG_HEADS, -1).transpose(1, 0, 3, 2, 4)

    qc, kc, vc = to_chunks(qf), to_chunks(k), to_chunks(i.astype(jnp.float32))
    bc = jnp.cumsum(to_chunks(logf), axis=3)
    causal = jnp.tril(jnp.ones((CHUNK, CHUNK), dtype=bool))[:, :, None]

    def step(state, inp):
        qt, kt, vt, bt = inp
        diff = bt[:, :, :, None, :] - bt[:, :, None, :, :]
        decay = jnp.exp(jnp.where(causal, diff, -jnp.inf))
        scores = jnp.einsum('bhtc,bhsc,bhtsc->bhts', qt, kt, decay)
        o = jnp.einsum('bhts,bhsv->bhtv', scores, vt) + jnp.einsum('bhtc,bhcv->bhtv', qt * jnp.exp(bt), state)
        b_last = bt[:, :, -1:, :]
        new_state = jnp.exp(b_last[:, :, 0, :])[..., None] * state + jnp.einsum(
            'bhsc,bhsv->bhcv', kt * jnp.exp(b_last - bt), vt)
        return new_state, o

    state0 = jnp.zeros((B, HG_HEADS, HG_DK, HG_DV), jnp.float32)
    _, oc = lax.scan(step, state0, (qc, kc, vc, bc))
    o = oc.transpose(1, 0, 3, 2, 4).reshape(B, S, HG_HEADS, HG_DV)
    o = rms_norm(o, norm_gain) * jax.nn.silu(g.astype(jnp.float32))
    return o.reshape(B, S, HG_VWIDTH)


def fox_mixer(q, k, v, f_logit, q_gain, k_gain):
    B, S = q.shape[0], q.shape[1]
    n_q = S // Q_BLOCK
    qn = rms_norm(q, q_gain).astype(jnp.float32) * (FOX_HD ** -0.5)
    kh = rms_norm(k, k_gain).astype(jnp.float32).transpose(0, 2, 1, 3)
    vh = v.astype(jnp.float32).transpose(0, 2, 1, 3)
    c = jnp.cumsum(jax.nn.log_sigmoid(f_logit.astype(jnp.float32)), axis=1).transpose(0, 2, 1)
    qb = qn.reshape(B, n_q, Q_BLOCK, FOX_HEADS, FOX_HD).transpose(1, 0, 3, 2, 4)
    cb = c.reshape(B, FOX_HEADS, n_q, Q_BLOCK).transpose(2, 0, 1, 3)
    key_pos = jnp.arange(S)

    def block(args):
        q_blk, c_blk, idx = args
        q_pos = idx * Q_BLOCK + jnp.arange(Q_BLOCK)
        s = jnp.einsum('bhqd,bhkd->bhqk', q_blk, kh) + c_blk[..., None] - c[:, :, None, :]
        s = jnp.where(key_pos[None, :] <= q_pos[:, None], s, -jnp.inf)
        p = jax.nn.softmax(s, axis=-1)
        return jnp.einsum('bhqk,bhkd->bhqd', p, vh)

    o = lax.map(block, (qb, cb, jnp.arange(n_q)))
    return o.transpose(1, 0, 3, 2, 4).reshape(B, S, FOX_WIDTH)


def moe_ffn(h, router_w, router_b, w_gu, b_gu, w_down, b_down):
    B, S, D = h.shape
    T = B * S
    TK = T * TOP_K
    ht = h.reshape(T, D)
    logits = (ht @ router_w + router_b).astype(jnp.float32)
    top_v, top_i = lax.top_k(logits, TOP_K)
    gates = jax.nn.softmax(top_v, axis=-1)
    flat_e = top_i.reshape(TK)
    order = jnp.argsort(flat_e)
    sorted_e = flat_e[order]
    sorted_tok = (order // TOP_K).astype(jnp.int32)
    counts = jnp.bincount(flat_e, length=N_EXPERTS)
    padded = (counts + EXPERT_BLOCK - 1) // EXPERT_BLOCK * EXPERT_BLOCK
    pad_end = jnp.cumsum(padded)
    pad_start = pad_end - padded
    start = jnp.cumsum(counts) - counts
    dest = pad_start[sorted_e] + jnp.arange(TK) - start[sorted_e]
    n_blocks = -(-TK // EXPERT_BLOCK) + N_EXPERTS
    n_rows = n_blocks * EXPERT_BLOCK
    row_tok = jnp.zeros((n_rows,), jnp.int32).at[dest].set(sorted_tok)
    row_w = jnp.zeros((n_rows,), jnp.float32).at[dest].set(gates.reshape(TK)[order])
    block_e = jnp.minimum(jnp.searchsorted(pad_end, jnp.arange(n_blocks) * EXPERT_BLOCK, side='right'),
                          N_EXPERTS - 1)

    def expert_block(args):
        tok, rw, e = args
        xb = ht[tok]
        gu = xb @ w_gu[e] + b_gu[e]
        gate, up = jnp.split(gu, 2, axis=-1)
        gate = jnp.minimum(gate, SWIGLU_LIMIT)
        up = jnp.clip(up, -SWIGLU_LIMIT, SWIGLU_LIMIT)
        act = (up + 1.0) * gate * jax.nn.sigmoid(SWIGLU_ALPHA * gate)
        out = act @ w_down[e] + b_down[e]
        return out * rw[:, None].astype(out.dtype)

    rows = lax.map(expert_block, (row_tok.reshape(n_blocks, EXPERT_BLOCK),
                                  row_w.reshape(n_blocks, EXPERT_BLOCK), block_e))
    y = jax.ops.segment_sum(rows.reshape(n_rows, D), row_tok, num_segments=T)
    return y.reshape(B, S, D)


def setup_inputs(seed: int = 0) -> dict:
    key = jax.random.key(seed)
    ks = jax.random.split(key, 20)
    f32 = jnp.float32
    n = lambda k, shape, s: jax.random.normal(k, shape, f32) * s
    return {
        "x": n(ks[0], (BATCH, SEQ, D_MODEL), 1.0),
        "lb_logits": n(ks[1], (DEPTH + 1, HG_WIDTH), 0.1),
        "norm1": 1.0 + n(ks[2], (DEPTH, D_MODEL), 0.02),
        "w_in": n(ks[3], (DEPTH, D_MODEL, IN_COLS), D_MODEL ** -0.5),
        "hg_norm": 1.0 + n(ks[4], (DEPTH, HG_DV), 0.02),
        "fox_q_norm": 1.0 + n(ks[5], (DEPTH, FOX_HD), 0.02),
        "fox_k_norm": 1.0 + n(ks[6], (DEPTH, FOX_HD), 0.02),
        "fox_f_bias": 2.0 + n(ks[7], (DEPTH, FOX_HEADS), 1.0),
        "w_up_hg": n(ks[8], (DEPTH, HG_VWIDTH, D_MODEL), HG_VWIDTH ** -0.5),
        "w_up_fox": n(ks[9], (DEPTH, FOX_WIDTH, D_MODEL), FOX_WIDTH ** -0.5),
        "w_out": n(ks[10], (DEPTH, D_MODEL, D_MODEL), D_MODEL ** -0.5),
        "norm2": 1.0 + n(ks[11], (DEPTH, D_MODEL), 0.02),
        "router_w": n(ks[12], (DEPTH, D_MODEL, N_EXPERTS), D_MODEL ** -0.5),
        "router_b": n(ks[13], (DEPTH, N_EXPERTS), 0.01),
        "w_gu": n(ks[14], (DEPTH, N_EXPERTS, D_MODEL, 2 * D_EXPERT), D_MODEL ** -0.5),
        "b_gu": n(ks[15], (DEPTH, N_EXPERTS, 2 * D_EXPERT), 0.01),
        "w_down": n(ks[16], (DEPTH, N_EXPERTS, D_EXPERT, D_MODEL), D_EXPERT ** -0.5),
        "b_down": n(ks[17], (DEPTH, N_EXPERTS, D_MODEL), 0.01),
    }


def reference(x, lb_logits, norm1, w_in, hg_norm, fox_q_norm, fox_k_norm, fox_f_bias, w_up_hg, w_up_fox,
              w_out, norm2, router_w, router_b, w_gu, b_gu, w_down, b_down):
    B, S, _ = x.shape
    lb_all = jnp.cumsum(jax.nn.softmax(lb_logits.astype(jnp.float32), axis=0), axis=0)
    for l in range(DEPTH):
        h = rms_norm(x, norm1[l])
        p = h @ w_in[l]
        hq, hf, hi, hg, fq, fk, fv, ff, ga, gb = jnp.split(p, SPLIT_POINTS, axis=-1)
        heads4 = lambda t, hd: t.reshape(B, S, -1, hd)
        a = hgrn2_mixer(heads4(hq, HG_DK), heads4(hf, HG_DK), heads4(hi, HG_DV), heads4(hg, HG_DV),
                        lb_all[l], hg_norm[l])
        b = fox_mixer(heads4(fq, FOX_HD), heads4(fk, FOX_HD), heads4(fv, FOX_HD), ff + fox_f_bias[l],
                      fox_q_norm[l], fox_k_norm[l])
        merged = (jax.nn.sigmoid(ga.astype(jnp.float32)) * (a.astype(x.dtype) @ w_up_hg[l])
                  + jax.nn.sigmoid(gb.astype(jnp.float32)) * (b.astype(x.dtype) @ w_up_fox[l]))
        x = x + (merged.astype(x.dtype) @ w_out[l])
        h2 = rms_norm(x, norm2[l])
        x = x + moe_ffn(h2, router_w[l], router_b[l], w_gu[l], b_gu[l], w_down[l], b_down[l]).astype(x.dtype)
    return x
```

```cpp
#define DUP_MASK 0
#include <hip/hip_runtime.h>
#include <cstdio>
#include <cstdint>

constexpr int D_MODEL = 2048, BATCH = 4, SEQ = 8192, T = BATCH * SEQ;
constexpr int HEADS = 8, HD = 128, WIDTH = 1024;
constexpr int IN_COLS = 11272, NEXP = 32, TOPK = 4, TK = T * TOPK;
constexpr int NROWS_MAX = TK + NEXP * 256;
constexpr int NTILES_MAX = NROWS_MAX / 256;
constexpr float EPS = 1e-6f;
constexpr int RT_TOK = 128, RT_WGS = T / RT_TOK;

typedef unsigned short bf16_t;
__device__ __forceinline__ float bf2f(bf16_t b) { return __uint_as_float(((unsigned)b) << 16); }
__device__ __forceinline__ bf16_t f2bf(float f) { unsigned u = __float_as_uint(f); u += 0x7fffu + ((u >> 16) & 1u); return (bf16_t)(u >> 16); }
__device__ __forceinline__ float wave_sum(float v) {
#pragma unroll
    for (int o = 1; o < 64; o <<= 1) v += __shfl_xor(v, o);
    return v;
}
__device__ __forceinline__ float wave_max(float v) {
#pragma unroll
    for (int o = 1; o < 64; o <<= 1) v = fmaxf(v, __shfl_xor(v, o));
    return v;
}
__device__ __forceinline__ float sigmoidf_(float x) { return 1.f / (1.f + __expf(-x)); }
__device__ __forceinline__ float siluf_(float x) { return x * sigmoidf_(x); }
__device__ __forceinline__ float log_sigmoidf_(float z) { return fminf(z, 0.f) - log1pf(__expf(-fabsf(z))); }

constexpr size_t MiB = 1u << 20;
constexpr size_t WS_CTL = 0;
constexpr size_t WS_SMALL = 1 * MiB;
constexpr size_t OFF_C = WS_SMALL;
constexpr size_t OFF_FL = OFF_C + 1 * MiB;
constexpr size_t OFF_TOPI = OFF_FL + 1 * MiB;
constexpr size_t OFF_GATE = OFF_TOPI + MiB / 2;
constexpr size_t OFF_POS = OFF_GATE + MiB / 2;
constexpr size_t OFF_ROWW = OFF_POS + MiB / 2;
constexpr size_t OFF_CNT = OFF_ROWW + 1 * MiB;
constexpr size_t OFF_TILEE = OFF_CNT + 64 * 1024;
constexpr size_t WS_BIG = 8 * MiB;
constexpr size_t OFF_X1 = WS_BIG;
constexpr size_t OFF_H2 = OFF_X1 + 256 * MiB;
constexpr size_t OFF_YR = OFF_H2 + 128 * MiB;
constexpr size_t OFF_A = OFF_YR + 544 * MiB;
constexpr size_t OFF_H = OFF_A;
constexpr size_t OFF_HQ = OFF_H + 128 * MiB;
constexpr size_t OFF_LOGF = OFF_HQ + 64 * MiB;
constexpr size_t OFF_HV = OFF_LOGF + 64 * MiB;
constexpr size_t OFF_HG = OFF_HV + 64 * MiB;
constexpr size_t OFF_FQ = OFF_HG + 64 * MiB;
constexpr size_t OFF_FK = OFF_FQ + 64 * MiB;
constexpr size_t OFF_FV = OFF_FK + 64 * MiB;
constexpr size_t OFF_GA = OFF_FV + 64 * MiB;
constexpr size_t OFF_GB = OFF_GA + 128 * MiB;
constexpr size_t OFF_AOUT = OFF_GB + 128 * MiB;
constexpr size_t OFF_BOUT = OFF_AOUT + 64 * MiB;
constexpr size_t OFF_MRG = OFF_BOUT + 64 * MiB;
constexpr size_t OFF_A_END = OFF_MRG + 128 * MiB;
constexpr size_t OFF_XS = OFF_A;
constexpr size_t OFF_ACT = OFF_XS + 544 * MiB;
constexpr size_t WS_END = (OFF_A_END > OFF_ACT + 544 * MiB) ? OFF_A_END : OFF_ACT + 544 * MiB;

struct P {
    const float *x, *lb_logits, *norm1, *w_in, *hg_norm, *fq_norm, *fk_norm, *f_bias, *w_up_hg, *w_up_fox, *w_out, *norm2, *router_w, *router_b, *w_gu, *b_gu, *w_down, *b_down;
    float* out; unsigned char* ws;
};

#define LAS __attribute__((address_space(3)))
#define GAS __attribute__((address_space(1)))
typedef short bf16x8 __attribute__((ext_vector_type(8)));
typedef float f32x4 __attribute__((ext_vector_type(4)));
typedef float f32x2 __attribute__((ext_vector_type(2)));
typedef unsigned u32x4 __attribute__((ext_vector_type(4)));
typedef unsigned u32x2 __attribute__((ext_vector_type(2)));
#define LDS_WAIT() asm volatile("s_waitcnt lgkmcnt(0)" ::: "memory")
#define VM_WAIT() asm volatile("s_waitcnt vmcnt(0)" ::: "memory")
__device__ __forceinline__ unsigned cvt_pk_bf16(float lo, float hi) { unsigned r; asm volatile("v_cvt_pk_bf16_f32 %0, %1, %2" : "=v"(r) : "v"(lo), "v"(hi)); return r; }
__device__ __forceinline__ float fast_sigmoid(float x) { return __builtin_amdgcn_rcpf(1.f + __builtin_amdgcn_exp2f(-1.4426950408889634f * x)); }

constexpr size_t OFF_WIN_T = OFF_A_END;
constexpr size_t OFF_WUPA_T = OFF_WIN_T + 44 * MiB;
constexpr size_t OFF_WUPB_T = OFF_WUPA_T + 4 * MiB;
constexpr size_t OFF_WOUT_T = OFF_WUPB_T + 4 * MiB;
constexpr size_t OFF_WGU_T = OFF_WOUT_T + 8 * MiB;
constexpr size_t OFF_WDN_T = OFF_WGU_T + 512 * MiB;
constexpr size_t WS_END2 = OFF_WDN_T + 256 * MiB;
constexpr size_t OFF_SLOC = WS_END2;
constexpr size_t OFF_STATE = OFF_SLOC + 128 * MiB;
constexpr size_t OFF_DEC = OFF_STATE + 128 * MiB;
constexpr size_t OFF_H8 = OFF_DEC + 2 * MiB;
constexpr size_t OFF_WIN8_T = OFF_H8 + 64 * MiB;
constexpr size_t OFF_WOUT8_T = OFF_WIN8_T + 24 * MiB;
constexpr size_t WS_END3 = OFF_WIN8_T + 28 * MiB;
constexpr size_t OFF_BT = OFF_TILEE + 4096;
constexpr size_t OFF_JLO = OFF_BT + 8192 + 4096;
constexpr size_t OFF_RWT = 7 * MiB + 128 * 1024;
constexpr size_t OFF_HSC = 7 * MiB + 640 * 1024;
constexpr int CW_CMAX2 = 49152, CW_RMAX = 65536;
constexpr int CW_CMAX = 32768;
constexpr size_t OFF_RSTD = 7 * MiB + 512 * 1024;
constexpr size_t OFF_ROWRS = 6 * MiB + 576 * 1024;
constexpr size_t OFF_ROWTOK = 6 * MiB;
static_assert(OFF_ROWTOK + (size_t)NROWS_MAX * 4 <= OFF_ROWRS && OFF_ROWRS + (size_t)NROWS_MAX * 4 <= OFF_RWT && OFF_RWT + 2 * NEXP * D_MODEL * 2 <= OFF_RSTD && OFF_RSTD + (size_t)T * 4 <= WS_BIG && OFF_JLO + 4096 <= OFF_ROWTOK, "small-table map");
constexpr size_t OFF_X1B = OFF_H;
constexpr int CW_BAR = 4096;
constexpr size_t CTL_ZERO_BYTES = 512 * 1024;

#define XB_TMO      128
#define XB_XCNT(j)  (256  + 64 * (j))
#define XB_XSUB(j)  (1280 + 64 * (j))
#define XB_XGEN(j)  (2304 + 64 * (j))
#define XB_TOP      3328
#define XB_TOPGEN   3392
#define XCD_BAR_WORDS 3456
#define XB_SPIN_CAP (1u << 18)
__device__ __forceinline__ unsigned xb_ld(unsigned* p)              { return __hip_atomic_load(p, __ATOMIC_RELAXED, __HIP_MEMORY_SCOPE_AGENT); }
__device__ __forceinline__ unsigned xb_add(unsigned* p, unsigned v) { return __hip_atomic_fetch_add(p, v, __ATOMIC_RELAXED, __HIP_MEMORY_SCOPE_AGENT); }
__device__ __forceinline__ unsigned xb_xcc_id() { return (unsigned)__builtin_amdgcn_s_getreg((3 << 11) | 20) & 0xFu; }
#define XB_SPIN(cond, bar) do { unsigned _sp = 0; while (cond) { __builtin_amdgcn_s_sleep(1); \
    if ((++_sp & 255u) == 0u) { if (xb_ld(&(bar)[XB_TMO])) break; if (_sp > XB_SPIN_CAP) { atomicAdd(&(bar)[XB_TMO], 1u); break; } } } } while (0)
struct XcdBarrier { unsigned* bar; unsigned x; volatile LAS unsigned* st; };
__device__ __forceinline__ XcdBarrier xcd_barrier_post(unsigned* bar, volatile LAS unsigned* st) {
    XcdBarrier b; b.bar = bar; b.x = xb_xcc_id(); b.st = st;
    if (threadIdx.x == 0) (void)xb_add(&bar[XB_XCNT(b.x)], 1u);
    return b;
}
__device__ __forceinline__ void xcd_barrier_complete(unsigned* bar, unsigned x, unsigned& nloc, unsigned& nx) {
    const unsigned G = gridDim.x * gridDim.y * gridDim.z;
    unsigned sum, cnt, mine, sp = 0u;
    for (;;) {
        sum = 0u; cnt = 0u; mine = 0u;
#pragma unroll
        for (unsigned j = 0; j < 16; ++j) { const unsigned c = xb_ld(&bar[XB_XCNT(j)]); sum += c; cnt += (c > 0u) ? 1u : 0u; mine = (j == x) ? c : mine; }
        if (sum == G) break;
        __builtin_amdgcn_s_sleep(1);
        if ((++sp & 255u) == 0u) { if (xb_ld(&bar[XB_TMO])) break; if (sp > XB_SPIN_CAP) { atomicAdd(&bar[XB_TMO], 1u); break; } }
    }
    nloc = mine > 0u ? mine : 1u; nx = cnt > 0u ? cnt : 1u;
}
__device__ __forceinline__ void xcd_barrier(const XcdBarrier& b) {
    asm volatile("s_waitcnt vmcnt(0)" ::: "memory");
    __syncthreads();
    if (threadIdx.x == 0) {
        unsigned* bar = b.bar;
        __builtin_amdgcn_s_waitcnt(0);
        unsigned nloc = b.st[0], nx = b.st[1];
        if (nloc == 0u) { xcd_barrier_complete(bar, b.x, nloc, nx); b.st[0] = nloc; b.st[1] = nx; }
        const unsigned old = xb_add(&bar[XB_XSUB(b.x)], 1u);
        const unsigned gen = old / nloc;
        if (old + 1u == (gen + 1u) * nloc) {
            __builtin_amdgcn_fence(__ATOMIC_RELEASE, "agent");
            asm volatile("s_waitcnt vmcnt(0)" ::: "memory");
            const unsigned og = xb_add(&bar[XB_TOP], 1u);
            const unsigned tg = og / nx;
            if (og + 1u == (tg + 1u) * nx) xb_add(&bar[XB_TOPGEN], 1u);
            else XB_SPIN(xb_ld(&bar[XB_TOPGEN]) == tg, bar);
            __builtin_amdgcn_fence(__ATOMIC_ACQUIRE, "agent");
            xb_add(&bar[XB_XGEN(b.x)], 1u);
            asm volatile("s_waitcnt vmcnt(0)" ::: "memory");
        } else {
            XB_SPIN(xb_ld(&bar[XB_XGEN(b.x)]) == gen, bar);
            __builtin_amdgcn_fence(__ATOMIC_ACQUIRE, "agent");
            asm volatile("s_waitcnt vmcnt(0)" ::: "memory");
        }
    }
    __syncthreads();
}

namespace pg8 {
constexpr int BM = 256, BK = 64, HALF = 128, HTB = HALF * BK * 2, STAGE_BYTES = 8 * HTB, NXCD = 8, WGM = 8;
__host__ __device__ __forceinline__ int lds_byte(int r, int c) { const int st = (r >> 4) * 2 + (c >> 5), rr = r & 15, cc = c & 31, ob = rr * 64 + cc * 2; return st * 1024 + (ob ^ (((ob >> 9) & 1) << 5)); }
__host__ __device__ __forceinline__ void stage_rc(int b, int& R, int& C) { const int st = b / 1024, sb = b % 1024, swz = sb ^ (((sb >> 9) & 1) << 5); R = (st >> 1) * 16 + swz / 64; C = (st & 1) * 32 + (swz % 64) / 2; }
__host__ __device__ __forceinline__ int perm32(int rho) { const int n = rho >> 4, i = rho & 15; return 8 * (i >> 2) + 4 * n + (i & 3); }
struct Unit { int pm, pn, e, h; };
__device__ __forceinline__ void tile_map(int wgid, int nM, int nN, int& pm, int& pn) {
    const int nwg = nM * nN; { const int q = nwg / NXCD, r = nwg % NXCD, xcd = wgid % NXCD, off = wgid / NXCD; wgid = (xcd < r ? xcd * (q + 1) : r * (q + 1) + (xcd - r) * q) + off; }
    const int nig = WGM * nN, gid = wgid / nig, fm = gid * WGM, gsz = (nM - fm) < WGM ? (nM - fm) : WGM;
    pm = fm + ((wgid % nig) % gsz); pn = (wgid % nig) / gsz;
}
typedef int i32x8 __attribute__((ext_vector_type(8)));
typedef int i32x4 __attribute__((ext_vector_type(4)));
template <class Epi, class Sched, bool FP8 = false, bool GATHER = false, bool I8 = false>
__device__ __forceinline__ void gemm_phase(LAS unsigned char* lds, const int K, const Sched& S, const Epi& E, const int* rowtok = nullptr) {
    int tid = threadIdx.x; asm volatile("" : "+v"(tid));
    const int wid = __builtin_amdgcn_readfirstlane(tid >> 6), lane = tid & 63, wr = wid >> 2, wc = wid & 3, fr = lane & 15, fq = lane >> 4;
    const int nt = K / BK;
    unsigned voffA[2], voffB[2];
#pragma unroll
    for (int i = 0; i < 2; ++i) { int R, C; stage_rc(tid * 16 + i * 8192, R, C); const int Rb = Epi::PERM ? ((R & ~31) + perm32(R & 31)) : R;
        voffA[i] = (unsigned)(R * K + C) * 2u; voffB[i] = (unsigned)(Rb * K + C) * 2u; }
    const size_t kstep = (size_t)(BK * 2);
    const size_t hstep = (size_t)HALF * K * 2;
    const unsigned ldsw = (unsigned)wid * 1024u;
    const int aoff = lds_byte(wr * 64 + fr, fq * 8), boff = lds_byte(wc * 32 + fr, fq * 8);
#define PG8_SA(b, h) (((b) * 2 + (h)) * HTB)
#define PG8_SB(b, h) ((4 + (b) * 2 + (h)) * HTB)
#define PG8_STAGE(bufoff, gbase, voff) do { _Pragma("unroll") for (int _i = 0; _i < 2; ++_i) \
        __builtin_amdgcn_global_load_lds((const unsigned*)((const char*)(gbase) + (voff)[_i]), (LAS unsigned*)(lds + (bufoff) + ldsw + _i * 8192), 16, 0, 0); } while (0)
#define PG8_LDA(dst, b, h) do { _Pragma("unroll") for (int m = 0; m < 4; ++m) { const i32x4 _x = *(const LAS i32x4*)(lds + PG8_SA(b, h) + aoff + m * 2048), _y = *(const LAS i32x4*)(lds + PG8_SA(b, h) + aoff + m * 2048 + 1024); \
        dst[m] = __builtin_shufflevector(_x, _y, 0, 1, 2, 3, 4, 5, 6, 7); } } while (0)
#define PG8_LDB(dst, b, h) do { _Pragma("unroll") for (int n = 0; n < 2; ++n) { const i32x4 _x = *(const LAS i32x4*)(lds + PG8_SB(b, h) + boff + n * 2048), _y = *(const LAS i32x4*)(lds + PG8_SB(b, h) + boff + n * 2048 + 1024); \
        dst[n] = __builtin_shufflevector(_x, _y, 0, 1, 2, 3, 4, 5, 6, 7); } } while (0)
#define PG8_LO(v) __builtin_bit_cast(bf16x8, __builtin_shufflevector(v, v, 0, 1, 2, 3))
#define PG8_HI(v) __builtin_bit_cast(bf16x8, __builtin_shufflevector(v, v, 4, 5, 6, 7))
#define PG8_MMA(ai, bj, At, Bt) do { __builtin_amdgcn_s_setprio(1); if constexpr (I8) { _Pragma("unroll") for (int m = 0; m < 4; ++m) _Pragma("unroll") for (int n = 0; n < 2; ++n) { \
        i32x4 _c = __builtin_bit_cast(i32x4, acc[ai][bj][m][n]); \
        _c = __builtin_amdgcn_mfma_i32_16x16x64_i8(__builtin_shufflevector(Bt[n], Bt[n], 0, 1, 2, 3), __builtin_shufflevector(At[m], At[m], 0, 1, 2, 3), _c, 0, 0, 0); \
        _c = __builtin_amdgcn_mfma_i32_16x16x64_i8(__builtin_shufflevector(Bt[n], Bt[n], 4, 5, 6, 7), __builtin_shufflevector(At[m], At[m], 4, 5, 6, 7), _c, 0, 0, 0); \
        acc[ai][bj][m][n] = __builtin_bit_cast(f32x4, _c); } } else if constexpr (FP8) { _Pragma("unroll") for (int m = 0; m < 4; ++m) _Pragma("unroll") for (int n = 0; n < 2; ++n) \
        asm volatile("v_mfma_scale_f32_16x16x128_f8f6f4 %0, %1, %2, %0, %3, %4 op_sel_hi:[0,0,0]" : "+v"(acc[ai][bj][m][n]) : "v"(Bt[n]), "v"(At[m]), "v"(sc_w), "v"(sc_a)); } else { \
        _Pragma("unroll") for (int m = 0; m < 4; ++m) _Pragma("unroll") for (int n = 0; n < 2; ++n) { \
        acc[ai][bj][m][n] = __builtin_amdgcn_mfma_f32_16x16x32_bf16(PG8_LO(Bt[n]), PG8_LO(At[m]), acc[ai][bj][m][n], 0, 0, 0); \
        acc[ai][bj][m][n] = __builtin_amdgcn_mfma_f32_16x16x32_bf16(PG8_HI(Bt[n]), PG8_HI(At[m]), acc[ai][bj][m][n], 0, 0, 0); } } __builtin_amdgcn_s_setprio(0); } while (0)
#define PG8_WAIT_V(n) asm volatile("s_waitcnt vmcnt(" #n ")" ::: "memory")
#define PG8_WAIT_L(n) asm volatile("s_waitcnt lgkmcnt(" #n ")" ::: "memory")
#define PG8_BAR __builtin_amdgcn_s_barrier()
#define PG8_SCHED __builtin_amdgcn_sched_barrier(0)
    Unit cur, nxt; int ui = 0;
    if (!S.next(0, cur)) return;
    unsigned gA[2][2], gN[2][2], arow[2];
    if constexpr (GATHER) {
#pragma unroll
        for (int i = 0; i < 2; ++i) { int R, C; stage_rc(tid * 16 + i * 8192, R, C); arow[i] = (unsigned)R; voffA[i] = (unsigned)C * 2u; }
#pragma unroll
        for (int h = 0; h < 2; ++h)
#pragma unroll
            for (int i = 0; i < 2; ++i) gA[h][i] = (unsigned)rowtok[cur.pm * 256 + h * 128 + (int)arow[i]] * (unsigned)(K * 2) + voffA[i];
    }
#define PG8_STAGE_A(bufoff, gbase, h, last_) do { if constexpr (GATHER) { if (last_) { _Pragma("unroll") for (int _i = 0; _i < 2; ++_i) \
        __builtin_amdgcn_global_load_lds((const unsigned*)((const char*)(gbase) + gN[h][_i]), (LAS unsigned*)(lds + (bufoff) + ldsw + _i * 8192), 16, 0, 0); } else { _Pragma("unroll") for (int _i = 0; _i < 2; ++_i) \
        __builtin_amdgcn_global_load_lds((const unsigned*)((const char*)(gbase) + gA[h][_i]), (LAS unsigned*)(lds + (bufoff) + ldsw + _i * 8192), 16, 0, 0); } } \
        else { PG8_STAGE(bufoff, (const char*)(gbase) + (h) * hstep, voffA); } } while (0)
    f32x4 acc[2][2][4][2];
#pragma unroll
    for (int a = 0; a < 2; ++a)
#pragma unroll
        for (int b = 0; b < 2; ++b)
#pragma unroll
            for (int m = 0; m < 4; ++m)
#pragma unroll
                for (int n = 0; n < 2; ++n) acc[a][b][m][n] = (f32x4){0.f, 0.f, 0.f, 0.f};
    i32x8 At[4], B0[2], B1[2];
    int sc_w = 121, sc_a = 127; asm volatile("" : "+v"(sc_w), "+v"(sc_a));
    const char* cA = S.aptr(cur); const char* cB = S.bptr(cur);
    PG8_STAGE(PG8_SB(0, 0), cB, voffB); PG8_STAGE(PG8_SB(0, 1), cB + hstep, voffB); PG8_STAGE_A(PG8_SA(0, 0), cA, 0, false); PG8_STAGE_A(PG8_SA(0, 1), cA, 1, false);
    if (wr == 1) PG8_BAR;
    PG8_WAIT_V(2); PG8_BAR;
    PG8_STAGE(PG8_SB(1, 0), cB + kstep, voffB); PG8_STAGE_A(PG8_SA(1, 0), cA + kstep, 0, false); PG8_STAGE(PG8_SB(1, 1), cB + hstep + kstep, voffB);
    PG8_WAIT_V(6); PG8_BAR;
    for (;;) {
        const bool has_next = S.next(ui + 1, nxt);
        const char* nA = has_next ? S.aptr(nxt) : cA; const char* nB = has_next ? S.bptr(nxt) : cB;
        if constexpr (GATHER) { const int pmn = has_next ? nxt.pm : cur.pm;
#pragma unroll
            for (int h = 0; h < 2; ++h)
#pragma unroll
                for (int i = 0; i < 2; ++i) gN[h][i] = (unsigned)rowtok[pmn * 256 + h * 128 + (int)arow[i]] * (unsigned)(K * 2) + voffA[i]; }
        for (int t = 0; t < nt; t += 2) {
            const bool last = (t == nt - 2);
            const char* a1 = cA + (size_t)(t + 1) * kstep;
            const char* a2 = last ? nA : cA + (size_t)(t + 2) * kstep; const char* b2 = last ? nB : cB + (size_t)(t + 2) * kstep;
            const char* a3 = a2 + kstep; const char* b3 = b2 + kstep;
            PG8_LDB(B0, 0, 0); PG8_LDB(B1, 0, 1); PG8_SCHED; PG8_LDA(At, 0, 0); PG8_STAGE_A(PG8_SA(1, 1), a1, 1, false);
            PG8_WAIT_V(8); PG8_WAIT_L(0); PG8_BAR; PG8_MMA(0, 0, At, B0); PG8_MMA(0, 1, At, B1); PG8_BAR; PG8_SCHED;
            PG8_LDA(At, 0, 1); PG8_STAGE(PG8_SB(0, 0), b2, voffB); PG8_STAGE(PG8_SB(0, 1), b2 + hstep, voffB); PG8_STAGE_A(PG8_SA(0, 0), a2, 0, last);
            PG8_WAIT_V(8); PG8_WAIT_L(0); PG8_BAR; PG8_MMA(1, 0, At, B0); PG8_MMA(1, 1, At, B1); PG8_BAR; PG8_SCHED;
            PG8_LDB(B0, 1, 0); PG8_LDB(B1, 1, 1); PG8_SCHED; PG8_LDA(At, 1, 0); PG8_STAGE_A(PG8_SA(0, 1), a2, 1, last);
            PG8_WAIT_V(8); PG8_WAIT_L(0); PG8_BAR; PG8_MMA(0, 0, At, B0); PG8_MMA(0, 1, At, B1); PG8_BAR; PG8_SCHED;
            PG8_LDA(At, 1, 1); PG8_STAGE(PG8_SB(1, 0), b3, voffB); PG8_STAGE(PG8_SB(1, 1), b3 + hstep, voffB); PG8_STAGE_A(PG8_SA(1, 0), a3, 0, last);
            PG8_WAIT_V(8); PG8_WAIT_L(0); PG8_BAR; PG8_MMA(1, 0, At, B0); PG8_MMA(1, 1, At, B1); PG8_BAR; PG8_SCHED;
        }
        if (wr == 0) PG8_BAR;
        if constexpr (FP8 && !I8) asm volatile("s_nop 15\n\ts_nop 15" ::: "memory");
        if constexpr (I8) {
            const float* rsp = S.rs + cur.pm * 256 + wr * 64 + fr; const int colb = cur.e * 256 + wc * 32 + 8 * fq;
            f32x4 cs[2][2];
#pragma unroll
            for (int bj = 0; bj < 2; ++bj)
#pragma unroll
                for (int n = 0; n < 2; ++n) { const int c0 = S.ccol(colb + bj * 128 + 4 * n); const u32x4 cb = *(const u32x4*)(S.cs + c0);
                    cs[bj][n] = (f32x4){__uint_as_float(cb.x), __uint_as_float(cb.y), __uint_as_float(cb.z), __uint_as_float(cb.w)} * (1.f / 127.f); }
#pragma unroll
            for (int ai = 0; ai < 2; ++ai)
#pragma unroll
                for (int m = 0; m < 4; ++m) { const float r = rsp[ai * 128 + m * 16];
#pragma unroll
                    for (int bj = 0; bj < 2; ++bj)
#pragma unroll
                        for (int n = 0; n < 2; ++n) { const i32x4 ci = __builtin_bit_cast(i32x4, acc[ai][bj][m][n]);
                            acc[ai][bj][m][n] = (f32x4){(float)ci[0], (float)ci[1], (float)ci[2], (float)ci[3]} * (cs[bj][n] * r); } }
        }
        E(acc, cur, wr, wc, fr, fq);
#ifdef EPI_DUP
        E(acc, cur, wr, wc, fr, fq);
#endif
        if (!has_next) break;
#pragma unroll
        for (int a = 0; a < 2; ++a)
#pragma unroll
            for (int b = 0; b < 2; ++b)
#pragma unroll
                for (int m = 0; m < 4; ++m)
#pragma unroll
                    for (int n = 0; n < 2; ++n) acc[a][b][m][n] = (f32x4){0.f, 0.f, 0.f, 0.f};
        cur = nxt; cA = nA; cB = nB; ++ui;
        if constexpr (GATHER) { gA[0][0] = gN[0][0]; gA[0][1] = gN[0][1]; gA[1][0] = gN[1][0]; gA[1][1] = gN[1][1]; }
        if (wr == 1) PG8_BAR;
    }
    PG8_WAIT_V(0);
    PG8_BAR;
#undef PG8_SA
#undef PG8_SB
#undef PG8_STAGE
#undef PG8_STAGE_A
#undef PG8_LDA
#undef PG8_LDB
#undef PG8_LO
#undef PG8_HI
#undef PG8_MMA
#undef PG8_WAIT_V
#undef PG8_WAIT_L
#undef PG8_BAR
#undef PG8_SCHED
}
struct SchedDense {
    int nM, nN, G, c; const char* A; const char* Bt; size_t tstep;
    __device__ __forceinline__ bool next(int i, Unit& u) const { const long L = (long)i * G + c; if (L >= (long)nM * nN) return false; tile_map((int)L, nM, nN, u.pm, u.pn); u.e = 0; u.h = 0; return true; }
    __device__ __forceinline__ const char* aptr(const Unit& u) const { return A + (size_t)u.pm * tstep; }
    __device__ __forceinline__ const char* bptr(const Unit& u) const { return Bt + (size_t)u.pn * tstep; }
};
struct SchedMerge {
    int nM, nN, G, c; const char *A0, *A1, *B0, *B1; size_t tstep;
    __device__ __forceinline__ bool next(int i, Unit& u) const { const long L = (long)(i >> 1) * G + c; if (L >= (long)nM * nN) return false; tile_map((int)L, nM, nN, u.pm, u.pn); u.e = 0; u.h = i & 1; return true; }
    __device__ __forceinline__ const char* aptr(const Unit& u) const { return (u.h ? A1 : A0) + (size_t)u.pm * tstep; }
    __device__ __forceinline__ const char* bptr(const Unit& u) const { return (u.h ? B1 : B0) + (size_t)u.pn * tstep; }
};
struct SchedMoe {
    int nM, nN, G, c; const char* A; const char* Bt; size_t tstep, estride; const LAS int* tilee; bool gather;
    __device__ __forceinline__ bool next(int i, Unit& u) const { const long L = (long)i * G + c; if (L >= (long)nM * nN) return false; tile_map((int)L, nM, nN, u.pm, u.pn); u.e = __builtin_amdgcn_readfirstlane(tilee[u.pm]); u.h = 0; return true; }
    __device__ __forceinline__ const char* aptr(const Unit& u) const { return gather ? A : A + (size_t)u.pm * tstep; }
    __device__ __forceinline__ const char* bptr(const Unit& u) const { return Bt + (size_t)u.e * estride + (size_t)u.pn * tstep; }
};
}

constexpr int NWAVES = 8;
constexpr int RING_BYTES = 131072, MISC_OFF = RING_BYTES, LDS_BYTES = 147456;
struct Frame { LAS unsigned char* lds; volatile LAS unsigned* MISC; int tid, lane, wave, vcu, G; };
__device__ __forceinline__ Frame phase_frame(const Frame& F0) { Frame F = F0; int t = threadIdx.x; asm volatile("" : "+v"(t)); F.tid = t; F.lane = t & 63; F.wave = __builtin_amdgcn_readfirstlane(t >> 6); return F; }

struct MapId { __device__ __forceinline__ int operator()(int c) const { return c; } };
struct MapWin { __device__ __forceinline__ int operator()(int c) const { return c < 7168 ? c : (c < 7176 ? -1 : c - 8); } };
#ifndef FP8_GROUPS
#define FP8_GROUPS 0x7fu
#endif
__host__ __device__ constexpr int fp8_rank(int g) { int r = 0; for (int i = 0; i < g; ++i) r += (FP8_GROUPS >> i) & 1; return r; }
constexpr int N8G = fp8_rank(7), NB16T = 4 * (7 - N8G), NF8T = 4 * N8G + 16;
template <int SEL> __device__ __forceinline__ int in_tile_of(int l) { int cnt = 0, out = SEL ? 28 + (l - 4 * N8G) : 0;
#pragma unroll
    for (int g = 0; g < 7; ++g) if ((int)((FP8_GROUPS >> g) & 1u) == SEL) { if (l >= 4 * cnt && l < 4 * cnt + 4) out = 4 * g + (l - 4 * cnt); ++cnt; }
    return out; }
struct SchedI8 {
    int nM, nN, G, c; const char* A; const char* Bt; size_t tstep; const float* rs; const unsigned* cs;
    __device__ __forceinline__ bool next(int i, pg8::Unit& u) const { const long L = (long)i * G + c; if (L >= (long)nM * nN) return false; pg8::tile_map((int)L, nM, nN, u.pm, u.pn); u.e = u.pn; u.h = 0; return true; }
    __device__ __forceinline__ const char* aptr(const pg8::Unit& u) const { return A + (size_t)u.pm * tstep; }
    __device__ __forceinline__ const char* bptr(const pg8::Unit& u) const { return Bt + (size_t)u.pn * tstep; }
    __device__ __forceinline__ int ccol(int c0) const { return c0; }
};
template <int SEL> struct SchedIn {
    int nM, nN, G, c; const char* A; const char* Bt; size_t tstep; const float* rs; const unsigned* cs;
    __device__ __forceinline__ bool next(int i, pg8::Unit& u) const { const long L = (long)i * G + c; if (L >= (long)nM * nN) return false; pg8::tile_map((int)L, nM, nN, u.pm, u.pn); u.e = in_tile_of<SEL>(u.pn); u.h = 0; return true; }
    __device__ __forceinline__ const char* aptr(const pg8::Unit& u) const { return A + (size_t)u.pm * tstep; }
    __device__ __forceinline__ const char* bptr(const pg8::Unit& u) const { return Bt + (size_t)(SEL ? u.pn : u.e) * tstep; }
    __device__ __forceinline__ int ccol(int c0) const { return c0 < 7168 ? c0 : c0 + 8; }
};
struct MapWinG { __device__ __forceinline__ int operator()(int c) const { if (c >= 7176) return c - 7176 + 1024 * N8G; if (c >= 7168) return -1; const int g = c >> 10; int r = 0;
#pragma unroll
        for (int i = 0; i < 7; ++i) r += (i < g) ? (int)((FP8_GROUPS >> i) & 1u) : 0;
        return ((FP8_GROUPS >> g) & 1u) ? r * 1024 + (c & 1023) : -1; } };
struct MapGu { __device__ __forceinline__ int operator()(int c) const { const int bj = c >> 11, j = c & 2047; return ((j >> 7) << 8) + (bj << 7) + (j & 127); } };
__device__ __forceinline__ unsigned pk4_fp8(float a, float b, float c, float d) { int r = __builtin_amdgcn_cvt_pk_fp8_f32(a, b, 0, false); r = __builtin_amdgcn_cvt_pk_fp8_f32(c, d, r, true); return (unsigned)r; }
constexpr float W8_SCALE = 64.f;
__device__ __forceinline__ unsigned pk4_i8(float a, float b, float c, float d) { const int q0 = (int)__builtin_rintf(__builtin_amdgcn_fmed3f(a, -127.f, 127.f)), q1 = (int)__builtin_rintf(__builtin_amdgcn_fmed3f(b, -127.f, 127.f)), q2 = (int)__builtin_rintf(__builtin_amdgcn_fmed3f(c, -127.f, 127.f)), q3 = (int)__builtin_rintf(__builtin_amdgcn_fmed3f(d, -127.f, 127.f)); return (unsigned)(q0 & 255) | ((unsigned)(q1 & 255) << 8) | ((unsigned)(q2 & 255) << 16) | ((unsigned)q3 << 24); }
template <class Map, bool Q8 = false, bool I8 = false>
__device__ __forceinline__ void p0_transpose_item(const float* W, int K, int N, void* WTv, LAS float* scr, int item, int lane, Map map, const unsigned* cmax = nullptr) {
    const int nblk = (N + 31) / 32, kb = item / nblk, nb = item % nblk, k0 = 64 * kb, n0 = 32 * nb;
    const int col = n0 + (lane & 31); const bool okc = col < N;
    float v[32];
#pragma unroll
    for (int i = 0; i < 32; ++i) { const int kk = 2 * i + (lane >> 5); v[i] = okc ? W[(size_t)(k0 + kk) * N + col] : 0.f; }
#pragma unroll
    for (int i = 0; i < 32; ++i) { const int kk = 2 * i + (lane >> 5); scr[kk * 33 + (lane & 31)] = v[i]; }
    LDS_WAIT(); asm volatile("" ::: "memory");
    const int c = lane & 7;
#pragma unroll
    for (int j = 0; j < 4; ++j) { const int n = (lane >> 3) + 8 * j; const LAS float* s = scr + (8 * c) * 33 + n;
        const int dr = (n0 + n < N) ? map(n0 + n) : -1;
        if constexpr (Q8) { u32x2 o;
            if constexpr (I8) { const float inv = 127.f / fmaxf(__uint_as_float(cmax[(n0 + n < N) ? n0 + n : 0]), 1e-30f);
                o.x = pk4_i8(s[0 * 33] * inv, s[1 * 33] * inv, s[2 * 33] * inv, s[3 * 33] * inv); o.y = pk4_i8(s[4 * 33] * inv, s[5 * 33] * inv, s[6 * 33] * inv, s[7 * 33] * inv); }
            else { o.x = pk4_fp8(s[0 * 33] * W8_SCALE, s[1 * 33] * W8_SCALE, s[2 * 33] * W8_SCALE, s[3 * 33] * W8_SCALE); o.y = pk4_fp8(s[4 * 33] * W8_SCALE, s[5 * 33] * W8_SCALE, s[6 * 33] * W8_SCALE, s[7 * 33] * W8_SCALE); }
            if (dr >= 0) *(u32x2*)((unsigned char*)WTv + (size_t)dr * K + k0 + 8 * c) = o; }
        else { u32x4 o; o.x = cvt_pk_bf16(s[0 * 33], s[1 * 33]); o.y = cvt_pk_bf16(s[2 * 33], s[3 * 33]); o.z = cvt_pk_bf16(s[4 * 33], s[5 * 33]); o.w = cvt_pk_bf16(s[6 * 33], s[7 * 33]);
            if (dr >= 0) *(u32x4*)((bf16_t*)WTv + (size_t)dr * K + k0 + 8 * c) = o; } }
    LDS_WAIT(); asm volatile("" ::: "memory");
}
template <class Map>
__device__ __forceinline__ void p0_fp8_load(float (&v)[64], const float* W, int N, int item, int lane) {
    const int nblk = N / 32, kb = item / nblk, nb = item % nblk, k0 = 128 * kb + 64 * (lane >> 5), col = 32 * nb + (lane & 31);
    const float* src = W + (size_t)k0 * N + col;
#pragma unroll
    for (int i = 0; i < 64; ++i) v[i] = __builtin_nontemporal_load(src + (size_t)i * N);
}
template <class Map>
__device__ __forceinline__ void p0_fp8_finish(const float (&v)[64], int K, int N, unsigned char* WT, int item, int lane, Map map) {
    const int nblk = N / 32, kb = item / nblk, nb = item % nblk, k0 = 128 * kb + 64 * (lane >> 5), col = 32 * nb + (lane & 31);
    u32x4 o[4];
#pragma unroll
    for (int q = 0; q < 4; ++q) {
        o[q].x = pk4_fp8(v[16 * q + 0] * W8_SCALE, v[16 * q + 1] * W8_SCALE, v[16 * q + 2] * W8_SCALE, v[16 * q + 3] * W8_SCALE);
        o[q].y = pk4_fp8(v[16 * q + 4] * W8_SCALE, v[16 * q + 5] * W8_SCALE, v[16 * q + 6] * W8_SCALE, v[16 * q + 7] * W8_SCALE);
        o[q].z = pk4_fp8(v[16 * q + 8] * W8_SCALE, v[16 * q + 9] * W8_SCALE, v[16 * q + 10] * W8_SCALE, v[16 * q + 11] * W8_SCALE);
        o[q].w = pk4_fp8(v[16 * q + 12] * W8_SCALE, v[16 * q + 13] * W8_SCALE, v[16 * q + 14] * W8_SCALE, v[16 * q + 15] * W8_SCALE); }
#define XCHG(pa, pb, bit, msk) do { const bool b_ = (lane & (bit)) != 0; u32x4 s_ = b_ ? o[pa] : o[pb]; \
        s_.x = (unsigned)__shfl_xor((int)s_.x, msk); s_.y = (unsigned)__shfl_xor((int)s_.y, msk); s_.z = (unsigned)__shfl_xor((int)s_.z, msk); s_.w = (unsigned)__shfl_xor((int)s_.w, msk); \
        if (b_) o[pa] = s_; else o[pb] = s_; } while (0)
    XCHG(0, 1, 1, 1); XCHG(2, 3, 1, 1); XCHG(0, 2, 2, 2); XCHG(1, 3, 2, 2);
#undef XCHG
    const int j = lane & 3, colb = col - j;
#pragma unroll
    for (int q = 0; q < 4; ++q) *(u32x4*)(WT + (size_t)map(colb + q) * K + k0 + 16 * j) = o[q];
}
constexpr int CW_QH = 128, CW_QC = 192;
__device__ __forceinline__ void p0_weights(const Frame& F0, const P& p) { const Frame F = phase_frame(F0);
    LAS float* scr = (LAS float*)(F.lds + F.wave * 8448);
    const int gw = F.vcu * NWAVES + F.wave, NGW = F.G * NWAVES;
    constexpr int I_IN = (2048 / 64) * ((IN_COLS + 31) / 32), I_UP = (1024 / 64) * (2048 / 32), NB16 = I_IN + 2 * I_UP;
    unsigned char* ws = p.ws;
    for (int it = gw; it < NB16 - I_IN; it += NGW) {
        int r = it;
        if (r < I_UP) { p0_transpose_item(p.w_up_hg, 1024, 2048, (bf16_t*)(ws + OFF_WUPA_T), scr, r, F.lane, MapId{}); continue; } r -= I_UP;
        p0_transpose_item(p.w_up_fox, 1024, 2048, (bf16_t*)(ws + OFF_WUPB_T), scr, r, F.lane, MapId{});
    }
}
template <int NCOLS> __device__ __forceinline__ void p0_colmax_t(const Frame& F0, const float* W, unsigned* CMAX) { const Frame F = phase_frame(F0);
    const int gw = F.vcu * NWAVES + F.wave, NGW = F.G * NWAVES, lane = F.lane;
    constexpr int NBLK = (NCOLS + 31) / 32, I_IN = (2048 / 64) * NBLK;
    for (int it = gw; it < I_IN; it += NGW) { const int kb = it / NBLK, nb = it % NBLK, k0 = 64 * kb, col = 32 * nb + (lane & 31); const bool okc = col < NCOLS;
        float m = 0.f;
#pragma unroll
        for (int i = 0; i < 32; ++i) { const int kk = 2 * i + (lane >> 5); m = fmaxf(m, __builtin_fabsf(okc ? W[(size_t)(k0 + kk) * NCOLS + col] : 0.f)); }
        m = fmaxf(m, __shfl_xor(m, 32));
        if (lane < 32 && okc) atomicMax(CMAX + col, __float_as_uint(m)); }
}
__device__ __forceinline__ void p0_colmax(const Frame& F0, const P& p) { p0_colmax_t<IN_COLS>(F0, p.w_in, (unsigned*)(p.ws + WS_CTL) + CW_CMAX); p0_colmax_t<2048>(F0, p.w_out, (unsigned*)(p.ws + WS_CTL) + CW_CMAX2); }
__device__ __forceinline__ void p0_win_i8(const Frame& F0, const P& p) { const Frame F = phase_frame(F0);
    LAS float* scr = (LAS float*)(F.lds + F.wave * 8448);
    const unsigned* CMAX = (const unsigned*)(p.ws + WS_CTL) + CW_CMAX;
    const int gw = F.vcu * NWAVES + F.wave, NGW = F.G * NWAVES;
    constexpr int I_IN = (2048 / 64) * ((IN_COLS + 31) / 32);
    for (int it = gw; it < I_IN; it += NGW) p0_transpose_item<MapWinG, true, true>(p.w_in, 2048, IN_COLS, p.ws + OFF_WIN8_T, scr, it, F.lane, MapWinG{}, CMAX);
    constexpr int I_OUT = (2048 / 64) * (2048 / 32);
    for (int it = gw; it < I_OUT; it += NGW) p0_transpose_item<MapId, true, true>(p.w_out, 2048, 2048, p.ws + OFF_WOUT8_T, scr, it, F.lane, MapId{}, (const unsigned*)(p.ws + WS_CTL) + CW_CMAX2);
}
struct MapGuOrId { int gu; __device__ __forceinline__ int operator()(int c) const { const int bj = c >> 11, j = c & 2047; return gu ? ((j >> 7) << 8) + (bj << 7) + (j & 127) : c; } };
__device__ __forceinline__ void cq_issue(float (&v)[64], const P& p, int c, int wave, int lane) {
    constexpr int I_GU = (2048 / 128) * (4096 / 32), I_DN = (2048 / 128) * (2048 / 32);
    const int r = __builtin_amdgcn_readfirstlane(c * 8 + wave); const bool gu = r < NEXP * I_GU; const int q = gu ? r : r - NEXP * I_GU, per = gu ? I_GU : I_DN, e = q / per, N = gu ? 4096 : 2048;
    const float* W = gu ? p.w_gu + (size_t)e * 2048 * 4096 : p.w_down + (size_t)e * 2048 * 2048;
    p0_fp8_load<MapId>(v, W, N, q - e * per, lane);
}
__device__ __forceinline__ void cq_finish(const float (&v)[64], const P& p, int c, int wave, int lane) {
    constexpr int I_GU = (2048 / 128) * (4096 / 32), I_DN = (2048 / 128) * (2048 / 32);
    const int r = __builtin_amdgcn_readfirstlane(c * 8 + wave); const bool gu = r < NEXP * I_GU; const int q = gu ? r : r - NEXP * I_GU, per = gu ? I_GU : I_DN, e = q / per, N = gu ? 4096 : 2048;
    unsigned char* WT = gu ? p.ws + OFF_WGU_T + (size_t)e * 4096 * 2048 : p.ws + OFF_WDN_T + (size_t)e * 2048 * 2048;
    p0_fp8_finish(v, 2048, N, WT, q - e * per, lane, MapGuOrId{gu ? 1 : 0});
}
__device__ __forceinline__ void convert_queue(const Frame& F0, const P& p) { const Frame F = phase_frame(F0);
    constexpr int I_GU = (2048 / 128) * (4096 / 32), I_DN = (2048 / 128) * (2048 / 32), NCONV = NEXP * (I_GU + I_DN), NCH = NCONV / 8;
    unsigned* qhead = (unsigned*)(p.ws + WS_CTL) + CW_QC; LAS int* slot = (LAS int*)(F.lds + MISC_OFF + 768);
    if (F.tid == 0) { slot[0] = (int)__hip_atomic_fetch_add(qhead, 1u, __ATOMIC_RELAXED, __HIP_MEMORY_SCOPE_AGENT); slot[1] = (int)__hip_atomic_fetch_add(qhead, 1u, __ATOMIC_RELAXED, __HIP_MEMORY_SCOPE_AGENT); }
    __syncthreads();
    int ca = __builtin_amdgcn_readfirstlane(slot[0]), cb = __builtin_amdgcn_readfirstlane(slot[1]);
    float va[64], vb[64];
    if (ca < NCH) {
        cq_issue(va, p, ca, F.wave, F.lane);
        for (;;) {
            if (F.tid == 0) slot[2] = (int)__hip_atomic_fetch_add(qhead, 1u, __ATOMIC_RELAXED, __HIP_MEMORY_SCOPE_AGENT);
            cq_issue(vb, p, cb < NCH ? cb : NCH - 1, F.wave, F.lane);
            cq_finish(va, p, ca, F.wave, F.lane);
            __syncthreads();
            const int cn = __builtin_amdgcn_readfirstlane(slot[2]);
            if (cb >= NCH) break;
            if (F.tid == 0) slot[3] = (int)__hip_atomic_fetch_add(qhead, 1u, __ATOMIC_RELAXED, __HIP_MEMORY_SCOPE_AGENT);
            cq_issue(va, p, cn < NCH ? cn : NCH - 1, F.wave, F.lane);
            cq_finish(vb, p, cb, F.wave, F.lane);
            __syncthreads();
            const int cm = __builtin_amdgcn_readfirstlane(slot[3]);
            if (cn >= NCH) break;
            ca = cn; cb = cm;
        }
    }
    __syncthreads();
}
__device__ __forceinline__ void p0_router_prep(const Frame& F0, const P& p) { const Frame F = phase_frame(F0);
    bf16_t* RWT = (bf16_t*)(p.ws + OFF_RWT);
    for (int i = F.vcu * NWAVES * 64 + F.tid; i < NEXP * D_MODEL; i += F.G * NWAVES * 64) { const int e = i >> 11, k = i & 2047;
        const float w = p.norm2[k] * p.router_w[(size_t)k * NEXP + e]; const bf16_t hi = f2bf(w); RWT[i] = hi; RWT[NEXP * D_MODEL + i] = f2bf(w - bf2f(hi)); }
}
__device__ __forceinline__ void p0_rmsnorm(const Frame& F0, const P& p) { const Frame F = phase_frame(F0);
    LAS float* WF = (LAS float*)F.lds;
    LAS float* FLs = (LAS float*)(F.lds + 65536);
    unsigned char* H8 = p.ws + OFF_H8; float* HSC = (float*)(p.ws + OFF_HSC); float* C = (float*)(p.ws + OFF_C); float* BT = (float*)(p.ws + OFF_BT);
    for (int k = F.tid; k < D_MODEL; k += NWAVES * 64) { const float4* wr = (const float4*)(p.w_in + (size_t)k * IN_COLS + 7168); const float4 w0 = wr[0], w1 = wr[1];
        WF[0 * 2048 + k] = w0.x; WF[1 * 2048 + k] = w0.y; WF[2 * 2048 + k] = w0.z; WF[3 * 2048 + k] = w0.w; WF[4 * 2048 + k] = w1.x; WF[5 * 2048 + k] = w1.y; WF[6 * 2048 + k] = w1.z; WF[7 * 2048 + k] = w1.w; }
    __syncthreads();
    const int lane = F.lane;
    for (int blk = F.vcu; blk < T / 128; blk += F.G) {
        for (int pr = 0; pr < 8; ++pr) {
            const int lt = F.wave * 16 + 2 * pr, ta = blk * 128 + lt;
            const float4* xa = (const float4*)(p.x + (size_t)ta * D_MODEL); const float4* xb = xa + D_MODEL / 4;
            float4 va[8], vb[8]; float sa = 0.f, sb = 0.f;
#pragma unroll
            for (int i = 0; i < 8; ++i) { va[i] = xa[lane + 64 * i]; vb[i] = xb[lane + 64 * i];
                sa += va[i].x * va[i].x + va[i].y * va[i].y + va[i].z * va[i].z + va[i].w * va[i].w; sb += vb[i].x * vb[i].x + vb[i].y * vb[i].y + vb[i].z * vb[i].z + vb[i].w * vb[i].w; }
            const float ra = rsqrtf(wave_sum(sa) * (1.f / D_MODEL) + EPS), rb = rsqrtf(wave_sum(sb) * (1.f / D_MODEL) + EPS);
            float qa_ = 0.f, qb_ = 0.f;
#pragma unroll
            for (int i = 0; i < 8; ++i) { const float4 g = ((const float4*)p.norm1)[lane + 64 * i];
                qa_ = fmaxf(fmaxf(qa_, fmaxf(__builtin_fabsf(va[i].x * g.x), __builtin_fabsf(va[i].y * g.y))), fmaxf(__builtin_fabsf(va[i].z * g.z), __builtin_fabsf(va[i].w * g.w)));
                qb_ = fmaxf(fmaxf(qb_, fmaxf(__builtin_fabsf(vb[i].x * g.x), __builtin_fabsf(vb[i].y * g.y))), fmaxf(__builtin_fabsf(vb[i].z * g.z), __builtin_fabsf(vb[i].w * g.w))); }
            const float ma_ = fmaxf(wave_max(qa_) * ra, 1e-30f), mb_ = fmaxf(wave_max(qb_) * rb, 1e-30f), inva = 127.f / ma_, invb = 127.f / mb_;
            if (lane == 0) { HSC[ta] = ma_ * (1.f / 127.f); HSC[ta + 1] = mb_ * (1.f / 127.f); }
            float aa[8], ab[8];
#pragma unroll
            for (int j = 0; j < 8; ++j) { aa[j] = 0.f; ab[j] = 0.f; }
#pragma unroll
            for (int i = 0; i < 8; ++i) {
                const float4 g = ((const float4*)p.norm1)[lane + 64 * i]; const int k0 = 4 * (lane + 64 * i);
                const float4 ha = make_float4(va[i].x * ra * g.x, va[i].y * ra * g.y, va[i].z * ra * g.z, va[i].w * ra * g.w);
                const float4 hb = make_float4(vb[i].x * rb * g.x, vb[i].y * rb * g.y, vb[i].z * rb * g.z, vb[i].w * rb * g.w);
                *(unsigned*)(H8 + (size_t)ta * D_MODEL + k0) = pk4_i8(ha.x * inva, ha.y * inva, ha.z * inva, ha.w * inva); *(unsigned*)(H8 + (size_t)(ta + 1) * D_MODEL + k0) = pk4_i8(hb.x * invb, hb.y * invb, hb.z * invb, hb.w * invb);
#pragma unroll
                for (int j = 0; j < 8; ++j) { const f32x4 w = *(const LAS f32x4*)(WF + j * 2048 + k0);
                    aa[j] += ha.x * w[0] + ha.y * w[1] + ha.z * w[2] + ha.w * w[3]; ab[j] += hb.x * w[0] + hb.y * w[1] + hb.z * w[2] + hb.w * w[3]; }
            }
#pragma unroll
            for (int j = 0; j < 8; ++j) { aa[j] = wave_sum(aa[j]); ab[j] = wave_sum(ab[j]); }
            float ma = aa[0], mb = ab[0];
#pragma unroll
            for (int j = 1; j < 8; ++j) { ma = (lane == j) ? aa[j] : ma; mb = (lane == j) ? ab[j] : mb; }
            if (lane < 8) { const float fb = p.f_bias[lane]; FLs[lt * 8 + lane] = log_sigmoidf_(ma + fb); FLs[(lt + 1) * 8 + lane] = log_sigmoidf_(mb + fb); }
        }
        __syncthreads();
        if (F.tid < 8) { float c = 0.f; for (int tt = 0; tt < 128; ++tt) { c += FLs[tt * 8 + F.tid]; FLs[tt * 8 + F.tid] = c; } BT[blk * 8 + F.tid] = c; }
        __syncthreads();
        for (int e = F.tid; e < 1024; e += NWAVES * 64) C[(size_t)blk * 1024 + e] = FLs[e];
        __syncthreads();
    }
}
__device__ __forceinline__ void p1_fix_c(const Frame& F0, const P& p) { const Frame F = phase_frame(F0);
    float* C = (float*)(p.ws + OFF_C); const float* BT = (const float*)(p.ws + OFF_BT);
    for (int blk = F.vcu; blk < T / 128; blk += F.G) {
        const int j = F.tid & 7, b0 = (blk / 64) * 64; float off = 0.f;
        for (int w = b0; w < blk; ++w) off += BT[w * 8 + j];
        for (int e = F.tid; e < 1024; e += NWAVES * 64) C[(size_t)blk * 1024 + e] += off;
    }
}
struct EpiIn1 {
    static constexpr bool PERM = true;
    unsigned char* ws; const float* lb_logits; LAS float* NS; const float* fq_norm; const float* fk_norm;
    __device__ __forceinline__ void operator()(const f32x4 (&acc)[2][2][4][2], const pg8::Unit& u, int wr, int wc, int fr, int fq) const {
        const int pn = u.e; int seg, colt;
        if (pn < 28) { seg = pn >> 2; colt = (pn & 3) * 256; } else if (pn < 36) { seg = 7; colt = (pn - 28) * 256; } else { seg = 8; colt = (pn - 36) * 256; }
        const int ldc = seg < 7 ? 1024 : 2048;
        bf16_t* base = (bf16_t*)(ws + (seg < 7 ? OFF_HQ + (size_t)seg * 64 * MiB : OFF_GA + (size_t)(seg - 7) * 128 * MiB));
        const int row0 = u.pm * 256 + wr * 64 + fr, col0 = colt + wc * 32 + 8 * fq;
        const int mode = (seg == 0) ? 0 : (seg == 1) ? 1 : (seg == 3) ? 3 : (seg >= 7) ? 4 : 2;
        if (seg == 4 || seg == 5) {
            const float* gn = (seg == 4) ? fq_norm : fk_norm; const float gs = (seg == 4) ? 0.08838834764831845f : 1.f;
#pragma unroll
            for (int ai = 0; ai < 2; ++ai)
#pragma unroll
                for (int m = 0; m < 4; ++m)
#pragma unroll
                    for (int bj = 0; bj < 2; ++bj) { const f32x4 a = acc[ai][bj][m][0], b = acc[ai][bj][m][1];
                        float q = a[0] * a[0] + a[1] * a[1] + a[2] * a[2] + a[3] * a[3] + b[0] * b[0] + b[1] * b[1] + b[2] * b[2] + b[3] * b[3];
                        q += __shfl_xor(q, 16); q += __shfl_xor(q, 32);
                        if (fq == 0) NS[(ai * 128 + wr * 64 + m * 16 + fr) * 8 + bj * 4 + wc] = q; }
            asm volatile("s_waitcnt lgkmcnt(0)" ::: "memory");
            __builtin_amdgcn_s_barrier();
            const f32x4 g0 = *(const f32x4*)(gn + 32 * wc + 8 * fq) * gs, g1 = *(const f32x4*)(gn + 32 * wc + 8 * fq + 4) * gs;
#pragma unroll
            for (int ai = 0; ai < 2; ++ai)
#pragma unroll
                for (int m = 0; m < 4; ++m) { bf16_t* rowp = base + (size_t)(row0 + ai * 128 + m * 16) * ldc + col0;
#pragma unroll
                    for (int bj = 0; bj < 2; ++bj) { const f32x4 t = *(const LAS f32x4*)(NS + (ai * 128 + wr * 64 + m * 16 + fr) * 8 + bj * 4);
                        const float rs = rsqrtf((t[0] + t[1] + t[2] + t[3]) * (1.f / 128.f) + EPS);
                        const f32x4 v0 = acc[ai][bj][m][0] * rs * g0, v1 = acc[ai][bj][m][1] * rs * g1;
                        u32x4 w; w.x = cvt_pk_bf16(v0[0], v0[1]); w.y = cvt_pk_bf16(v0[2], v0[3]); w.z = cvt_pk_bf16(v1[0], v1[1]); w.w = cvt_pk_bf16(v1[2], v1[3]);
                        *(u32x4*)(rowp + bj * 128) = w; } }
            return;
        }
        f32x4 lbv[2][2];
        if (mode == 1) {
#pragma unroll
            for (int bj = 0; bj < 2; ++bj)
#pragma unroll
                for (int n = 0; n < 2; ++n) { const int cc = col0 + bj * 128 + 4 * n; const f32x4 l0 = *(const f32x4*)(lb_logits + cc), l1 = *(const f32x4*)(lb_logits + 1024 + cc);
#pragma unroll
                    for (int j = 0; j < 4; ++j) lbv[bj][n][j] = __builtin_amdgcn_rcpf(1.f + __expf(l1[j] - l0[j])); }
        }
#pragma unroll
        for (int ai = 0; ai < 2; ++ai)
#pragma unroll
            for (int m = 0; m < 4; ++m) { bf16_t* rowp = base + (size_t)(row0 + ai * 128 + m * 16) * ldc + col0;
#pragma unroll
                for (int bj = 0; bj < 2; ++bj) { f32x4 v[2] = {acc[ai][bj][m][0], acc[ai][bj][m][1]};
#pragma unroll
                    for (int n = 0; n < 2; ++n)
#pragma unroll
                        for (int j = 0; j < 4; ++j) { float x = v[n][j];
                            if (mode == 0) x = x * fast_sigmoid(x) * 0.08838834764831845f;
                            else if (mode == 1) { const float lb = lbv[bj][n][j]; x = __logf(lb + (1.f - lb) * fast_sigmoid(x)); }
                            else if (mode == 3) x = x * fast_sigmoid(x);
                            else if (mode == 4) x = fast_sigmoid(x);
                            v[n][j] = x; }
                    u32x4 w; w.x = cvt_pk_bf16(v[0][0], v[0][1]); w.y = cvt_pk_bf16(v[0][2], v[0][3]); w.z = cvt_pk_bf16(v[1][0], v[1][1]); w.w = cvt_pk_bf16(v[1][2], v[1][3]);
                    *(u32x4*)(rowp + bj * 128) = w; } }
    }
};

struct EpiMerge {
    static constexpr bool PERM = true;
    unsigned char* ws;
    __device__ __forceinline__ void operator()(const f32x4 (&acc)[2][2][4][2], const pg8::Unit& u, int wr, int wc, int fr, int fq) const {
        const int row0 = u.pm * 256 + wr * 64 + fr, col0 = u.pn * 256 + wc * 32 + 8 * fq;
        const bf16_t* G = (const bf16_t*)(ws + (u.h ? OFF_GB : OFF_GA)); bf16_t* TMP = (bf16_t*)(ws + OFF_X1); bf16_t* MRG = (bf16_t*)(ws + OFF_MRG);
#pragma unroll
        for (int ai = 0; ai < 2; ++ai)
#pragma unroll
            for (int m = 0; m < 4; ++m) { const size_t ro = (size_t)(row0 + ai * 128 + m * 16) * D_MODEL + col0; float rmx = 0.f;
#pragma unroll
                for (int bj = 0; bj < 2; ++bj) { const u32x4 g = *(const u32x4*)(G + ro + bj * 128);
                    f32x4 v0 = acc[ai][bj][m][0], v1 = acc[ai][bj][m][1];
                    v0[0] *= __uint_as_float(g.x << 16); v0[1] *= __uint_as_float(g.x & 0xffff0000u); v0[2] *= __uint_as_float(g.y << 16); v0[3] *= __uint_as_float(g.y & 0xffff0000u);
                    v1[0] *= __uint_as_float(g.z << 16); v1[1] *= __uint_as_float(g.z & 0xffff0000u); v1[2] *= __uint_as_float(g.w << 16); v1[3] *= __uint_as_float(g.w & 0xffff0000u);
                    if (u.h != 0) { const u32x4 t = *(const u32x4*)(TMP + ro + bj * 128);
                        v0[0] += __uint_as_float(t.x << 16); v0[1] += __uint_as_float(t.x & 0xffff0000u); v0[2] += __uint_as_float(t.y << 16); v0[3] += __uint_as_float(t.y & 0xffff0000u);
                        v1[0] += __uint_as_float(t.z << 16); v1[1] += __uint_as_float(t.z & 0xffff0000u); v1[2] += __uint_as_float(t.w << 16); v1[3] += __uint_as_float(t.w & 0xffff0000u); }
                    u32x4 w; w.x = cvt_pk_bf16(v0[0], v0[1]); w.y = cvt_pk_bf16(v0[2], v0[3]); w.z = cvt_pk_bf16(v1[0], v1[1]); w.w = cvt_pk_bf16(v1[2], v1[3]);
                    *(u32x4*)((u.h ? MRG : TMP) + ro + bj * 128) = w;
                    rmx = fmaxf(fmaxf(rmx, fmaxf(fmaxf(__builtin_fabsf(v0[0]), __builtin_fabsf(v0[1])), fmaxf(__builtin_fabsf(v0[2]), __builtin_fabsf(v0[3])))), fmaxf(fmaxf(__builtin_fabsf(v1[0]), __builtin_fabsf(v1[1])), fmaxf(__builtin_fabsf(v1[2]), __builtin_fabsf(v1[3])))); }
                if (u.h != 0) {
                    rmx = fmaxf(rmx, __shfl_xor(rmx, 16)); rmx = fmaxf(rmx, __shfl_xor(rmx, 32));
                    if (fq == 0) atomicMax((unsigned*)(ws + WS_CTL) + CW_RMAX + row0 + ai * 128 + m * 16, __float_as_uint(rmx * 1.004f)); } }
    }
};
struct EpiWout1 {
    static constexpr bool PERM = true;
    const float* x; bf16_t* X1;
    __device__ __forceinline__ void operator()(const f32x4 (&acc)[2][2][4][2], const pg8::Unit& u, int wr, int wc, int fr, int fq) const {
        const int row0 = u.pm * 256 + wr * 64 + fr, col0 = u.pn * 256 + wc * 32 + 8 * fq;
#pragma unroll
        for (int ai = 0; ai < 2; ++ai)
#pragma unroll
            for (int m = 0; m < 4; ++m) { const size_t ro = (size_t)(row0 + ai * 128 + m * 16) * D_MODEL + col0;
#pragma unroll
                for (int bj = 0; bj < 2; ++bj) { const f32x4 v0 = *(const f32x4*)(x + ro + bj * 128) + acc[ai][bj][m][0], v1 = *(const f32x4*)(x + ro + bj * 128 + 4) + acc[ai][bj][m][1];
                    u32x4 w; w.x = cvt_pk_bf16(v0[0], v0[1]); w.y = cvt_pk_bf16(v0[2], v0[3]); w.z = cvt_pk_bf16(v1[0], v1[1]); w.w = cvt_pk_bf16(v1[2], v1[3]);
                    *(u32x4*)(X1 + ro + bj * 128) = w; } }
    }
};
struct EpiGU1 {
    static constexpr bool PERM = true;
    const float* b_gu; unsigned char* ACT; const float* ROWRS;
    __device__ __forceinline__ void operator()(const f32x4 (&acc)[2][2][4][2], const pg8::Unit& u, int wr, int wc, int fr, int fq) const {
        const int row0 = u.pm * 256 + wr * 64 + fr, ca = u.pn * 128 + wc * 32 + 8 * fq;
        const float* bg = b_gu + (size_t)u.e * 4096 + ca;
        const f32x4 bg0 = *(const f32x4*)bg, bg1 = *(const f32x4*)(bg + 4), bu0 = *(const f32x4*)(bg + 2048), bu1 = *(const f32x4*)(bg + 2052);
#pragma unroll
        for (int ai = 0; ai < 2; ++ai)
#pragma unroll
            for (int m = 0; m < 4; ++m) {
                const float rs = ROWRS[row0 + ai * 128 + m * 16];
                f32x4 g[2] = {acc[ai][0][m][0] * rs + bg0, acc[ai][0][m][1] * rs + bg1}, up[2] = {acc[ai][1][m][0] * rs + bu0, acc[ai][1][m][1] * rs + bu1}; float o[8];
#pragma unroll
                for (int n = 0; n < 2; ++n)
#pragma unroll
                    for (int j = 0; j < 4; ++j) { const float gg = fminf(g[n][j], 7.f), uu = fminf(fmaxf(up[n][j], -7.f), 7.f); o[n * 4 + j] = (uu + 1.f) * gg * fast_sigmoid(1.702f * gg); }
                u32x2 w; w.x = pk4_fp8(o[0], o[1], o[2], o[3]); w.y = pk4_fp8(o[4], o[5], o[6], o[7]);
                *(u32x2*)(ACT + (size_t)(row0 + ai * 128 + m * 16) * D_MODEL + ca) = w; }
    }
};
constexpr float YR_SCALE = 32.f;
struct EpiDown1 {
    static constexpr bool PERM = true;
    const float* b_down; const float* ROWW; unsigned char* YR;
    __device__ __forceinline__ void operator()(const f32x4 (&acc)[2][2][4][2], const pg8::Unit& u, int wr, int wc, int fr, int fq) const {
        const int row0 = u.pm * 256 + wr * 64 + fr, col0 = u.pn * 256 + wc * 32 + 8 * fq;
        const float* bb = b_down + (size_t)u.e * 2048 + col0;
        f32x4 bv[2][2];
#pragma unroll
        for (int bj = 0; bj < 2; ++bj) { bv[bj][0] = *(const f32x4*)(bb + bj * 128); bv[bj][1] = *(const f32x4*)(bb + bj * 128 + 4); }
#pragma unroll
        for (int ai = 0; ai < 2; ++ai)
#pragma unroll
            for (int m = 0; m < 4; ++m) { const int r = row0 + ai * 128 + m * 16; const float rw = ROWW[r];
#pragma unroll
                for (int bj = 0; bj < 2; ++bj) { f32x4 v0 = (acc[ai][bj][m][0] + bv[bj][0]) * (rw * YR_SCALE), v1 = (acc[ai][bj][m][1] + bv[bj][1]) * (rw * YR_SCALE);
#pragma unroll
                    for (int j = 0; j < 4; ++j) { v0[j] = __builtin_amdgcn_fmed3f(v0[j], -448.f, 448.f); v1[j] = __builtin_amdgcn_fmed3f(v1[j], -448.f, 448.f); }
                    u32x2 w; w.x = pk4_fp8(v0[0], v0[1], v0[2], v0[3]); w.y = pk4_fp8(v1[0], v1[1], v1[2], v1[3]);
                    *(u32x2*)(YR + (size_t)r * D_MODEL + col0 + bj * 128) = w; } }
    }
};
constexpr int TILEE_LDS_OFF = MISC_OFF + 1024;
__device__ __forceinline__ int load_tile_table(const Frame& F0, const P& p) { const Frame F = phase_frame(F0);
    const int* TILEE = (const int*)(p.ws + OFF_TILEE); LAS int* tl = (LAS int*)(F.lds + TILEE_LDS_OFF);
    for (int i = F.tid; i <= NTILES_MAX; i += NWAVES * 64) tl[i] = TILEE[i];
    __syncthreads();
    return tl[NTILES_MAX];
}


typedef short s16x4 __attribute__((ext_vector_type(4)));
__device__ __forceinline__ int img_off(int row, int ch) { return 256 * row + 16 * (ch ^ (((row & 3) << 2) | ((row >> 2) & 3))); }
__device__ __forceinline__ void tr_frag_issue(s16x4& lo, s16x4& hi, LAS unsigned char* img, int r0, int ctile, int lane) {
    const int q = (lane & 15) >> 2, pp = lane & 3;
    lo = __builtin_amdgcn_ds_read_tr16_b64_v4i16((LAS s16x4*)(img + img_off(r0 + q, 2 * ctile + (pp >> 1)) + 8 * (pp & 1)));
    hi = __builtin_amdgcn_ds_read_tr16_b64_v4i16((LAS s16x4*)(img + img_off(r0 + 4 + q, 2 * ctile + (pp >> 1)) + 8 * (pp & 1)));
}
__device__ __forceinline__ bf16x8 frag8(const s16x4& lo, const s16x4& hi) { return (bf16x8){lo[0], lo[1], lo[2], lo[3], hi[0], hi[1], hi[2], hi[3]}; }
__device__ __forceinline__ float clamp80(float x) { return fminf(fmaxf(x, -80.f), 80.f); }
constexpr int HG_V = 0, HG_K = 16384, HG_Q = 32768, HG_QH = 49152, HG_P = 65536, HG_SEG = 73728, HG_RED = 77824;

__device__ __forceinline__ void hgrn_cumsum(const Frame& F, const unsigned (&lf)[8], float (&b0)[8], float (&b1)[8], float& B0, float& B1) {
    LAS float* SEG = (LAS float*)(F.lds + HG_SEG);
    float c0 = 0.f, c1 = 0.f;
#pragma unroll
    for (int r = 0; r < 8; ++r) { c0 += __uint_as_float(lf[r] << 16); c1 += __uint_as_float(lf[r] & 0xffff0000u); b0[r] = c0; b1[r] = c1; }
    *(LAS f32x2*)(SEG + F.wave * 128 + 2 * F.lane) = (f32x2){c0, c1};
    __syncthreads();
    float p0 = 0.f, p1 = 0.f; B0 = 0.f; B1 = 0.f;
#pragma unroll
    for (int j = 0; j < 8; ++j) { const f32x2 s = *(const LAS f32x2*)(SEG + j * 128 + 2 * F.lane); if (j < F.wave) { p0 += s[0]; p1 += s[1]; } B0 += s[0]; B1 += s[1]; }
#pragma unroll
    for (int r = 0; r < 8; ++r) { b0[r] += p0; b1[r] += p1; }
}
__device__ __forceinline__ void hgrn_v_to_lds(const Frame& F, const bf16_t* HV, size_t tok0, int h) {
#pragma unroll
    for (int i = 0; i < 2; ++i) { const int qd = F.tid + 512 * i, row = qd >> 4, ch = qd & 15;
        const u32x4 v = *(const u32x4*)(HV + (tok0 + row) * 1024 + h * 128 + ch * 8);
        *(LAS u32x4*)(F.lds + HG_V + img_off(row, ch)) = v; }
}
__device__ __forceinline__ void p2_hgrn_local(const Frame& F0, const P& p) { const Frame F = phase_frame(F0);
    const bf16_t* LOGF = (const bf16_t*)(p.ws + OFF_LOGF); const bf16_t* HV = (const bf16_t*)(p.ws + OFF_HV);
    bf16_t* SLOC = (bf16_t*)(p.ws + OFF_SLOC); float* DEC = (float*)(p.ws + OFF_DEC);
    const int w = F.wave, lane = F.lane, g = lane >> 4;
    for (int it = F.vcu; it < 4096; it += F.G) {
        const int bh = it >> 7, n = it & 127, b = bh >> 3, h = bh & 7; const size_t tok0 = (size_t)b * SEQ + n * 64;
        const size_t gbase = (tok0 + 8 * w) * 1024 + h * 128 + 2 * lane;
        unsigned lf[8];
#pragma unroll
        for (int r = 0; r < 8; ++r) lf[r] = *(const unsigned*)(LOGF + gbase + (size_t)r * 1024);
        hgrn_v_to_lds(F, HV, tok0, h);
        float b0[8], b1[8], B0, B1;
        hgrn_cumsum(F, lf, b0, b1, B0, B1);
#pragma unroll
        for (int r = 0; r < 8; ++r) { const float l0 = __uint_as_float(lf[r] << 16), l1 = __uint_as_float(lf[r] & 0xffff0000u);
            const float k0 = (1.f - __expf(l0)) * __expf(B0 - b0[r]), k1 = (1.f - __expf(l1)) * __expf(B1 - b1[r]);
            *(LAS unsigned*)(F.lds + HG_K + img_off(8 * w + r, lane >> 2) + (lane & 3) * 4) = cvt_pk_bf16(k0, k1); }
        if (w == 0) *(f32x2*)(DEC + (size_t)it * 128 + 2 * lane) = (f32x2){__expf(B0), __expf(B1)};
        __syncthreads();
        s16x4 al[2], ah[2];
#pragma unroll
        for (int ks = 0; ks < 2; ++ks) tr_frag_issue(al[ks], ah[ks], F.lds + HG_K, 32 * ks + 8 * g, w, lane);
        f32x4 acc[8];
#pragma unroll
        for (int vt = 0; vt < 8; ++vt) {
            s16x4 bl[2], bh2[2];
#pragma unroll
            for (int ks = 0; ks < 2; ++ks) tr_frag_issue(bl[ks], bh2[ks], F.lds + HG_V, 32 * ks + 8 * g, vt, lane);
            acc[vt] = (f32x4){0.f, 0.f, 0.f, 0.f};
#pragma unroll
            for (int ks = 0; ks < 2; ++ks) acc[vt] = __builtin_amdgcn_mfma_f32_16x16x32_bf16(frag8(al[ks], ah[ks]), frag8(bl[ks], bh2[ks]), acc[vt], 0, 0, 0);
        }
#pragma unroll
        for (int vt = 0; vt < 8; ++vt) { u32x2 o; o.x = cvt_pk_bf16(acc[vt][0], acc[vt][1]); o.y = cvt_pk_bf16(acc[vt][2], acc[vt][3]);
            *(u32x2*)(SLOC + (size_t)it * 16384 + (size_t)(16 * vt + (lane & 15)) * 128 + 16 * w + 4 * g) = o; }
        __syncthreads();
    }
}
__device__ __forceinline__ void p3_hgrn_scan(const Frame& F0, const P& p) { const Frame F = phase_frame(F0);
    const bf16_t* SLOC = (const bf16_t*)(p.ws + OFF_SLOC); const float* DEC = (const float*)(p.ws + OFF_DEC); bf16_t* STATE = (bf16_t*)(p.ws + OFF_STATE);
    for (int gid = F.vcu * 512 + F.tid; gid < 32 * 4096; gid += F.G * 512) {
        const int bh = gid >> 12, e = (gid & 4095) * 4, c = e & 127;
        f32x4 st = {0.f, 0.f, 0.f, 0.f};
        for (int n0 = 0; n0 < 128; n0 += 8) {
            u32x2 sl[8]; f32x4 dc[8];
#pragma unroll
            for (int j = 0; j < 8; ++j) { const size_t it = (size_t)bh * 128 + n0 + j; sl[j] = *(const u32x2*)(SLOC + it * 16384 + e); dc[j] = *(const f32x4*)(DEC + it * 128 + c); }
#pragma unroll
            for (int j = 0; j < 8; ++j) { const size_t it = (size_t)bh * 128 + n0 + j;
                u32x2 o; o.x = cvt_pk_bf16(st[0], st[1]); o.y = cvt_pk_bf16(st[2], st[3]); *(u32x2*)(STATE + it * 16384 + e) = o;
                st[0] = dc[j][0] * st[0] + __uint_as_float(sl[j].x << 16); st[1] = dc[j][1] * st[1] + __uint_as_float(sl[j].x & 0xffff0000u);
                st[2] = dc[j][2] * st[2] + __uint_as_float(sl[j].y << 16); st[3] = dc[j][3] * st[3] + __uint_as_float(sl[j].y & 0xffff0000u); }
        }
    }
}
__device__ __forceinline__ void p4_hgrn_out(const Frame& F0, const P& p) { const Frame F = phase_frame(F0);
    const bf16_t* HQ = (const bf16_t*)(p.ws + OFF_HQ); const bf16_t* LOGF = (const bf16_t*)(p.ws + OFF_LOGF); const bf16_t* HV = (const bf16_t*)(p.ws + OFF_HV); const bf16_t* HG = (const bf16_t*)(p.ws + OFF_HG);
    const bf16_t* STATE = (const bf16_t*)(p.ws + OFF_STATE); bf16_t* AOUT = (bf16_t*)(p.ws + OFF_AOUT);
    const int w = F.wave, lane = F.lane, g = lane >> 4, l15 = lane & 15, tt = w & 3, vh = w >> 2;
    LAS float* RED = (LAS float*)(F.lds + HG_RED);
    unsigned* qhead = (unsigned*)(p.ws + WS_CTL) + CW_QH; LAS int* slot = (LAS int*)(F.lds + MISC_OFF + 768);
    if (F.tid == 0) { slot[1] = (int)__hip_atomic_fetch_add(qhead, 1u, __ATOMIC_RELAXED, __HIP_MEMORY_SCOPE_AGENT); slot[2] = (int)__hip_atomic_fetch_add(qhead, 1u, __ATOMIC_RELAXED, __HIP_MEMORY_SCOPE_AGENT); }
    __syncthreads();
    int it = __builtin_amdgcn_readfirstlane(slot[1]), itn = __builtin_amdgcn_readfirstlane(slot[2]), par = 0;
    unsigned lfN[8], qqN[8]; u32x2 hgN[4]; u32x4 vN[2];
#define HGO_PRE(item) do { const int bh_ = (item) >> 7, n_ = (item) & 127, b_ = bh_ >> 3, h_ = bh_ & 7; const size_t tok_ = (size_t)b_ * SEQ + n_ * 64, gb_ = (tok_ + 8 * w) * 1024 + h_ * 128 + 2 * lane; \
        _Pragma("unroll") for (int r = 0; r < 8; ++r) { lfN[r] = *(const unsigned*)(LOGF + gb_ + (size_t)r * 1024); qqN[r] = *(const unsigned*)(HQ + gb_ + (size_t)r * 1024); } \
        _Pragma("unroll") for (int vt = 0; vt < 4; ++vt) hgN[vt] = *(const u32x2*)(HG + (tok_ + 16 * tt + l15) * 1024 + h_ * 128 + 64 * vh + 16 * vt + 4 * g); \
        _Pragma("unroll") for (int i = 0; i < 2; ++i) { const int qd = F.tid + 512 * i, row = qd >> 4, ch = qd & 15; vN[i] = *(const u32x4*)(HV + (tok_ + row) * 1024 + h_ * 128 + ch * 8); } } while (0)
    if (it < 4096) HGO_PRE(it);
    while (it < 4096) {
        if (F.tid == 0) slot[3 + par] = (int)__hip_atomic_fetch_add(qhead, 1u, __ATOMIC_RELAXED, __HIP_MEMORY_SCOPE_AGENT);
        const int bh = it >> 7, n = it & 127, b = bh >> 3, h = bh & 7; const size_t tok0 = (size_t)b * SEQ + n * 64;
        bf16x8 sfr[4][4];
#pragma unroll
        for (int vt = 0; vt < 4; ++vt)
#pragma unroll
            for (int ks = 0; ks < 4; ++ks) sfr[vt][ks] = *(const bf16x8*)(STATE + (size_t)it * 16384 + (size_t)(64 * vh + 16 * vt + l15) * 128 + 32 * ks + 8 * g);
        u32x2 hgv[4]; unsigned lf[8], qq[8];
#pragma unroll
        for (int vt = 0; vt < 4; ++vt) hgv[vt] = hgN[vt];
#pragma unroll
        for (int r = 0; r < 8; ++r) { lf[r] = lfN[r]; qq[r] = qqN[r]; }
#pragma unroll
        for (int i = 0; i < 2; ++i) { const int qd = F.tid + 512 * i, row = qd >> 4, ch = qd & 15; *(LAS u32x4*)(F.lds + HG_V + img_off(row, ch)) = vN[i]; }
        { const int nx = itn < 4096 ? itn : 4095; HGO_PRE(nx); }
        float b0[8], b1[8], B0, B1;
        hgrn_cumsum(F, lf, b0, b1, B0, B1);
        const float r0 = 0.5f * B0, r1 = 0.5f * B1;
#pragma unroll
        for (int r = 0; r < 8; ++r) { const float l0 = __uint_as_float(lf[r] << 16), l1 = __uint_as_float(lf[r] & 0xffff0000u), q0 = __uint_as_float(qq[r] << 16), q1 = __uint_as_float(qq[r] & 0xffff0000u);
            const int off = img_off(8 * w + r, lane >> 2) + (lane & 3) * 4;
            *(LAS unsigned*)(F.lds + HG_Q + off) = cvt_pk_bf16(q0 * __expf(clamp80(b0[r] - r0)), q1 * __expf(clamp80(b1[r] - r1)));
            *(LAS unsigned*)(F.lds + HG_K + off) = cvt_pk_bf16((1.f - __expf(l0)) * __expf(clamp80(r0 - b0[r])), (1.f - __expf(l1)) * __expf(clamp80(r1 - b1[r])));
            *(LAS unsigned*)(F.lds + HG_QH + off) = cvt_pk_bf16(q0 * __expf(b0[r]), q1 * __expf(b1[r])); }
        __syncthreads();
#pragma unroll
        for (int si = 0; si < 2; ++si) { const int st = 2 * vh + si; f32x4 sc = {0.f, 0.f, 0.f, 0.f};
#pragma unroll
            for (int ks = 0; ks < 4; ++ks) { const bf16x8 a = *(const LAS bf16x8*)(F.lds + HG_K + img_off(16 * st + l15, 4 * ks + g)), bq = *(const LAS bf16x8*)(F.lds + HG_Q + img_off(16 * tt + l15, 4 * ks + g));
                sc = __builtin_amdgcn_mfma_f32_16x16x32_bf16(a, bq, sc, 0, 0, 0); }
#pragma unroll
            for (int rg = 0; rg < 4; ++rg) sc[rg] = (16 * st + 4 * g + rg > 16 * tt + l15) ? 0.f : sc[rg];
            const int t = 16 * tt + l15, chunk = 2 * st + (g >> 1);
            u32x2 o; o.x = cvt_pk_bf16(sc[0], sc[1]); o.y = cvt_pk_bf16(sc[2], sc[3]);
            *(LAS u32x2*)(F.lds + HG_P + t * 128 + ((chunk ^ (t & 7)) * 16) + 8 * (g & 1)) = o; }
        __syncthreads();
        bf16x8 pb[2], qb[4];
        { const int t = 16 * tt + l15;
#pragma unroll
          for (int ks = 0; ks < 2; ++ks) pb[ks] = *(const LAS bf16x8*)(F.lds + HG_P + t * 128 + (((4 * ks + g) ^ (t & 7)) * 16));
#pragma unroll
          for (int ks = 0; ks < 4; ++ks) qb[ks] = *(const LAS bf16x8*)(F.lds + HG_QH + img_off(t, 4 * ks + g)); }
        f32x4 oacc[4]; float ssq = 0.f;
#pragma unroll
        for (int vt = 0; vt < 4; ++vt) {
            s16x4 vl[2], vhh[2];
#pragma unroll
            for (int ks = 0; ks < 2; ++ks) tr_frag_issue(vl[ks], vhh[ks], F.lds + HG_V, 32 * ks + 8 * g, 4 * vh + vt, lane);
            f32x4 a = {0.f, 0.f, 0.f, 0.f};
#pragma unroll
            for (int ks = 0; ks < 2; ++ks) a = __builtin_amdgcn_mfma_f32_16x16x32_bf16(frag8(vl[ks], vhh[ks]), pb[ks], a, 0, 0, 0);
#pragma unroll
            for (int ks = 0; ks < 4; ++ks) a = __builtin_amdgcn_mfma_f32_16x16x32_bf16(sfr[vt][ks], qb[ks], a, 0, 0, 0);
            oacc[vt] = a; ssq += a[0] * a[0] + a[1] * a[1] + a[2] * a[2] + a[3] * a[3];
        }
        ssq += __shfl_xor(ssq, 16); ssq += __shfl_xor(ssq, 32);
        if (g == 0) RED[(16 * tt + l15) * 2 + vh] = ssq;
        __syncthreads();
        { const int t = 16 * tt + l15; const float tot = RED[t * 2] + RED[t * 2 + 1], rs = rsqrtf(tot * (1.f / 128.f) + EPS);
#pragma unroll
          for (int vt = 0; vt < 4; ++vt) { const int v0 = 64 * vh + 16 * vt + 4 * g; const f32x4 gn = *(const f32x4*)(p.hg_norm + v0);
              const float y0 = oacc[vt][0] * rs * gn[0] * __uint_as_float(hgv[vt].x << 16), y1 = oacc[vt][1] * rs * gn[1] * __uint_as_float(hgv[vt].x & 0xffff0000u);
              const float y2 = oacc[vt][2] * rs * gn[2] * __uint_as_float(hgv[vt].y << 16), y3 = oacc[vt][3] * rs * gn[3] * __uint_as_float(hgv[vt].y & 0xffff0000u);
              u32x2 o; o.x = cvt_pk_bf16(y0, y1); o.y = cvt_pk_bf16(y2, y3);
              *(u32x2*)(AOUT + (tok0 + t) * 1024 + h * 128 + v0) = o; } }
        __syncthreads();
        it = itn; itn = __builtin_amdgcn_readfirstlane(slot[3 + par]); par ^= 1;
    }
#undef HGO_PRE
}

namespace fox {
constexpr int NW = 8, QBLK = 32, KVBLK = 64, QB = NW * QBLK, D = 128, RS = 1024;
constexpr int SHM_V = KVBLK * D * 2, SHM_K = KVBLK * D * 2;
constexpr int OFF_VL = 0, OFF_KL = 2 * SHM_V, OFF_WS = 2 * SHM_V + 2 * SHM_K, OFF_BIAS = OFF_WS + NW * 64 * 4, OFF_ITEM = OFF_BIAS + 2 * 64 * 4;
constexpr float THR = 8.f;
typedef float f32x16 __attribute__((ext_vector_type(16)));
#define KSWZ(row, colB) ((row) * 256 + ((colB) ^ (((row) & 7) << 4)))
#define SBAR() __builtin_amdgcn_sched_barrier(0)
__device__ __forceinline__ int v_st(int k, int c) { const int kk = (k & ~0xC) | ((k & 4) << 1) | ((k & 8) >> 1); return ((kk >> 3) * 4 + (c >> 5)) * 512 + ((kk & 7) * 32 + (c & 31)) * 2; }
__device__ __forceinline__ int v_rd_base(int lane) { return ((lane & 3) << 3) | (((lane >> 2) & 3) << 6) | (((lane >> 4) & 1) << 5) | (((lane >> 5) & 1) << 8); }
constexpr int v_rd_off(int d0, int ks, int half) { return d0 * 512 + ks * 4096 + half * 2048; }
__device__ __forceinline__ int crow(int r, int hi) { return (r & 3) + 8 * (r >> 2) + 4 * hi; }
__device__ __forceinline__ void mask_tile(f32x16& p0, f32x16& p1, int dq) {
    const float NEG = -__builtin_inff();
#pragma unroll
    for (int r = 0; r < 16; ++r) { const int c = (r & 3) + 8 * (r >> 2); if (dq - c < 0) p0[r] = NEG; if (dq - c - 32 < 0) p1[r] = NEG; }
}
__device__ __forceinline__ void partialSM(f32x16& p0, f32x16& p1, float& m_reg, float& mn, float& alpha) {
    float pmax = p0[0];
#pragma unroll
    for (int r = 1; r < 16; ++r) pmax = fmaxf(pmax, p0[r]);
#pragma unroll
    for (int r = 0; r < 16; ++r) pmax = fmaxf(pmax, p1[r]);
    { auto rr = __builtin_amdgcn_permlane32_swap(__float_as_uint(pmax), __float_as_uint(pmax), false, false); pmax = fmaxf(__uint_as_float(rr[0]), __uint_as_float(rr[1])); }
    constexpr float C2 = 1.4426950408889634f;
    if (__builtin_expect(__all((pmax - m_reg) <= THR), 1)) { mn = m_reg; alpha = 1.f; }
    else { mn = fmaxf(m_reg, pmax); alpha = __builtin_amdgcn_exp2f((m_reg - mn) * C2); m_reg = mn; }
    const float mnL = -mn * C2;
#pragma unroll
    for (int r = 0; r < 16; ++r) p0[r] = fmaf(p0[r], C2, mnL);
#pragma unroll
    for (int r = 0; r < 16; ++r) p1[r] = fmaf(p1[r], C2, mnL);
#pragma unroll
    for (int r = 0; r < 16; ++r) p0[r] = __builtin_amdgcn_exp2f(p0[r]);
}
__device__ __forceinline__ void finishSM(f32x16& p0, f32x16& p1, float alpha, float& l_reg, bf16x8& pa0, bf16x8& pa1, bf16x8& pa2, bf16x8& pa3) {
#pragma unroll
    for (int r = 0; r < 16; ++r) p1[r] = __builtin_amdgcn_exp2f(p1[r]);
    float ps = 0;
#pragma unroll
    for (int r = 0; r < 16; ++r) ps += p0[r];
#pragma unroll
    for (int r = 0; r < 16; ++r) ps += p1[r];
    { auto rr = __builtin_amdgcn_permlane32_swap(__float_as_uint(ps), __float_as_uint(ps), false, false); ps = __uint_as_float(rr[0]) + __uint_as_float(rr[1]); }
    l_reg = l_reg * alpha + ps;
#define PK4(P, B_, OUT) do { unsigned a0 = cvt_pk_bf16(P[B_+0], P[B_+1]), a1 = cvt_pk_bf16(P[B_+2], P[B_+3]); unsigned b0 = cvt_pk_bf16(P[B_+4], P[B_+5]), b1 = cvt_pk_bf16(P[B_+6], P[B_+7]); \
        auto r0 = __builtin_amdgcn_permlane32_swap(a0, b0, false, false); auto r1 = __builtin_amdgcn_permlane32_swap(a1, b1, false, false); \
        u32x4 w = {r0[0], r1[0], r0[1], r1[1]}; OUT = *reinterpret_cast<bf16x8*>(&w); } while (0)
    PK4(p0, 0, pa0); PK4(p0, 8, pa1); PK4(p1, 0, pa2); PK4(p1, 8, pa3);
#undef PK4
}
template <int KB>
__device__ __forceinline__ void qkt(f32x16& p0, f32x16& p1, const LAS char* lds, int r32, int hi, const bf16x8* qr) {
    const LAS float* bb = (const LAS float*)(lds + OFF_BIAS) + KB * 64 + 4 * hi;
#pragma unroll
    for (int j = 0; j < 4; ++j) { const f32x4 a = *(const LAS f32x4*)(bb + 8 * j), b = *(const LAS f32x4*)(bb + 32 + 8 * j);
        p0[4 * j] = a[0]; p0[4 * j + 1] = a[1]; p0[4 * j + 2] = a[2]; p0[4 * j + 3] = a[3]; p1[4 * j] = b[0]; p1[4 * j + 1] = b[1]; p1[4 * j + 2] = b[2]; p1[4 * j + 3] = b[3]; }
    const LAS char* kb[4];
#pragma unroll
    for (int dd = 0; dd < 4; ++dd) kb[dd] = lds + OFF_KL + KB * SHM_K + KSWZ(r32, (dd * 16 + hi * 8) * 2);
#pragma unroll
    for (int d0 = 0; d0 < 8; ++d0) { const LAS char* a = kb[d0 & 3] + (d0 >> 2) * 128;
        const bf16x8 b0 = *reinterpret_cast<const LAS bf16x8*>(a), b1 = *reinterpret_cast<const LAS bf16x8*>(a + 32 * 256);
        p0 = __builtin_amdgcn_mfma_f32_32x32x16_bf16(b0, qr[d0], p0, 0, 0, 0);
        p1 = __builtin_amdgcn_mfma_f32_32x32x16_bf16(b1, qr[d0], p1, 0, 0, 0); }
}
template <int VB>
__device__ __forceinline__ void pv_tile(f32x16* o, const LAS char* vb0, bf16x8 pa0, bf16x8 pa1, bf16x8 pa2, bf16x8 pa3) {
#define TRR(off) __builtin_amdgcn_ds_read_tr16_b64_v4i16((LAS s16x4*)(vb0 + (off)))
#define PV_D0(d0) do { constexpr int b_ = VB * SHM_V + v_rd_off(d0, 0, 0); \
        const s16x4 l0 = TRR(b_), h0 = TRR(b_ + 2048), l1 = TRR(b_ + 4096), h1 = TRR(b_ + 6144), l2 = TRR(b_ + 8192), h2 = TRR(b_ + 10240), l3 = TRR(b_ + 12288), h3 = TRR(b_ + 14336); \
        o[d0] = __builtin_amdgcn_mfma_f32_32x32x16_bf16(pa0, (bf16x8){l0[0], l0[1], l0[2], l0[3], h0[0], h0[1], h0[2], h0[3]}, o[d0], 0, 0, 0); \
        o[d0] = __builtin_amdgcn_mfma_f32_32x32x16_bf16(pa1, (bf16x8){l1[0], l1[1], l1[2], l1[3], h1[0], h1[1], h1[2], h1[3]}, o[d0], 0, 0, 0); \
        o[d0] = __builtin_amdgcn_mfma_f32_32x32x16_bf16(pa2, (bf16x8){l2[0], l2[1], l2[2], l2[3], h2[0], h2[1], h2[2], h2[3]}, o[d0], 0, 0, 0); \
        o[d0] = __builtin_amdgcn_mfma_f32_32x32x16_bf16(pa3, (bf16x8){l3[0], l3[1], l3[2], l3[3], h3[0], h3[1], h3[2], h3[3]}, o[d0], 0, 0, 0); } while (0)
    PV_D0(0); PV_D0(1); PV_D0(2); PV_D0(3);
#undef PV_D0
#undef TRR
}
struct BlockRef { const bf16_t* Q; const bf16_t* K; const bf16_t* V; bf16_t* O; const float* Cp; int P0, jlo; float cref; };
struct Seam { bf16x8 qr[8]; bf16x8 st_v0, st_v1, st_k0, st_k1; float sb0, sb1; };
#define ROW(p, k0, rr) ((p) + (size_t)((k0) + (rr)) * RS + sc)
#define VMW() asm volatile("s_waitcnt vmcnt(0)" ::: "memory")
#define VMWN(n) asm volatile("s_waitcnt vmcnt(%0)" :: "i"(n) : "memory")
#define SLOAD_H(R, k0) do { S.st_v0 = *(const bf16x8*)ROW((R).V, k0, sr); S.st_v1 = *(const bf16x8*)ROW((R).V, k0, 32 + sr); S.st_k0 = *(const bf16x8*)ROW((R).K, k0, sr); S.st_k1 = *(const bf16x8*)ROW((R).K, k0, 32 + sr); \
        S.sb0 = (R).Cp[(size_t)((k0) + sr) * 8]; S.sb1 = (R).Cp[(size_t)((k0) + 32 + sr) * 8]; } while (0)
#define SWRITE_HK(bf, cr) do { *(LAS bf16x8*)(K_lds + (bf) * SHM_K + kws) = S.st_k0; *(LAS bf16x8*)(K_lds + (bf) * SHM_K + kws + 32 * 256) = S.st_k1; \
        if (sc == 0) { BIASL[(bf) * 64 + sr] = (cr) - S.sb0; BIASL[(bf) * 64 + 32 + sr] = (cr) - S.sb1; } } while (0)
#define SWRITE_HV(bf) do { *(LAS bf16x8*)(V_lds + (bf) * SHM_V + vst0) = S.st_v0; *(LAS bf16x8*)(V_lds + (bf) * SHM_V + vst1) = S.st_v1; } while (0)
#define SWRITE_H(bf, cr) do { SWRITE_HV(bf); SWRITE_HK(bf, cr); } while (0)
__device__ __forceinline__ void prime(const BlockRef& cur, LAS char* lds, Seam& S) {
    int tid = threadIdx.x; asm volatile("" : "+v"(tid)); const int wid = __builtin_amdgcn_readfirstlane(tid >> 6), lane = tid & 63, r32 = lane & 31, hi = lane >> 5;
    const int sr = tid >> 4, sc = (tid & 15) * 8, kws = KSWZ(sr, sc * 2); LAS char* K_lds = lds + OFF_KL; LAS float* BIASL = (LAS float*)(lds + OFF_BIAS);
    const int kb0 = cur.jlo * KVBLK;
#pragma unroll
    for (int d0 = 0; d0 < 8; ++d0) S.qr[d0] = *(const bf16x8*)(cur.Q + (size_t)(wid * QBLK + r32) * RS + d0 * 16 + hi * 8);
    SLOAD_H(cur, kb0); VMW(); SWRITE_HK(0, cur.cref);
    __syncthreads();
}
__device__ __forceinline__ void block(const BlockRef& cur, const BlockRef& nxt, LAS char* lds, Seam& S) {
    const int tid = threadIdx.x, wid = __builtin_amdgcn_readfirstlane(tid >> 6), lane = tid & 63, r32 = lane & 31, hi = lane >> 5;
    const int j_lo = cur.jlo, j_hi = (cur.P0 + QB - 1) / KVBLK + 1, NT = j_hi - j_lo;
    const int kbn = nxt.jlo * KVBLK;
    const int qlo = cur.P0 + wid * QBLK, qm = qlo + r32 - 4 * hi;
    LAS char* V_lds = lds + OFF_VL; LAS char* K_lds = lds + OFF_KL; LAS float* BIASL = (LAS float*)(lds + OFF_BIAS);
    LAS float* ws = (LAS float*)(lds + OFF_WS) + wid * 64; LAS float* li_l = ws; LAS float* al_l = ws + 32;
    float m_reg = -1e30f, l_reg = 0; f32x16 o[4] = {};
    const int sr = tid >> 4, sc = (tid & 15) * 8, vst0 = v_st(sr, sc), vst1 = v_st(32 + sr, sc), kws = KSWZ(sr, sc * 2);
    const LAS char* vb0 = V_lds + v_rd_base(lane);
#define RESC(a) do { if (__any((a) < 1.f)) { if (hi == 0) al_l[r32] = (a); asm volatile("s_waitcnt lgkmcnt(0)" ::: "memory"); \
                     for (int d_ = 0; d_ < 4; ++d_) for (int r = 0; r < 16; ++r) o[d_][r] *= al_l[crow(r, hi)]; } } while (0)
#define KBASE(t) ((j_lo + (t)) * KVBLK)
#define MASKT(P0_, P1_, t) do { const int kb_ = KBASE(t); if (kb_ + KVBLK - 1 > qlo) mask_tile(P0_, P1_, qm - kb_); } while (0)
#define SEAM_K0() do { VMWN(8); SWRITE_HK(0, nxt.cref); SBAR(); } while (0)
    f32x16 pA0, pA1, pB0, pB1; float mnA, mnB, alA, alB; bf16x8 pa0, pa1, pa2, pa3;
    SWRITE_HV(0); SBAR();
    if (NT > 1) SLOAD_H(cur, KBASE(1));
    SBAR(); qkt<0>(pA0, pA1, lds, r32, hi, S.qr);
    mask_tile(pA0, pA1, qm - KBASE(0)); partialSM(pA0, pA1, m_reg, mnA, alA);
    if (NT > 1) { VMW(); SWRITE_H(1, cur.cref); }
    __syncthreads();
#define HALF_STEP(PX0, PX1, mnX, alX, PY0, PY1, alY, t, KB, VB, SB) do { \
        SBAR(); qkt<KB>(PX0, PX1, lds, r32, hi, S.qr); \
        finishSM(PY0, PY1, alY, l_reg, pa0, pa1, pa2, pa3); SBAR(); \
        if ((t) + 1 < NT) { SLOAD_H(cur, KBASE((t) + 1)); SBAR(); } \
        pv_tile<VB>(o, vb0, pa0, pa1, pa2, pa3); MASKT(PX0, PX1, (t)); partialSM(PX0, PX1, m_reg, mnX, alX); \
        __syncthreads(); \
        if ((t) + 1 < NT) { VMW(); SWRITE_H(SB, cur.cref); } \
        RESC(alX); __syncthreads(); } while (0)
    for (int t = 1; t + 1 < NT; t += 2) {
        HALF_STEP(pB0, pB1, mnB, alB, pA0, pA1, alA, t, 1, 0, 0);
        HALF_STEP(pA0, pA1, mnA, alA, pB0, pB1, alB, t + 1, 0, 1, 1);
    }
    const bool even = (NT & 1) == 0;
    if (even) { SBAR(); qkt<1>(pB0, pB1, lds, r32, hi, S.qr); SBAR(); }
    SLOAD_H(nxt, kbn); SBAR();
#pragma unroll
    for (int d0 = 0; d0 < 8; ++d0) S.qr[d0] = *(const bf16x8*)(nxt.Q + (size_t)(wid * QBLK + r32) * RS + d0 * 16 + hi * 8);
    SBAR();
    finishSM(pA0, pA1, alA, l_reg, pa0, pa1, pa2, pa3); SBAR();
    pv_tile<0>(o, vb0, pa0, pa1, pa2, pa3);
    if (even) { MASKT(pB0, pB1, NT - 1); partialSM(pB0, pB1, m_reg, mnB, alB); __syncthreads(); RESC(alB);
        finishSM(pB0, pB1, alB, l_reg, pa0, pa1, pa2, pa3); SBAR(); pv_tile<1>(o, vb0, pa0, pa1, pa2, pa3); }
    SBAR(); SEAM_K0();
    if (hi == 0) li_l[r32] = l_reg; asm volatile("s_waitcnt lgkmcnt(0)" ::: "memory");
    const __amdgpu_buffer_rsrc_t orsrc = __builtin_amdgcn_make_buffer_rsrc((void*)(cur.O + (size_t)(wid * QBLK) * RS), 0, QBLK * RS * 2, 0x00020000);
    const int ovoff = (hi * 4 * RS + r32) * 2;
#pragma unroll
    for (int r = 0; r < 16; ++r) { const int orow0 = (r & 3) + 8 * (r >> 2); const float rl = __builtin_amdgcn_rcpf(li_l[orow0 + 4 * hi]);
#pragma unroll
        for (int d0 = 0; d0 < 4; ++d0) { const float v = o[d0][r] * rl; const float vn = __shfl_xor(v, 1);
            if ((r32 & 1) == 0) __builtin_amdgcn_raw_buffer_store_b32(cvt_pk_bf16(v, vn), orsrc, ovoff, orow0 * RS * 2 + d0 * 64, 0); } }
    __syncthreads();
#undef RESC
#undef KBASE
#undef MASKT
#undef SEAM_K0
#undef HALF_STEP
}
#undef ROW
#undef VMW
#undef VMWN
#undef SLOAD_H
#undef SWRITE_HK
#undef SWRITE_HV
#undef SWRITE_H
#undef KSWZ
#undef SBAR
}
constexpr int CW_ATTQ = 64;
__device__ __forceinline__ void p2_jlo(const Frame& F0, const P& p) { const Frame F = phase_frame(F0);
    const float* C = (const float*)(p.ws + OFF_C); int* JLO = (int*)(p.ws + OFF_JLO);
    const int gw = F.vcu * NWAVES + F.wave, NGW = F.G * NWAVES, lane = F.lane;
    const float gq = wave_max(fmaxf(fabsf(p.fq_norm[2 * lane]), fabsf(p.fq_norm[2 * lane + 1]))), gk = wave_max(fmaxf(fabsf(p.fk_norm[2 * lane]), fabsf(p.fk_norm[2 * lane + 1])));
    const float th = -(2.f * 1.02f * gq * gk * 11.3137085f + 104.f);
    for (int e = gw; e < BATCH * HEADS * 32; e += NGW) {
        const int b = e >> 8, h = (e >> 5) & 7, qb = e & 31, P0 = qb * 256;
        const float* Cp = C + (size_t)b * SEQ * 8 + h; const float c0 = Cp[(size_t)P0 * 8];
        int cnt = 0;
#pragma unroll
        for (int i = 0; i < 2; ++i) { const int j = lane + 64 * i, kl = 64 * j + 63; const bool neg = (kl < P0) && (c0 - Cp[(size_t)(kl < SEQ ? kl : 0) * 8] < th); cnt += __popcll(__ballot(neg)); }
        if (lane == 0) JLO[e] = cnt;
    }
}
__device__ __forceinline__ void p4_attention(const Frame& F0, const P& p, int rep) { const Frame F = phase_frame(F0);
    LAS char* lds = (LAS char*)F.lds; LAS int* ITEM = (LAS int*)(lds + fox::OFF_ITEM);
    const bf16_t* FQ = (const bf16_t*)(p.ws + OFF_FQ); const bf16_t* FK = (const bf16_t*)(p.ws + OFF_FK); const bf16_t* FV = (const bf16_t*)(p.ws + OFF_FV); bf16_t* BOUT = (bf16_t*)(p.ws + OFF_BOUT);
    const float* C = (const float*)(p.ws + OFF_C); const int* JLO = (const int*)(p.ws + OFF_JLO);
    unsigned* qhead = (unsigned*)(p.ws + WS_CTL) + CW_ATTQ + 64 * rep;
    constexpr int TOTAL = BATCH * HEADS * 32;
    if (F.tid == 0) { float fb[8]; for (int i = 0; i < 8; ++i) fb[i] = p.f_bias[i];
        for (int r = 0; r < 8; ++r) { int best = 0; for (int i = 1; i < 8; ++i) if (fb[i] > fb[best]) best = i; ITEM[r] = best; fb[best] = -INFINITY; }
        ITEM[8] = (int)__hip_atomic_fetch_add(qhead, 1u, __ATOMIC_RELAXED, __HIP_MEMORY_SCOPE_AGENT); }
    __syncthreads();
    auto mkref = [&](int L) { fox::BlockRef r; const int hr = L >> 7, rr = L & 127, qb = 31 - (rr >> 2), b = rr & 3, h = __builtin_amdgcn_readfirstlane(ITEM[hr]); const size_t t0 = (size_t)b * SEQ;
        r.Q = FQ + (t0 + qb * 256) * 1024 + h * 128; r.K = FK + t0 * 1024 + h * 128; r.V = FV + t0 * 1024 + h * 128; r.O = BOUT + (t0 + qb * 256) * 1024 + h * 128;
        r.Cp = C + t0 * 8 + h; r.P0 = qb * 256; r.jlo = __builtin_amdgcn_readfirstlane(JLO[(b * 8 + h) * 32 + qb]);
        r.cref = __uint_as_float(__builtin_amdgcn_readfirstlane(__float_as_uint(r.Cp[(size_t)(qb * 256 + 255) * 8]))); return r; };
    int L = __builtin_amdgcn_readfirstlane(ITEM[8]);
    if (L >= TOTAL) return;
    if (F.tid == 0) ITEM[9] = (int)__hip_atomic_fetch_add(qhead, 1u, __ATOMIC_RELAXED, __HIP_MEMORY_SCOPE_AGENT);
    __syncthreads();
    int Ln = __builtin_amdgcn_readfirstlane(ITEM[9]);
    fox::BlockRef cur = mkref(L);
    fox::Seam S;
    fox::prime(cur, lds, S);
    for (int it = 0;; ++it) {
        const bool last = Ln >= TOTAL;
        if (!last && F.tid == 0) ITEM[8 + (it & 1)] = (int)__hip_atomic_fetch_add(qhead, 1u, __ATOMIC_RELAXED, __HIP_MEMORY_SCOPE_AGENT);
        const fox::BlockRef nxt = last ? cur : mkref(Ln);
        fox::block(cur, nxt, lds, S);
        if (last) break;
        cur = nxt; L = Ln; Ln = __builtin_amdgcn_readfirstlane(ITEM[8 + (it & 1)]);
    }
}
__device__ __forceinline__ void p2_qknorm(const Frame& F0, const P& p) { const Frame F = phase_frame(F0);
    bf16_t* FQ = (bf16_t*)(p.ws + OFF_FQ); bf16_t* FK = (bf16_t*)(p.ws + OFF_FK);
    const int gw = F.vcu * NWAVES + F.wave, NGW = F.G * NWAVES, lane = F.lane, d0 = (lane & 7) * 16;
    float gq[16], gk[16];
#pragma unroll
    for (int j = 0; j < 16; ++j) { gq[j] = p.fq_norm[d0 + j] * 0.08838834764831845f; gk[j] = p.fk_norm[d0 + j]; }
    for (int t = gw; t < T; t += NGW) {
#pragma unroll
        for (int which = 0; which < 2; ++which) {
            bf16_t* ptr = (which ? FK : FQ) + (size_t)t * 1024 + lane * 16;
            const u32x4 a = *(const u32x4*)ptr, b = *(const u32x4*)(ptr + 8); const unsigned w[8] = {a.x, a.y, a.z, a.w, b.x, b.y, b.z, b.w};
            float v[16]; float ss = 0.f;
#pragma unroll
            for (int j = 0; j < 8; ++j) { v[2 * j] = __uint_as_float(w[j] << 16); v[2 * j + 1] = __uint_as_float(w[j] & 0xffff0000u); ss += v[2 * j] * v[2 * j] + v[2 * j + 1] * v[2 * j + 1]; }
            ss += __shfl_xor(ss, 1); ss += __shfl_xor(ss, 2); ss += __shfl_xor(ss, 4);
            const float rs = rsqrtf(ss * (1.f / 128.f) + EPS);
            unsigned o[8];
#pragma unroll
            for (int j = 0; j < 8; ++j) o[j] = which ? cvt_pk_bf16(v[2 * j] * rs * gk[2 * j], v[2 * j + 1] * rs * gk[2 * j + 1]) : cvt_pk_bf16(v[2 * j] * rs * gq[2 * j], v[2 * j + 1] * rs * gq[2 * j + 1]);
            *(u32x4*)ptr = (u32x4){o[0], o[1], o[2], o[3]}; *(u32x4*)(ptr + 8) = (u32x4){o[4], o[5], o[6], o[7]};
        }
    }
}
__device__ __forceinline__ void p7_router(const Frame& F0, const P& p) { const Frame F = phase_frame(F0);
    LAS int* hist = (LAS int*)(F.lds + MISC_OFF + 512);
    const bf16_t* X1 = (const bf16_t*)(p.ws + OFF_X1B); unsigned char* H2 = p.ws + OFF_H2; const bf16_t* RWT = (const bf16_t*)(p.ws + OFF_RWT); float* RSTD = (float*)(p.ws + OFF_RSTD);
    int* TOPI = (int*)(p.ws + OFF_TOPI); float* GATE = (float*)(p.ws + OFF_GATE); int* CNT = (int*)(p.ws + OFF_CNT);
    const int lane = F.lane, l15 = lane & 15, kg = lane >> 4;
    for (int blk = F.vcu; blk < T / 128; blk += F.G) {
        if (F.tid < NEXP) hist[F.tid] = 0;
        __syncthreads();
        const int tok = blk * 128 + F.wave * 16 + l15;
        const bf16_t* xr = X1 + (size_t)tok * D_MODEL + 8 * kg; unsigned char* hr = H2 + (size_t)tok * D_MODEL + 8 * kg;
        f32x4 acc0 = {0.f, 0.f, 0.f, 0.f}, acc1 = {0.f, 0.f, 0.f, 0.f}; float ss = 0.f;
#pragma unroll 4
        for (int ks = 0; ks < 64; ++ks) {
            const u32x4 xw = *(const u32x4*)(xr + 32 * ks);
            const f32x4 xa = {__uint_as_float(xw.x << 16), __uint_as_float(xw.x & 0xffff0000u), __uint_as_float(xw.y << 16), __uint_as_float(xw.y & 0xffff0000u)}, xb = {__uint_as_float(xw.z << 16), __uint_as_float(xw.z & 0xffff0000u), __uint_as_float(xw.w << 16), __uint_as_float(xw.w & 0xffff0000u)};
            const f32x4 ga = *(const f32x4*)(p.norm2 + 32 * ks + 8 * kg), gb = *(const f32x4*)(p.norm2 + 32 * ks + 8 * kg + 4);
            const bf16x8 bh0 = *(const bf16x8*)(RWT + (size_t)l15 * D_MODEL + 32 * ks + 8 * kg), bh1 = *(const bf16x8*)(RWT + (size_t)(16 + l15) * D_MODEL + 32 * ks + 8 * kg);
            const bf16x8 bl0 = *(const bf16x8*)(RWT + (size_t)(NEXP + l15) * D_MODEL + 32 * ks + 8 * kg), bl1 = *(const bf16x8*)(RWT + (size_t)(NEXP + 16 + l15) * D_MODEL + 32 * ks + 8 * kg);
            ss += xa[0] * xa[0] + xa[1] * xa[1] + xa[2] * xa[2] + xa[3] * xa[3] + xb[0] * xb[0] + xb[1] * xb[1] + xb[2] * xb[2] + xb[3] * xb[3];
            u32x2 h8; h8.x = pk4_fp8(xa[0] * ga[0], xa[1] * ga[1], xa[2] * ga[2], xa[3] * ga[3]); h8.y = pk4_fp8(xb[0] * gb[0], xb[1] * gb[1], xb[2] * gb[2], xb[3] * gb[3]);
            *(u32x2*)(hr + 32 * ks) = h8;
            const bf16x8 ah = __builtin_bit_cast(bf16x8, xw);
            acc0 = __builtin_amdgcn_mfma_f32_16x16x32_bf16(ah, bh0, acc0, 0, 0, 0); acc1 = __builtin_amdgcn_mfma_f32_16x16x32_bf16(ah, bh1, acc1, 0, 0, 0);
            acc0 = __builtin_amdgcn_mfma_f32_16x16x32_bf16(ah, bl0, acc0, 0, 0, 0); acc1 = __builtin_amdgcn_mfma_f32_16x16x32_bf16(ah, bl1, acc1, 0, 0, 0);
        }
        ss += __shfl_xor(ss, 16); ss += __shfl_xor(ss, 32);
        const float rstd = rsqrtf(ss * (1.f / D_MODEL) + EPS);
        if (kg == 0) RSTD[tok] = rstd;
        const float rb0 = p.router_b[l15], rb1 = p.router_b[16 + l15];
        float v0[4], v1[4];
#pragma unroll
        for (int r = 0; r < 4; ++r) { const float rs = __shfl(rstd, 4 * kg + r); v0[r] = acc0[r] * rs + rb0; v1[r] = acc1[r] * rs + rb1; }
        float tv[4][4]; int ti[4][4];
#pragma unroll
        for (int k = 0; k < 4; ++k)
#pragma unroll
            for (int r = 0; r < 4; ++r) {
                float bv = v0[r]; int bi = l15; if (v1[r] > bv) { bv = v1[r]; bi = 16 + l15; }
#pragma unroll
                for (int msk = 1; msk < 16; msk <<= 1) { const float ov = __shfl_xor(bv, msk); const int oi = __shfl_xor(bi, msk); if (ov > bv || (ov == bv && oi < bi)) { bv = ov; bi = oi; } }
                tv[k][r] = bv; ti[k][r] = bi; if (bi == l15) v0[r] = -INFINITY; if (bi == 16 + l15) v1[r] = -INFINITY;
            }
        if (l15 == 0) {
#pragma unroll
            for (int r = 0; r < 4; ++r) { const int t = blk * 128 + F.wave * 16 + 4 * kg + r;
                const float e1 = __expf(tv[1][r] - tv[0][r]), e2 = __expf(tv[2][r] - tv[0][r]), e3 = __expf(tv[3][r] - tv[0][r]), inv = 1.f / (1.f + e1 + e2 + e3);
                *(int4*)(TOPI + (size_t)t * 4) = make_int4(ti[0][r], ti[1][r], ti[2][r], ti[3][r]); *(float4*)(GATE + (size_t)t * 4) = make_float4(inv, e1 * inv, e2 * inv, e3 * inv);
                atomicAdd((int*)&hist[ti[0][r]], 1); atomicAdd((int*)&hist[ti[1][r]], 1); atomicAdd((int*)&hist[ti[2][r]], 1); atomicAdd((int*)&hist[ti[3][r]], 1); }
        }
        __syncthreads();
        if (F.tid < NEXP) CNT[blk * NEXP + F.tid] = hist[F.tid];
        __syncthreads();
    }
}
__device__ __forceinline__ void p8_scatter(const Frame& F0, const P& p) { const Frame F = phase_frame(F0);
    LAS int* base = (LAS int*)(F.lds + 0); LAS int* tot = base + 32; LAS int* segs = base + 64; LAS int* spos = base + 128;
    const int tid = F.tid, lane = F.lane;
    const int* CNT = (const int*)(p.ws + OFF_CNT); const int* TOPI = (const int*)(p.ws + OFF_TOPI); const float* GATE = (const float*)(p.ws + OFF_GATE);
    int* POS = (int*)(p.ws + OFF_POS); float* ROWW = (float*)(p.ws + OFF_ROWW); int* TILEE = (int*)(p.ws + OFF_TILEE);
    int* ROWTOK = (int*)(p.ws + OFF_ROWTOK); float* ROWRS = (float*)(p.ws + OFF_ROWRS); const float* RSTD = (const float*)(p.ws + OFF_RSTD);
    for (int wg = F.vcu; wg < RT_WGS; wg += F.G) {
        { LAS int* redb = base + 1024; LAS int* redt = redb + 512;
          const int e = tid & 31, part = tid >> 5; int before = 0, total = 0;
#pragma unroll
          for (int j = 0; j < 16; ++j) { const int w = part * 16 + j; const int c = CNT[w * NEXP + e]; total += c; before += (w < wg) ? c : 0; }
          redb[tid] = before; redt[tid] = total;
          __syncthreads();
          if (tid < NEXP) { int b2 = 0, t2 = 0;
#pragma unroll
              for (int q = 0; q < 16; ++q) { b2 += redb[q * 32 + tid]; t2 += redt[q * 32 + tid]; }
              base[tid] = b2; tot[tid] = t2; } }
        __syncthreads();
        if (tid == 0) { int s = 0; for (int e = 0; e < NEXP; ++e) { segs[e] = s; s += (tot[e] + 255) & ~255; } segs[NEXP] = s; }
        __syncthreads();
        if (wg == 0) {
            for (int e = 0; e < NEXP; ++e) { const int t0 = segs[e] >> 8, t1 = segs[e + 1] >> 8; for (int tt = t0 + tid; tt < t1; tt += NWAVES * 64) TILEE[tt] = e; }
            if (tid == 0) TILEE[NTILES_MAX] = segs[NEXP] >> 8;
        }
        { LAS int* cw = base + 2048;
          const int f = F.wave * 64 + lane, e = TOPI[(size_t)wg * RT_TOK * 4 + f]; int mycnt = 0, within = 0;
          for (int ex = 0; ex < NEXP; ++ex) { const unsigned long long m = __ballot(e == ex); if (lane == ex) mycnt = __popcll(m); if (e == ex) within = __popcll(m & ((1ull << lane) - 1ull)); }
          if (lane < NEXP) cw[F.wave * NEXP + lane] = mycnt;
          __syncthreads();
          int prev = 0;
          for (int w2 = 0; w2 < F.wave; ++w2) prev += cw[w2 * NEXP + e];
          const int pos = segs[e] + base[e] + prev + within;
          POS[(size_t)wg * RT_TOK * 4 + f] = pos; ROWW[pos] = GATE[(size_t)wg * RT_TOK * 4 + f]; ROWTOK[pos] = wg * RT_TOK + (f >> 2); ROWRS[pos] = RSTD[wg * RT_TOK + (f >> 2)]; }
        __syncthreads();
        if (wg < NEXP) { const int r0 = segs[wg] + tot[wg], r1 = segs[wg + 1]; for (int r = r0 + tid; r < r1; r += NWAVES * 64) { ROWTOK[r] = 0; ROWW[r] = 0.f; ROWRS[r] = 0.f; } }
        __syncthreads();
    }
}
__device__ __forceinline__ void p11_combine(const Frame& F0, const P& p) { const Frame F = phase_frame(F0);
    const bf16_t* X1 = (const bf16_t*)(p.ws + OFF_X1B); const unsigned char* YR = p.ws + OFF_YR; const int* POS = (const int*)(p.ws + OFF_POS);
    const int gw = F.vcu * NWAVES + F.wave, NGW = F.G * NWAVES, lane = F.lane;
    for (int t = gw; t < T; t += NGW) {
        const int4 pos = *(const int4*)(POS + (size_t)t * 4); const int pp[4] = {pos.x, pos.y, pos.z, pos.w};
#pragma unroll
        for (int i = 0; i < 2; ++i) {
            const int c = 16 * (lane + 64 * i);
            const u32x4 xa = *(const u32x4*)(X1 + (size_t)t * D_MODEL + c), xb = *(const u32x4*)(X1 + (size_t)t * D_MODEL + c + 8);
            float s16[16];
#pragma unroll
            for (int j = 0; j < 16; ++j) s16[j] = 0.f;
#pragma unroll
            for (int k = 0; k < 4; ++k) { const u32x4 y = *(const u32x4*)(YR + (size_t)pp[k] * D_MODEL + c); const unsigned yw[4] = {y.x, y.y, y.z, y.w};
#pragma unroll
                for (int d = 0; d < 4; ++d) { const auto lo = __builtin_amdgcn_cvt_pk_f32_fp8((int)yw[d], false), hi = __builtin_amdgcn_cvt_pk_f32_fp8((int)yw[d], true);
                    s16[4 * d + 0] += lo[0]; s16[4 * d + 1] += lo[1]; s16[4 * d + 2] += hi[0]; s16[4 * d + 3] += hi[1]; } }
            const unsigned xw[8] = {xa.x, xa.y, xa.z, xa.w, xb.x, xb.y, xb.z, xb.w};
            constexpr float inv = 1.f / YR_SCALE;
#pragma unroll
            for (int q = 0; q < 4; ++q) { f32x4 o;
                o[0] = __uint_as_float(xw[2 * q] << 16) + s16[4 * q + 0] * inv; o[1] = __uint_as_float(xw[2 * q] & 0xffff0000u) + s16[4 * q + 1] * inv;
                o[2] = __uint_as_float(xw[2 * q + 1] << 16) + s16[4 * q + 2] * inv; o[3] = __uint_as_float(xw[2 * q + 1] & 0xffff0000u) + s16[4 * q + 3] * inv;
                *(f32x4*)(p.out + (size_t)t * D_MODEL + c + 4 * q) = o; }
        }
    }
}

__device__ __forceinline__ void p6_quant(const Frame& F0, const P& p) { const Frame F = phase_frame(F0);
    const bf16_t* MRG = (const bf16_t*)(p.ws + OFF_MRG); unsigned char* Q = p.ws + OFF_H8; float* HSC = (float*)(p.ws + OFF_HSC); const unsigned* RMAX = (const unsigned*)(p.ws + WS_CTL) + CW_RMAX;
    const int gw = F.vcu * NWAVES + F.wave, NGW = F.G * NWAVES, lane = F.lane;
    for (int t = gw; t < T; t += NGW) {
        const float mx = fmaxf(__uint_as_float(RMAX[t]), 1e-30f), inv = 127.f / mx;
        const bf16_t* src = MRG + (size_t)t * D_MODEL + 32 * lane; u32x4 in[4];
#pragma unroll
        for (int i = 0; i < 4; ++i) in[i] = *(const u32x4*)(src + 8 * i);
        u32x4 o[2];
#pragma unroll
        for (int i = 0; i < 4; ++i) { const unsigned w[4] = {in[i].x, in[i].y, in[i].z, in[i].w};
            const unsigned a = pk4_i8(__uint_as_float(w[0] << 16) * inv, __uint_as_float(w[0] & 0xffff0000u) * inv, __uint_as_float(w[1] << 16) * inv, __uint_as_float(w[1] & 0xffff0000u) * inv);
            const unsigned b = pk4_i8(__uint_as_float(w[2] << 16) * inv, __uint_as_float(w[2] & 0xffff0000u) * inv, __uint_as_float(w[3] << 16) * inv, __uint_as_float(w[3] & 0xffff0000u) * inv);
            if (i & 1) { o[i >> 1].z = a; o[i >> 1].w = b; } else { o[i >> 1].x = a; o[i >> 1].y = b; } }
        *(u32x4*)(Q + (size_t)t * D_MODEL + 32 * lane) = o[0]; *(u32x4*)(Q + (size_t)t * D_MODEL + 32 * lane + 16) = o[1];
        if (lane == 0) HSC[t] = mx * (1.f / 127.f);
    }
}
struct Args { P p; int ph_lo, ph_hi, li, pad; };
__global__ void __launch_bounds__(NWAVES * 64, 2) mk_fwd(Args args) {
    extern __shared__ __attribute__((aligned(16))) unsigned char lds_raw[];
    Frame F; F.lds = (LAS unsigned char*)lds_raw; F.MISC = (volatile LAS unsigned*)(F.lds + MISC_OFF);
    F.tid = threadIdx.x; F.lane = F.tid & 63; F.wave = __builtin_amdgcn_readfirstlane(F.tid >> 6);
    F.G = gridDim.x; { const int bx = blockIdx.x; F.vcu = (F.G % 8 == 0) ? (bx % 8) * (F.G / 8) + bx / 8 : bx; }
    const P& p = args.p;
    for (int u = F.tid; u < (LDS_BYTES - MISC_OFF) / 4; u += NWAVES * 64) ((LAS unsigned*)(F.lds + MISC_OFF))[u] = 0u;
    __syncthreads();
    XcdBarrier bar = xcd_barrier_post((unsigned*)(p.ws + WS_CTL) + CW_BAR + args.li * XCD_BAR_WORDS, F.MISC + 8);
    const int lo = args.ph_lo, hi = args.ph_hi;
#ifndef DUP_MASK
#define DUP_MASK 0
#endif
#define DUP(k) ((DUP_MASK >> (k)) & 1)
#define IN(k) (lo <= (k) && (k) < hi)
#define BOTH(k) (IN(k) && IN((k) + 1))
    if (IN(0)) { for (int rep = 0; rep <= DUP(0); ++rep) { p0_colmax(F, p); p0_weights(F, p); p0_router_prep(F, p); __syncthreads(); p0_rmsnorm(F, p); __syncthreads(); } if (BOTH(0)) xcd_barrier(bar); }
    if (IN(1)) {
        p1_fix_c(F, p);
        p0_win_i8(F, p);
        xcd_barrier(bar);
        { SchedIn<1> S{T / 256, NF8T, F.G, (int)blockIdx.x, (const char*)(p.ws + OFF_H8), (const char*)(p.ws + OFF_WIN8_T), (size_t)256 * D_MODEL, (const float*)(p.ws + OFF_HSC), (const unsigned*)(p.ws + WS_CTL) + CW_CMAX};
          EpiIn1 E{p.ws, p.lb_logits, (LAS float*)(F.lds + MISC_OFF + 4096), p.fq_norm, p.fk_norm};
          pg8::gemm_phase<EpiIn1, SchedIn<1>, true, false, true>(F.lds, D_MODEL / 2, S, E); }
        if (BOTH(1)) xcd_barrier(bar);
    }
    if (IN(2)) { p2_jlo(F, p); p2_hgrn_local(F, p);     if (BOTH(2)) xcd_barrier(bar); }
    if (IN(3)) { for (int rep = 0; rep <= DUP(3); ++rep) p3_hgrn_scan(F, p); if (BOTH(3)) xcd_barrier(bar); }
    if (IN(4)) { if (((blockIdx.x >> 3) & 3) == 3) convert_queue(F, p); p4_hgrn_out(F, p); __syncthreads(); p4_attention(F, p, 0); __syncthreads(); convert_queue(F, p); if (BOTH(4)) xcd_barrier(bar); }
    if (IN(5)) {
        pg8::SchedMerge S{T / 256, D_MODEL / 256, F.G, (int)blockIdx.x, (const char*)(p.ws + OFF_AOUT), (const char*)(p.ws + OFF_BOUT), (const char*)(p.ws + OFF_WUPA_T), (const char*)(p.ws + OFF_WUPB_T), (size_t)256 * WIDTH * 2};
        EpiMerge E{p.ws};
        for (int rep = 0; rep <= DUP(5); ++rep) pg8::gemm_phase<EpiMerge, pg8::SchedMerge>(F.lds, WIDTH, S, E);
        if (BOTH(5)) xcd_barrier(bar);
    }
    if (IN(6)) {
        p6_quant(F, p);
        xcd_barrier(bar);
        SchedI8 S{T / 256, D_MODEL / 256, F.G, (int)blockIdx.x, (const char*)(p.ws + OFF_H8), (const char*)(p.ws + OFF_WOUT8_T), (size_t)256 * D_MODEL, (const float*)(p.ws + OFF_HSC), (const unsigned*)(p.ws + WS_CTL) + CW_CMAX2};
        EpiWout1 E{p.x, (bf16_t*)(p.ws + OFF_X1B)};
        for (int rep = 0; rep <= DUP(6); ++rep) pg8::gemm_phase<EpiWout1, SchedI8, true, false, true>(F.lds, D_MODEL / 2, S, E);
        if (BOTH(6)) xcd_barrier(bar);
    }
    if (IN(7)) { for (int rep = 0; rep <= DUP(7); ++rep) p7_router(F, p); if (BOTH(7)) xcd_barrier(bar); }
    if (IN(8)) { for (int rep = 0; rep <= DUP(8); ++rep) p8_scatter(F, p); if (BOTH(8)) xcd_barrier(bar); }
    if (IN(9)) {
        const int nT = load_tile_table(F, p);
        pg8::SchedMoe S{nT, 4096 / 256, F.G, (int)blockIdx.x, (const char*)(p.ws + OFF_H2), (const char*)(p.ws + OFF_WGU_T), (size_t)256 * D_MODEL, (size_t)4096 * D_MODEL, (const LAS int*)(F.lds + TILEE_LDS_OFF), true};
        EpiGU1 E{p.b_gu, p.ws + OFF_ACT, (const float*)(p.ws + OFF_ROWRS)};
        for (int rep = 0; rep <= DUP(9); ++rep) pg8::gemm_phase<EpiGU1, pg8::SchedMoe, true, true>(F.lds, D_MODEL / 2, S, E, (const int*)(p.ws + OFF_ROWTOK));
        if (BOTH(9)) xcd_barrier(bar);
    }
    if (IN(10)) {
        const int nT = load_tile_table(F, p);
        pg8::SchedMoe S{nT, D_MODEL / 256, F.G, (int)blockIdx.x, (const char*)(p.ws + OFF_ACT), (const char*)(p.ws + OFF_WDN_T), (size_t)256 * D_MODEL, (size_t)D_MODEL * D_MODEL, (const LAS int*)(F.lds + TILEE_LDS_OFF), false};
        EpiDown1 E{p.b_down, (const float*)(p.ws + OFF_ROWW), p.ws + OFF_YR};
        for (int rep = 0; rep <= DUP(10); ++rep) pg8::gemm_phase<EpiDown1, pg8::SchedMoe, true>(F.lds, D_MODEL / 2, S, E);
        if (BOTH(10)) xcd_barrier(bar);
    }
    if (IN(11)) { for (int rep = 0; rep <= DUP(11); ++rep) p11_combine(F, p); }
#undef IN
#undef BOTH
}
extern "C" void kernel_launch(void* const* d_in, const int* in_sizes, int n_in, void* d_out, int out_size, void* d_ws, size_t ws_size, hipStream_t stream) {
    static int grid = 0;
    if (grid == 0) {
        if (n_in != 18 || out_size != T * D_MODEL || ws_size < WS_END3) { fprintf(stderr, "kernel_launch: unexpected shapes (n_in %d out %d ws %zu need %zu)\n", n_in, out_size, ws_size, (size_t)WS_END3); grid = -1; return; }
        int dev = 0, cus = 0, per_cu = 0;
        if (hipGetDevice(&dev) != hipSuccess || hipDeviceGetAttribute(&cus, hipDeviceAttributeMultiprocessorCount, dev) != hipSuccess) { grid = -1; return; }
        if (hipFuncSetAttribute((const void*)mk_fwd, hipFuncAttributeMaxDynamicSharedMemorySize, LDS_BYTES) != hipSuccess) { fprintf(stderr, "kernel_launch: hipFuncSetAttribute failed\n"); grid = -1; return; }
        if (hipOccupancyMaxActiveBlocksPerMultiprocessor(&per_cu, (const void*)mk_fwd, NWAVES * 64, LDS_BYTES) != hipSuccess || per_cu < 1) fprintf(stderr, "kernel_launch: occupancy query says %d\n", per_cu);
        (void)hipGetLastError();
        grid = cus;
    }
    if (grid < 0) return;
    P p{};
    p.x = (const float*)d_in[0]; p.lb_logits = (const float*)d_in[1]; p.norm1 = (const float*)d_in[2]; p.w_in = (const float*)d_in[3]; p.hg_norm = (const float*)d_in[4];
    p.fq_norm = (const float*)d_in[5]; p.fk_norm = (const float*)d_in[6]; p.f_bias = (const float*)d_in[7]; p.w_up_hg = (const float*)d_in[8]; p.w_up_fox = (const float*)d_in[9];
    p.w_out = (const float*)d_in[10]; p.norm2 = (const float*)d_in[11]; p.router_w = (const float*)d_in[12]; p.router_b = (const float*)d_in[13]; p.w_gu = (const float*)d_in[14];
    p.b_gu = (const float*)d_in[15]; p.w_down = (const float*)d_in[16]; p.b_down = (const float*)d_in[17]; p.out = (float*)d_out; p.ws = (unsigned char*)d_ws;
    unsigned char* ws = p.ws;
    (void)hipMemsetAsync(ws + WS_CTL, 0, CTL_ZERO_BYTES, stream);
    Args a{}; a.p = p; a.ph_lo = 0; a.ph_hi = 12; a.li = 0; a.pad = 0;
    hipLaunchKernelGGL(mk_fwd, dim3(grid), dim3(NWAVES * 64), LDS_BYTES, stream, a);
}
```

```cpp
#define DUP_MASK 0
#include <hip/hip_runtime.h>
#include <cstdio>
#include <cstdint>

constexpr int D_MODEL = 2048, BATCH = 4, SEQ = 8192, T = BATCH * SEQ;
constexpr int HEADS = 8, HD = 128, WIDTH = 1024;
constexpr int IN_COLS = 11272, NEXP = 32, TOPK = 4, TK = T * TOPK;
constexpr int NROWS_MAX = TK + NEXP * 256;
constexpr int NTILES_MAX = NROWS_MAX / 256;
constexpr float EPS = 1e-6f;
constexpr int RT_TOK = 128, RT_WGS = T / RT_TOK;

typedef unsigned short bf16_t;
__device__ __forceinline__ float bf2f(bf16_t b) { return __uint_as_float(((unsigned)b) << 16); }
__device__ __forceinline__ bf16_t f2bf(float f) { unsigned u = __float_as_uint(f); u += 0x7fffu + ((u >> 16) & 1u); return (bf16_t)(u >> 16); }
__device__ __forceinline__ float wave_sum(float v) {
#pragma unroll
    for (int o = 1; o < 64; o <<= 1) v += __shfl_xor(v, o);
    return v;
}
__device__ __forceinline__ float wave_max(float v) {
#pragma unroll
    for (int o = 1; o < 64; o <<= 1) v = fmaxf(v, __shfl_xor(v, o));
    return v;
}
__device__ __forceinline__ float sigmoidf_(float x) { return 1.f / (1.f + __expf(-x)); }
__device__ __forceinline__ float siluf_(float x) { return x * sigmoidf_(x); }
__device__ __forceinline__ float log_sigmoidf_(float z) { return fminf(z, 0.f) - log1pf(__expf(-fabsf(z))); }

constexpr size_t MiB = 1u << 20;
constexpr size_t WS_CTL = 0;
constexpr size_t WS_SMALL = 1 * MiB;
constexpr size_t OFF_C = WS_SMALL;
constexpr size_t OFF_FL = OFF_C + 1 * MiB;
constexpr size_t OFF_TOPI = OFF_FL + 1 * MiB;
constexpr size_t OFF_GATE = OFF_TOPI + MiB / 2;
constexpr size_t OFF_POS = OFF_GATE + MiB / 2;
constexpr size_t OFF_ROWW = OFF_POS + MiB / 2;
constexpr size_t OFF_CNT = OFF_ROWW + 1 * MiB;
constexpr size_t OFF_TILEE = OFF_CNT + 64 * 1024;
constexpr size_t WS_BIG = 8 * MiB;
constexpr size_t OFF_X1 = WS_BIG;
constexpr size_t OFF_H2 = OFF_X1 + 256 * MiB;
constexpr size_t OFF_YR = OFF_H2 + 128 * MiB;
constexpr size_t OFF_A = OFF_YR + 544 * MiB;
constexpr size_t OFF_H = OFF_A;
constexpr size_t OFF_HQ = OFF_H + 128 * MiB;
constexpr size_t OFF_LOGF = OFF_HQ + 64 * MiB;
constexpr size_t OFF_HV = OFF_LOGF + 64 * MiB;
constexpr size_t OFF_HG = OFF_HV + 64 * MiB;
constexpr size_t OFF_FQ = OFF_HG + 64 * MiB;
constexpr size_t OFF_FK = OFF_FQ + 64 * MiB;
constexpr size_t OFF_FV = OFF_FK + 64 * MiB;
constexpr size_t OFF_GA = OFF_FV + 64 * MiB;
constexpr size_t OFF_GB = OFF_GA + 128 * MiB;
constexpr size_t OFF_AOUT = OFF_GB + 128 * MiB;
constexpr size_t OFF_BOUT = OFF_AOUT + 64 * MiB;
constexpr size_t OFF_MRG = OFF_BOUT + 64 * MiB;
constexpr size_t OFF_A_END = OFF_MRG + 128 * MiB;
constexpr size_t OFF_XS = OFF_A;
constexpr size_t OFF_ACT = OFF_XS + 544 * MiB;
constexpr size_t WS_END = (OFF_A_END > OFF_ACT + 544 * MiB) ? OFF_A_END : OFF_ACT + 544 * MiB;

struct P {
    const float *x, *lb_logits, *norm1, *w_in, *hg_norm, *fq_norm, *fk_norm, *f_bias, *w_up_hg, *w_up_fox, *w_out, *norm2, *router_w, *router_b, *w_gu, *b_gu, *w_down, *b_down;
    float* out; unsigned char* ws;
};

#define LAS __attribute__((address_space(3)))
#define GAS __attribute__((address_space(1)))
typedef short bf16x8 __attribute__((ext_vector_type(8)));
typedef float f32x4 __attribute__((ext_vector_type(4)));
typedef float f32x2 __attribute__((ext_vector_type(2)));
typedef unsigned u32x4 __attribute__((ext_vector_type(4)));
typedef unsigned u32x2 __attribute__((ext_vector_type(2)));
#define LDS_WAIT() asm volatile("s_waitcnt lgkmcnt(0)" ::: "memory")
#define VM_WAIT() asm volatile("s_waitcnt vmcnt(0)" ::: "memory")
__device__ __forceinline__ unsigned cvt_pk_bf16(float lo, float hi) { unsigned r; asm volatile("v_cvt_pk_bf16_f32 %0, %1, %2" : "=v"(r) : "v"(lo), "v"(hi)); return r; }
__device__ __forceinline__ float fast_sigmoid(float x) { return __builtin_amdgcn_rcpf(1.f + __builtin_amdgcn_exp2f(-1.4426950408889634f * x)); }

constexpr size_t OFF_WIN_T = OFF_A_END;
constexpr size_t OFF_WUPA_T = OFF_WIN_T + 44 * MiB;
constexpr size_t OFF_WUPB_T = OFF_WUPA_T + 4 * MiB;
constexpr size_t OFF_WOUT_T = OFF_WUPB_T + 4 * MiB;
constexpr size_t OFF_WGU_T = OFF_WOUT_T + 8 * MiB;
constexpr size_t OFF_WDN_T = OFF_WGU_T + 512 * MiB;
constexpr size_t WS_END2 = OFF_WDN_T + 256 * MiB;
constexpr size_t OFF_SLOC = WS_END2;
constexpr size_t OFF_STATE = OFF_SLOC + 128 * MiB;
constexpr size_t OFF_DEC = OFF_STATE + 128 * MiB;
constexpr size_t OFF_H8 = OFF_DEC + 2 * MiB;
constexpr size_t OFF_WIN8_T = OFF_H8 + 64 * MiB;
constexpr size_t OFF_WOUT8_T = OFF_WIN8_T + 24 * MiB;
constexpr size_t WS_END3 = OFF_WIN8_T + 28 * MiB;
constexpr size_t OFF_BT = OFF_TILEE + 4096;
constexpr size_t OFF_JLO = OFF_BT + 8192 + 4096;
constexpr size_t OFF_RWT = 7 * MiB + 128 * 1024;
constexpr size_t OFF_HSC2 = 7 * MiB + 768 * 1024;
constexpr size_t OFF_HSC = 7 * MiB + 640 * 1024;
constexpr int CW_CMAXA = 51200, CW_CMAXB = 53248;
constexpr int CW_CMAX2 = 49152, CW_RMAX = 65536;
constexpr int CW_CMAX = 32768;
constexpr size_t OFF_RSTD = 7 * MiB + 512 * 1024;
constexpr size_t OFF_ROWRS = 6 * MiB + 576 * 1024;
constexpr size_t OFF_ROWTOK = 6 * MiB;
static_assert(OFF_ROWTOK + (size_t)NROWS_MAX * 4 <= OFF_ROWRS && OFF_ROWRS + (size_t)NROWS_MAX * 4 <= OFF_RWT && OFF_RWT + 2 * NEXP * D_MODEL * 2 <= OFF_RSTD && OFF_RSTD + (size_t)T * 4 <= WS_BIG && OFF_JLO + 4096 <= OFF_ROWTOK, "small-table map");
constexpr size_t OFF_X1B = OFF_H;
constexpr int CW_BAR = 4096;
constexpr size_t CTL_ZERO_BYTES = 512 * 1024;

#define XB_TMO      128
#define XB_XCNT(j)  (256  + 64 * (j))
#define XB_XSUB(j)  (1280 + 64 * (j))
#define XB_XGEN(j)  (2304 + 64 * (j))
#define XB_TOP      3328
#define XB_TOPGEN   3392
#define XCD_BAR_WORDS 3456
#define XB_SPIN_CAP (1u << 18)
__device__ __forceinline__ unsigned xb_ld(unsigned* p)              { return __hip_atomic_load(p, __ATOMIC_RELAXED, __HIP_MEMORY_SCOPE_AGENT); }
__device__ __forceinline__ unsigned xb_add(unsigned* p, unsigned v) { return __hip_atomic_fetch_add(p, v, __ATOMIC_RELAXED, __HIP_MEMORY_SCOPE_AGENT); }
__device__ __forceinline__ unsigned xb_xcc_id() { return (unsigned)__builtin_amdgcn_s_getreg((3 << 11) | 20) & 0xFu; }
#define XB_SPIN(cond, bar) do { unsigned _sp = 0; while (cond) { __builtin_amdgcn_s_sleep(1); \
    if ((++_sp & 255u) == 0u) { if (xb_ld(&(bar)[XB_TMO])) break; if (_sp > XB_SPIN_CAP) { atomicAdd(&(bar)[XB_TMO], 1u); break; } } } } while (0)
struct XcdBarrier { unsigned* bar; unsigned x; volatile LAS unsigned* st; };
__device__ __forceinline__ XcdBarrier xcd_barrier_post(unsigned* bar, volatile LAS unsigned* st) {
    XcdBarrier b; b.bar = bar; b.x = xb_xcc_id(); b.st = st;
    if (threadIdx.x == 0) (void)xb_add(&bar[XB_XCNT(b.x)], 1u);
    return b;
}
__device__ __forceinline__ void xcd_barrier_complete(unsigned* bar, unsigned x, unsigned& nloc, unsigned& nx) {
    const unsigned G = gridDim.x * gridDim.y * gridDim.z;
    unsigned sum, cnt, mine, sp = 0u;
    for (;;) {
        sum = 0u; cnt = 0u; mine = 0u;
#pragma unroll
        for (unsigned j = 0; j < 16; ++j) { const unsigned c = xb_ld(&bar[XB_XCNT(j)]); sum += c; cnt += (c > 0u) ? 1u : 0u; mine = (j == x) ? c : mine; }
        if (sum == G) break;
        __builtin_amdgcn_s_sleep(1);
        if ((++sp & 255u) == 0u) { if (xb_ld(&bar[XB_TMO])) break; if (sp > XB_SPIN_CAP) { atomicAdd(&bar[XB_TMO], 1u); break; } }
    }
    nloc = mine > 0u ? mine : 1u; nx = cnt > 0u ? cnt : 1u;
}
__device__ __forceinline__ void xcd_barrier(const XcdBarrier& b) {
    asm volatile("s_waitcnt vmcnt(0)" ::: "memory");
    __syncthreads();
    if (threadIdx.x == 0) {
        unsigned* bar = b.bar;
        __builtin_amdgcn_s_waitcnt(0);
        unsigned nloc = b.st[0], nx = b.st[1];
        if (nloc == 0u) { xcd_barrier_complete(bar, b.x, nloc, nx); b.st[0] = nloc; b.st[1] = nx; }
        const unsigned old = xb_add(&bar[XB_XSUB(b.x)], 1u);
        const unsigned gen = old / nloc;
        if (old + 1u == (gen + 1u) * nloc) {
            __builtin_amdgcn_fence(__ATOMIC_RELEASE, "agent");
            asm volatile("s_waitcnt vmcnt(0)" ::: "memory");
            const unsigned og = xb_add(&bar[XB_TOP], 1u);
            const unsigned tg = og / nx;
            if (og + 1u == (tg + 1u) * nx) xb_add(&bar[XB_TOPGEN], 1u);
            else XB_SPIN(xb_ld(&bar[XB_TOPGEN]) == tg, bar);
            __builtin_amdgcn_fence(__ATOMIC_ACQUIRE, "agent");
            xb_add(&bar[XB_XGEN(b.x)], 1u);
            asm volatile("s_waitcnt vmcnt(0)" ::: "memory");
        } else {
            XB_SPIN(xb_ld(&bar[XB_XGEN(b.x)]) == gen, bar);
            __builtin_amdgcn_fence(__ATOMIC_ACQUIRE, "agent");
            asm volatile("s_waitcnt vmcnt(0)" ::: "memory");
        }
    }
    __syncthreads();
}

namespace pg8 {
constexpr int BM = 256, BK = 64, HALF = 128, HTB = HALF * BK * 2, STAGE_BYTES = 8 * HTB, NXCD = 8, WGM = 8;
__host__ __device__ __forceinline__ int lds_byte(int r, int c) { const int st = (r >> 4) * 2 + (c >> 5), rr = r & 15, cc = c & 31, ob = rr * 64 + cc * 2; return st * 1024 + (ob ^ (((ob >> 9) & 1) << 5)); }
__host__ __device__ __forceinline__ void stage_rc(int b, int& R, int& C) { const int st = b / 1024, sb = b % 1024, swz = sb ^ (((sb >> 9) & 1) << 5); R = (st >> 1) * 16 + swz / 64; C = (st & 1) * 32 + (swz % 64) / 2; }
__host__ __device__ __forceinline__ int perm32(int rho) { const int n = rho >> 4, i = rho & 15; return 8 * (i >> 2) + 4 * n + (i & 3); }
struct Unit { int pm, pn, e, h; };
__device__ __forceinline__ void tile_map(int wgid, int nM, int nN, int& pm, int& pn) {
    const int nwg = nM * nN; { const int q = nwg / NXCD, r = nwg % NXCD, xcd = wgid % NXCD, off = wgid / NXCD; wgid = (xcd < r ? xcd * (q + 1) : r * (q + 1) + (xcd - r) * q) + off; }
    const int nig = WGM * nN, gid = wgid / nig, fm = gid * WGM, gsz = (nM - fm) < WGM ? (nM - fm) : WGM;
    pm = fm + ((wgid % nig) % gsz); pn = (wgid % nig) / gsz;
}
typedef int i32x8 __attribute__((ext_vector_type(8)));
typedef int i32x4 __attribute__((ext_vector_type(4)));
template <class Epi, class Sched, bool FP8 = false, bool GATHER = false, bool I8 = false>
__device__ __forceinline__ void gemm_phase(LAS unsigned char* lds, const int K, const Sched& S, const Epi& E, const int* rowtok = nullptr) {
    int tid = threadIdx.x; asm volatile("" : "+v"(tid));
    const int wid = __builtin_amdgcn_readfirstlane(tid >> 6), lane = tid & 63, wr = wid >> 2, wc = wid & 3, fr = lane & 15, fq = lane >> 4;
    const int nt = K / BK;
    unsigned voffA[2], voffB[2];
#pragma unroll
    for (int i = 0; i < 2; ++i) { int R, C; stage_rc(tid * 16 + i * 8192, R, C); const int Rb = Epi::PERM ? ((R & ~31) + perm32(R & 31)) : R;
        voffA[i] = (unsigned)(R * K + C) * 2u; voffB[i] = (unsigned)(Rb * K + C) * 2u; }
    const size_t kstep = (size_t)(BK * 2);
    const size_t hstep = (size_t)HALF * K * 2;
    const unsigned ldsw = (unsigned)wid * 1024u;
    const int aoff = lds_byte(wr * 64 + fr, fq * 8), boff = lds_byte(wc * 32 + fr, fq * 8);
#define PG8_SA(b, h) (((b) * 2 + (h)) * HTB)
#define PG8_SB(b, h) ((4 + (b) * 2 + (h)) * HTB)
#define PG8_STAGE(bufoff, gbase, voff) do { _Pragma("unroll") for (int _i = 0; _i < 2; ++_i) \
        __builtin_amdgcn_global_load_lds((const unsigned*)((const char*)(gbase) + (voff)[_i]), (LAS unsigned*)(lds + (bufoff) + ldsw + _i * 8192), 16, 0, 0); } while (0)
#define PG8_LDA(dst, b, h) do { _Pragma("unroll") for (int m = 0; m < 4; ++m) { const i32x4 _x = *(const LAS i32x4*)(lds + PG8_SA(b, h) + aoff + m * 2048), _y = *(const LAS i32x4*)(lds + PG8_SA(b, h) + aoff + m * 2048 + 1024); \
        dst[m] = __builtin_shufflevector(_x, _y, 0, 1, 2, 3, 4, 5, 6, 7); } } while (0)
#define PG8_LDB(dst, b, h) do { _Pragma("unroll") for (int n = 0; n < 2; ++n) { const i32x4 _x = *(const LAS i32x4*)(lds + PG8_SB(b, h) + boff + n * 2048), _y = *(const LAS i32x4*)(lds + PG8_SB(b, h) + boff + n * 2048 + 1024); \
        dst[n] = __builtin_shufflevector(_x, _y, 0, 1, 2, 3, 4, 5, 6, 7); } } while (0)
#define PG8_LO(v) __builtin_bit_cast(bf16x8, __builtin_shufflevector(v, v, 0, 1, 2, 3))
#define PG8_HI(v) __builtin_bit_cast(bf16x8, __builtin_shufflevector(v, v, 4, 5, 6, 7))
#define PG8_MMA(ai, bj, At, Bt) do { __builtin_amdgcn_s_setprio(1); if constexpr (I8) { _Pragma("unroll") for (int m = 0; m < 4; ++m) _Pragma("unroll") for (int n = 0; n < 2; ++n) { \
        i32x4 _c = __builtin_bit_cast(i32x4, acc[ai][bj][m][n]); \
        _c = __builtin_amdgcn_mfma_i32_16x16x64_i8(__builtin_shufflevector(Bt[n], Bt[n], 0, 1, 2, 3), __builtin_shufflevector(At[m], At[m], 0, 1, 2, 3), _c, 0, 0, 0); \
        _c = __builtin_amdgcn_mfma_i32_16x16x64_i8(__builtin_shufflevector(Bt[n], Bt[n], 4, 5, 6, 7), __builtin_shufflevector(At[m], At[m], 4, 5, 6, 7), _c, 0, 0, 0); \
        acc[ai][bj][m][n] = __builtin_bit_cast(f32x4, _c); } } else if constexpr (FP8) { _Pragma("unroll") for (int m = 0; m < 4; ++m) _Pragma("unroll") for (int n = 0; n < 2; ++n) \
        asm volatile("v_mfma_scale_f32_16x16x128_f8f6f4 %0, %1, %2, %0, %3, %4 op_sel_hi:[0,0,0]" : "+v"(acc[ai][bj][m][n]) : "v"(Bt[n]), "v"(At[m]), "v"(sc_w), "v"(sc_a)); } else { \
        _Pragma("unroll") for (int m = 0; m < 4; ++m) _Pragma("unroll") for (int n = 0; n < 2; ++n) { \
        acc[ai][bj][m][n] = __builtin_amdgcn_mfma_f32_16x16x32_bf16(PG8_LO(Bt[n]), PG8_LO(At[m]), acc[ai][bj][m][n], 0, 0, 0); \
        acc[ai][bj][m][n] = __builtin_amdgcn_mfma_f32_16x16x32_bf16(PG8_HI(Bt[n]), PG8_HI(At[m]), acc[ai][bj][m][n], 0, 0, 0); } } __builtin_amdgcn_s_setprio(0); } while (0)
#define PG8_WAIT_V(n) asm volatile("s_waitcnt vmcnt(" #n ")" ::: "memory")
#define PG8_WAIT_L(n) asm volatile("s_waitcnt lgkmcnt(" #n ")" ::: "memory")
#define PG8_BAR __builtin_amdgcn_s_barrier()
#define PG8_SCHED __builtin_amdgcn_sched_barrier(0)
    Unit cur, nxt; int ui = 0;
    if (!S.next(0, cur)) return;
    unsigned gA[2][2], gN[2][2], arow[2];
    if constexpr (GATHER) {
#pragma unroll
        for (int i = 0; i < 2; ++i) { int R, C; stage_rc(tid * 16 + i * 8192, R, C); arow[i] = (unsigned)R; voffA[i] = (unsigned)C * 2u; }
#pragma unroll
        for (int h = 0; h < 2; ++h)
#pragma unroll
            for (int i = 0; i < 2; ++i) gA[h][i] = (unsigned)rowtok[cur.pm * 256 + h * 128 + (int)arow[i]] * (unsigned)(K * 2) + voffA[i];
    }
#define PG8_STAGE_A(bufoff, gbase, h, last_) do { if constexpr (GATHER) { if (last_) { _Pragma("unroll") for (int _i = 0; _i < 2; ++_i) \
        __builtin_amdgcn_global_load_lds((const unsigned*)((const char*)(gbase) + gN[h][_i]), (LAS unsigned*)(lds + (bufoff) + ldsw + _i * 8192), 16, 0, 0); } else { _Pragma("unroll") for (int _i = 0; _i < 2; ++_i) \
        __builtin_amdgcn_global_load_lds((const unsigned*)((const char*)(gbase) + gA[h][_i]), (LAS unsigned*)(lds + (bufoff) + ldsw + _i * 8192), 16, 0, 0); } } \
        else { PG8_STAGE(bufoff, (const char*)(gbase) + (h) * hstep, voffA); } } while (0)
    f32x4 acc[2][2][4][2];
#pragma unroll
    for (int a = 0; a < 2; ++a)
#pragma unroll
        for (int b = 0; b < 2; ++b)
#pragma unroll
            for (int m = 0; m < 4; ++m)
#pragma unroll
                for (int n = 0; n < 2; ++n) acc[a][b][m][n] = (f32x4){0.f, 0.f, 0.f, 0.f};
    i32x8 At[4], B0[2], B1[2];
    int sc_w = 121, sc_a = 127; asm volatile("" : "+v"(sc_w), "+v"(sc_a));
    const char* cA = S.aptr(cur); const char* cB = S.bptr(cur);
    PG8_STAGE(PG8_SB(0, 0), cB, voffB); PG8_STAGE(PG8_SB(0, 1), cB + hstep, voffB); PG8_STAGE_A(PG8_SA(0, 0), cA, 0, false); PG8_STAGE_A(PG8_SA(0, 1), cA, 1, false);
    if (wr == 1) PG8_BAR;
    PG8_WAIT_V(2); PG8_BAR;
    PG8_STAGE(PG8_SB(1, 0), cB + kstep, voffB); PG8_STAGE_A(PG8_SA(1, 0), cA + kstep, 0, false); PG8_STAGE(PG8_SB(1, 1), cB + hstep + kstep, voffB);
    PG8_WAIT_V(6); PG8_BAR;
    for (;;) {
        const bool has_next = S.next(ui + 1, nxt);
        const char* nA = has_next ? S.aptr(nxt) : cA; const char* nB = has_next ? S.bptr(nxt) : cB;
        if constexpr (GATHER) { const int pmn = has_next ? nxt.pm : cur.pm;
#pragma unroll
            for (int h = 0; h < 2; ++h)
#pragma unroll
                for (int i = 0; i < 2; ++i) gN[h][i] = (unsigned)rowtok[pmn * 256 + h * 128 + (int)arow[i]] * (unsigned)(K * 2) + voffA[i]; }
        for (int t = 0; t < nt; t += 2) {
            const bool last = (t == nt - 2);
            const char* a1 = cA + (size_t)(t + 1) * kstep;
            const char* a2 = last ? nA : cA + (size_t)(t + 2) * kstep; const char* b2 = last ? nB : cB + (size_t)(t + 2) * kstep;
            const char* a3 = a2 + kstep; const char* b3 = b2 + kstep;
            PG8_LDB(B0, 0, 0); PG8_LDB(B1, 0, 1); PG8_SCHED; PG8_LDA(At, 0, 0); PG8_STAGE_A(PG8_SA(1, 1), a1, 1, false);
            PG8_WAIT_V(8); PG8_WAIT_L(0); PG8_BAR; PG8_MMA(0, 0, At, B0); PG8_MMA(0, 1, At, B1); PG8_BAR; PG8_SCHED;
            PG8_LDA(At, 0, 1); PG8_STAGE(PG8_SB(0, 0), b2, voffB); PG8_STAGE(PG8_SB(0, 1), b2 + hstep, voffB); PG8_STAGE_A(PG8_SA(0, 0), a2, 0, last);
            PG8_WAIT_V(8); PG8_WAIT_L(0); PG8_BAR; PG8_MMA(1, 0, At, B0); PG8_MMA(1, 1, At, B1); PG8_BAR; PG8_SCHED;
            PG8_LDB(B0, 1, 0); PG8_LDB(B1, 1, 1); PG8_SCHED; PG8_LDA(At, 1, 0); PG8_STAGE_A(PG8_SA(0, 1), a2, 1, last);
            PG8_WAIT_V(8); PG8_WAIT_L(0); PG8_BAR; PG8_MMA(0, 0, At, B0); PG8_MMA(0, 1, At, B1); PG8_BAR; PG8_SCHED;
            PG8_LDA(At, 1, 1); PG8_STAGE(PG8_SB(1, 0), b3, voffB); PG8_STAGE(PG8_SB(1, 1), b3 + hstep, voffB); PG8_STAGE_A(PG8_SA(1, 0), a3, 0, last);
            PG8_WAIT_V(8); PG8_WAIT_L(0); PG8_BAR; PG8_MMA(1, 0, At, B0); PG8_MMA(1, 1, At, B1); PG8_BAR; PG8_SCHED;
        }
        if (wr == 0) PG8_BAR;
        if constexpr (FP8 && !I8) asm volatile("s_nop 15\n\ts_nop 15" ::: "memory");
        if constexpr (I8) {
            const float* rsp = S.rowscale(cur) + cur.pm * 256 + wr * 64 + fr; const unsigned* csb = S.colmax(cur); const int colb = cur.e * 256 + wc * 32 + 8 * fq;
            f32x4 cs[2][2];
#pragma unroll
            for (int bj = 0; bj < 2; ++bj)
#pragma unroll
                for (int n = 0; n < 2; ++n) { const int c0 = S.ccol(colb + bj * 128 + 4 * n); const u32x4 cb = *(const u32x4*)(csb + c0);
                    cs[bj][n] = (f32x4){__uint_as_float(cb.x), __uint_as_float(cb.y), __uint_as_float(cb.z), __uint_as_float(cb.w)} * (1.f / 127.f); }
#pragma unroll
            for (int ai = 0; ai < 2; ++ai)
#pragma unroll
                for (int m = 0; m < 4; ++m) { const float r = rsp[ai * 128 + m * 16];
#pragma unroll
                    for (int bj = 0; bj < 2; ++bj)
#pragma unroll
                        for (int n = 0; n < 2; ++n) { const i32x4 ci = __builtin_bit_cast(i32x4, acc[ai][bj][m][n]);
                            acc[ai][bj][m][n] = (f32x4){(float)ci[0], (float)ci[1], (float)ci[2], (float)ci[3]} * (cs[bj][n] * r); } }
        }
        E(acc, cur, wr, wc, fr, fq);
#ifdef EPI_DUP
        E(acc, cur, wr, wc, fr, fq);
#endif
        if (!has_next) break;
#pragma unroll
        for (int a = 0; a < 2; ++a)
#pragma unroll
            for (int b = 0; b < 2; ++b)
#pragma unroll
                for (int m = 0; m < 4; ++m)
#pragma unroll
                    for (int n = 0; n < 2; ++n) acc[a][b][m][n] = (f32x4){0.f, 0.f, 0.f, 0.f};
        cur = nxt; cA = nA; cB = nB; ++ui;
        if constexpr (GATHER) { gA[0][0] = gN[0][0]; gA[0][1] = gN[0][1]; gA[1][0] = gN[1][0]; gA[1][1] = gN[1][1]; }
        if (wr == 1) PG8_BAR;
    }
    PG8_WAIT_V(0);
    PG8_BAR;
#undef PG8_SA
#undef PG8_SB
#undef PG8_STAGE
#undef PG8_STAGE_A
#undef PG8_LDA
#undef PG8_LDB
#undef PG8_LO
#undef PG8_HI
#undef PG8_MMA
#undef PG8_WAIT_V
#undef PG8_WAIT_L
#undef PG8_BAR
#undef PG8_SCHED
}
struct SchedDense {
    int nM, nN, G, c; const char* A; const char* Bt; size_t tstep;
    __device__ __forceinline__ bool next(int i, Unit& u) const { const long L = (long)i * G + c; if (L >= (long)nM * nN) return false; tile_map((int)L, nM, nN, u.pm, u.pn); u.e = 0; u.h = 0; return true; }
    __device__ __forceinline__ const char* aptr(const Unit& u) const { return A + (size_t)u.pm * tstep; }
    __device__ __forceinline__ const char* bptr(const Unit& u) const { return Bt + (size_t)u.pn * tstep; }
};
struct SchedMerge {
    int nM, nN, G, c; const char *A0, *A1, *B0, *B1; size_t tstep;
    __device__ __forceinline__ bool next(int i, Unit& u) const { const long L = (long)(i >> 1) * G + c; if (L >= (long)nM * nN) return false; tile_map((int)L, nM, nN, u.pm, u.pn); u.e = 0; u.h = i & 1; return true; }
    __device__ __forceinline__ const char* aptr(const Unit& u) const { return (u.h ? A1 : A0) + (size_t)u.pm * tstep; }
    __device__ __forceinline__ const char* bptr(const Unit& u) const { return (u.h ? B1 : B0) + (size_t)u.pn * tstep; }
};
struct SchedMoe {
    int nM, nN, G, c; const char* A; const char* Bt; size_t tstep, estride; const LAS int* tilee; bool gather;
    __device__ __forceinline__ bool next(int i, Unit& u) const { const long L = (long)i * G + c; if (L >= (long)nM * nN) return false; tile_map((int)L, nM, nN, u.pm, u.pn); u.e = __builtin_amdgcn_readfirstlane(tilee[u.pm]); u.h = 0; return true; }
    __device__ __forceinline__ const char* aptr(const Unit& u) const { return gather ? A : A + (size_t)u.pm * tstep; }
    __device__ __forceinline__ const char* bptr(const Unit& u) const { return Bt + (size_t)u.e * estride + (size_t)u.pn * tstep; }
};
}

constexpr int NWAVES = 8;
constexpr int RING_BYTES = 131072, MISC_OFF = RING_BYTES, LDS_BYTES = 147456;
struct Frame { LAS unsigned char* lds; volatile LAS unsigned* MISC; int tid, lane, wave, vcu, G; };
__device__ __forceinline__ Frame phase_frame(const Frame& F0) { Frame F = F0; int t = threadIdx.x; asm volatile("" : "+v"(t)); F.tid = t; F.lane = t & 63; F.wave = __builtin_amdgcn_readfirstlane(t >> 6); return F; }

struct MapId { __device__ __forceinline__ int operator()(int c) const { return c; } };
struct MapWin { __device__ __forceinline__ int operator()(int c) const { return c < 7168 ? c : (c < 7176 ? -1 : c - 8); } };
#ifndef FP8_GROUPS
#define FP8_GROUPS 0x7fu
#endif
__host__ __device__ constexpr int fp8_rank(int g) { int r = 0; for (int i = 0; i < g; ++i) r += (FP8_GROUPS >> i) & 1; return r; }
constexpr int N8G = fp8_rank(7), NB16T = 4 * (7 - N8G), NF8T = 4 * N8G + 16;
template <int SEL> __device__ __forceinline__ int in_tile_of(int l) { int cnt = 0, out = SEL ? 28 + (l - 4 * N8G) : 0;
#pragma unroll
    for (int g = 0; g < 7; ++g) if ((int)((FP8_GROUPS >> g) & 1u) == SEL) { if (l >= 4 * cnt && l < 4 * cnt + 4) out = 4 * g + (l - 4 * cnt); ++cnt; }
    return out; }
struct SchedI8 {
    int nM, nN, G, c; const char* A; const char* Bt; size_t tstep; const float* rs; const unsigned* cs;
    __device__ __forceinline__ bool next(int i, pg8::Unit& u) const { const long L = (long)i * G + c; if (L >= (long)nM * nN) return false; pg8::tile_map((int)L, nM, nN, u.pm, u.pn); u.e = u.pn; u.h = 0; return true; }
    __device__ __forceinline__ const char* aptr(const pg8::Unit& u) const { return A + (size_t)u.pm * tstep; }
    __device__ __forceinline__ const char* bptr(const pg8::Unit& u) const { return Bt + (size_t)u.pn * tstep; }
    __device__ __forceinline__ int ccol(int c0) const { return c0; }
    __device__ __forceinline__ const float* rowscale(const pg8::Unit&) const { return rs; }
    __device__ __forceinline__ const unsigned* colmax(const pg8::Unit&) const { return cs; }
};
template <int SEL> struct SchedIn {
    int nM, nN, G, c; const char* A; const char* Bt; size_t tstep; const float* rs; const unsigned* cs;
    __device__ __forceinline__ bool next(int i, pg8::Unit& u) const { const long L = (long)i * G + c; if (L >= (long)nM * nN) return false; pg8::tile_map((int)L, nM, nN, u.pm, u.pn); u.e = in_tile_of<SEL>(u.pn); u.h = 0; return true; }
    __device__ __forceinline__ const char* aptr(const pg8::Unit& u) const { return A + (size_t)u.pm * tstep; }
    __device__ __forceinline__ const char* bptr(const pg8::Unit& u) const { return Bt + (size_t)(SEL ? u.pn : u.e) * tstep; }
    __device__ __forceinline__ int ccol(int c0) const { return c0 < 7168 ? c0 : c0 + 8; }
    __device__ __forceinline__ const float* rowscale(const pg8::Unit&) const { return rs; }
    __device__ __forceinline__ const unsigned* colmax(const pg8::Unit&) const { return cs; }
};
struct MapWinG { __device__ __forceinline__ int operator()(int c) const { if (c >= 7176) return c - 7176 + 1024 * N8G; if (c >= 7168) return -1; const int g = c >> 10; int r = 0;
#pragma unroll
        for (int i = 0; i < 7; ++i) r += (i < g) ? (int)((FP8_GROUPS >> i) & 1u) : 0;
        return ((FP8_GROUPS >> g) & 1u) ? r * 1024 + (c & 1023) : -1; } };
struct MapGu { __device__ __forceinline__ int operator()(int c) const { const int bj = c >> 11, j = c & 2047; return ((j >> 7) << 8) + (bj << 7) + (j & 127); } };
__device__ __forceinline__ unsigned pk4_fp8(float a, float b, float c, float d) { int r = __builtin_amdgcn_cvt_pk_fp8_f32(a, b, 0, false); r = __builtin_amdgcn_cvt_pk_fp8_f32(c, d, r, true); return (unsigned)r; }
constexpr float W8_SCALE = 64.f;
__device__ __forceinline__ unsigned pk4_i8(float a, float b, float c, float d) { const int q0 = (int)__builtin_rintf(__builtin_amdgcn_fmed3f(a, -127.f, 127.f)), q1 = (int)__builtin_rintf(__builtin_amdgcn_fmed3f(b, -127.f, 127.f)), q2 = (int)__builtin_rintf(__builtin_amdgcn_fmed3f(c, -127.f, 127.f)), q3 = (int)__builtin_rintf(__builtin_amdgcn_fmed3f(d, -127.f, 127.f)); return (unsigned)(q0 & 255) | ((unsigned)(q1 & 255) << 8) | ((unsigned)(q2 & 255) << 16) | ((unsigned)q3 << 24); }
template <class Map, bool Q8 = false, bool I8 = false>
__device__ __forceinline__ void p0_transpose_item(const float* W, int K, int N, void* WTv, LAS float* scr, int item, int lane, Map map, const unsigned* cmax = nullptr) {
    const int nblk = (N + 31) / 32, kb = item / nblk, nb = item % nblk, k0 = 64 * kb, n0 = 32 * nb;
    const int col = n0 + (lane & 31); const bool okc = col < N;
    float v[32];
#pragma unroll
    for (int i = 0; i < 32; ++i) { const int kk = 2 * i + (lane >> 5); v[i] = okc ? W[(size_t)(k0 + kk) * N + col] : 0.f; }
#pragma unroll
    for (int i = 0; i < 32; ++i) { const int kk = 2 * i + (lane >> 5); scr[kk * 33 + (lane & 31)] = v[i]; }
    LDS_WAIT(); asm volatile("" ::: "memory");
    const int c = lane & 7;
#pragma unroll
    for (int j = 0; j < 4; ++j) { const int n = (lane >> 3) + 8 * j; const LAS float* s = scr + (8 * c) * 33 + n;
        const int dr = (n0 + n < N) ? map(n0 + n) : -1;
        if constexpr (Q8) { u32x2 o;
            if constexpr (I8) { const float inv = 127.f / fmaxf(__uint_as_float(cmax[(n0 + n < N) ? n0 + n : 0]), 1e-30f);
                o.x = pk4_i8(s[0 * 33] * inv, s[1 * 33] * inv, s[2 * 33] * inv, s[3 * 33] * inv); o.y = pk4_i8(s[4 * 33] * inv, s[5 * 33] * inv, s[6 * 33] * inv, s[7 * 33] * inv); }
            else { o.x = pk4_fp8(s[0 * 33] * W8_SCALE, s[1 * 33] * W8_SCALE, s[2 * 33] * W8_SCALE, s[3 * 33] * W8_SCALE); o.y = pk4_fp8(s[4 * 33] * W8_SCALE, s[5 * 33] * W8_SCALE, s[6 * 33] * W8_SCALE, s[7 * 33] * W8_SCALE); }
            if (dr >= 0) *(u32x2*)((unsigned char*)WTv + (size_t)dr * K + k0 + 8 * c) = o; }
        else { u32x4 o; o.x = cvt_pk_bf16(s[0 * 33], s[1 * 33]); o.y = cvt_pk_bf16(s[2 * 33], s[3 * 33]); o.z = cvt_pk_bf16(s[4 * 33], s[5 * 33]); o.w = cvt_pk_bf16(s[6 * 33], s[7 * 33]);
            if (dr >= 0) *(u32x4*)((bf16_t*)WTv + (size_t)dr * K + k0 + 8 * c) = o; } }
    LDS_WAIT(); asm volatile("" ::: "memory");
}
template <class Map>
__device__ __forceinline__ void p0_fp8_load(float (&v)[64], const float* W, int N, int item, int lane) {
    const int nblk = N / 32, kb = item / nblk, nb = item % nblk, k0 = 128 * kb + 64 * (lane >> 5), col = 32 * nb + (lane & 31);
    const float* src = W + (size_t)k0 * N + col;
#pragma unroll
    for (int i = 0; i < 64; ++i) v[i] = __builtin_nontemporal_load(src + (size_t)i * N);
}
template <class Map>
__device__ __forceinline__ void p0_fp8_finish(const float (&v)[64], int K, int N, unsigned char* WT, int item, int lane, Map map) {
    const int nblk = N / 32, kb = item / nblk, nb = item % nblk, k0 = 128 * kb + 64 * (lane >> 5), col = 32 * nb + (lane & 31);
    u32x4 o[4];
#pragma unroll
    for (int q = 0; q < 4; ++q) {
        o[q].x = pk4_fp8(v[16 * q + 0] * W8_SCALE, v[16 * q + 1] * W8_SCALE, v[16 * q + 2] * W8_SCALE, v[16 * q + 3] * W8_SCALE);
        o[q].y = pk4_fp8(v[16 * q + 4] * W8_SCALE, v[16 * q + 5] * W8_SCALE, v[16 * q + 6] * W8_SCALE, v[16 * q + 7] * W8_SCALE);
        o[q].z = pk4_fp8(v[16 * q + 8] * W8_SCALE, v[16 * q + 9] * W8_SCALE, v[16 * q + 10] * W8_SCALE, v[16 * q + 11] * W8_SCALE);
        o[q].w = pk4_fp8(v[16 * q + 12] * W8_SCALE, v[16 * q + 13] * W8_SCALE, v[16 * q + 14] * W8_SCALE, v[16 * q + 15] * W8_SCALE); }
#define XCHG(pa, pb, bit, msk) do { const bool b_ = (lane & (bit)) != 0; u32x4 s_ = b_ ? o[pa] : o[pb]; \
        s_.x = (unsigned)__shfl_xor((int)s_.x, msk); s_.y = (unsigned)__shfl_xor((int)s_.y, msk); s_.z = (unsigned)__shfl_xor((int)s_.z, msk); s_.w = (unsigned)__shfl_xor((int)s_.w, msk); \
        if (b_) o[pa] = s_; else o[pb] = s_; } while (0)
    XCHG(0, 1, 1, 1); XCHG(2, 3, 1, 1); XCHG(0, 2, 2, 2); XCHG(1, 3, 2, 2);
#undef XCHG
    const int j = lane & 3, colb = col - j;
#pragma unroll
    for (int q = 0; q < 4; ++q) *(u32x4*)(WT + (size_t)map(colb + q) * K + k0 + 16 * j) = o[q];
}
constexpr int CW_QH = 128, CW_QC = 192;
__device__ __forceinline__ void p0_weights(const Frame& F0, const P& p) { const Frame F = phase_frame(F0);
    LAS float* scr = (LAS float*)(F.lds + F.wave * 8448);
    const int gw = F.vcu * NWAVES + F.wave, NGW = F.G * NWAVES;
    constexpr int I_IN = (2048 / 64) * ((IN_COLS + 31) / 32), I_UP = (1024 / 64) * (2048 / 32), NB16 = I_IN + 2 * I_UP;
    unsigned char* ws = p.ws;
    (void)scr; (void)gw; (void)NGW; (void)ws; (void)NB16;
}
template <int NCOLS, int KROWS = 2048> __device__ __forceinline__ void p0_colmax_t(const Frame& F0, const float* W, unsigned* CMAX) { const Frame F = phase_frame(F0);
    const int gw = F.vcu * NWAVES + F.wave, NGW = F.G * NWAVES, lane = F.lane;
    constexpr int NBLK = (NCOLS + 31) / 32, I_IN = (KROWS / 64) * NBLK;
    for (int it = gw; it < I_IN; it += NGW) { const int kb = it / NBLK, nb = it % NBLK, k0 = 64 * kb, col = 32 * nb + (lane & 31); const bool okc = col < NCOLS;
        float m = 0.f;
#pragma unroll
        for (int i = 0; i < 32; ++i) { const int kk = 2 * i + (lane >> 5); m = fmaxf(m, __builtin_fabsf(okc ? W[(size_t)(k0 + kk) * NCOLS + col] : 0.f)); }
        m = fmaxf(m, __shfl_xor(m, 32));
        if (lane < 32 && okc) atomicMax(CMAX + col, __float_as_uint(m)); }
}
__device__ __forceinline__ void p0_colmax(const Frame& F0, const P& p) { p0_colmax_t<IN_COLS>(F0, p.w_in, (unsigned*)(p.ws + WS_CTL) + CW_CMAX); p0_colmax_t<2048>(F0, p.w_out, (unsigned*)(p.ws + WS_CTL) + CW_CMAX2);
    p0_colmax_t<2048, 1024>(F0, p.w_up_hg, (unsigned*)(p.ws + WS_CTL) + CW_CMAXA); p0_colmax_t<2048, 1024>(F0, p.w_up_fox, (unsigned*)(p.ws + WS_CTL) + CW_CMAXB); }
__device__ __forceinline__ void p0_win_i8(const Frame& F0, const P& p) { const Frame F = phase_frame(F0);
    LAS float* scr = (LAS float*)(F.lds + F.wave * 8448);
    const unsigned* CMAX = (const unsigned*)(p.ws + WS_CTL) + CW_CMAX;
    const int gw = F.vcu * NWAVES + F.wave, NGW = F.G * NWAVES;
    constexpr int I_IN = (2048 / 64) * ((IN_COLS + 31) / 32);
    for (int it = gw; it < I_IN; it += NGW) p0_transpose_item<MapWinG, true, true>(p.w_in, 2048, IN_COLS, p.ws + OFF_WIN8_T, scr, it, F.lane, MapWinG{}, CMAX);
    constexpr int I_OUT = (2048 / 64) * (2048 / 32);
    for (int it = gw; it < I_OUT; it += NGW) p0_transpose_item<MapId, true, true>(p.w_out, 2048, 2048, p.ws + OFF_WOUT8_T, scr, it, F.lane, MapId{}, (const unsigned*)(p.ws + WS_CTL) + CW_CMAX2);
    constexpr int I_UP = (1024 / 64) * (2048 / 32);
    for (int it = gw; it < I_UP; it += NGW) { p0_transpose_item<MapId, true, true>(p.w_up_hg, 1024, 2048, p.ws + OFF_WUPA_T, scr, it, F.lane, MapId{}, (const unsigned*)(p.ws + WS_CTL) + CW_CMAXA);
        p0_transpose_item<MapId, true, true>(p.w_up_fox, 1024, 2048, p.ws + OFF_WUPB_T, scr, it, F.lane, MapId{}, (const unsigned*)(p.ws + WS_CTL) + CW_CMAXB); }
}
struct MapGuOrId { int gu; __device__ __forceinline__ int operator()(int c) const { const int bj = c >> 11, j = c & 2047; return gu ? ((j >> 7) << 8) + (bj << 7) + (j & 127) : c; } };
__device__ __forceinline__ void cq_issue(float (&v)[64], const P& p, int c, int wave, int lane) {
    constexpr int I_GU = (2048 / 128) * (4096 / 32), I_DN = (2048 / 128) * (2048 / 32);
    const int r = __builtin_amdgcn_readfirstlane(c * 8 + wave); const bool gu = r < NEXP * I_GU; const int q = gu ? r : r - NEXP * I_GU, per = gu ? I_GU : I_DN, e = q / per, N = gu ? 4096 : 2048;
    const float* W = gu ? p.w_gu + (size_t)e * 2048 * 4096 : p.w_down + (size_t)e * 2048 * 2048;
    p0_fp8_load<MapId>(v, W, N, q - e * per, lane);
}
__device__ __forceinline__ void cq_finish(const float (&v)[64], const P& p, int c, int wave, int lane) {
    constexpr int I_GU = (2048 / 128) * (4096 / 32), I_DN = (2048 / 128) * (2048 / 32);
    const int r = __builtin_amdgcn_readfirstlane(c * 8 + wave); const bool gu = r < NEXP * I_GU; const int q = gu ? r : r - NEXP * I_GU, per = gu ? I_GU : I_DN, e = q / per, N = gu ? 4096 : 2048;
    unsigned char* WT = gu ? p.ws + OFF_WGU_T + (size_t)e * 4096 * 2048 : p.ws + OFF_WDN_T + (size_t)e * 2048 * 2048;
    p0_fp8_finish(v, 2048, N, WT, q - e * per, lane, MapGuOrId{gu ? 1 : 0});
}
__device__ __forceinline__ void convert_queue(const Frame& F0, const P& p) { const Frame F = phase_frame(F0);
    constexpr int I_GU = (2048 / 128) * (4096 / 32), I_DN = (2048 / 128) * (2048 / 32), NCONV = NEXP * (I_GU + I_DN), NCH = NCONV / 8;
    unsigned* qhead = (unsigned*)(p.ws + WS_CTL) + CW_QC; LAS int* slot = (LAS int*)(F.lds + MISC_OFF + 768);
    if (F.tid == 0) { slot[0] = (int)__hip_atomic_fetch_add(qhead, 1u, __ATOMIC_RELAXED, __HIP_MEMORY_SCOPE_AGENT); slot[1] = (int)__hip_atomic_fetch_add(qhead, 1u, __ATOMIC_RELAXED, __HIP_MEMORY_SCOPE_AGENT); }
    __syncthreads();
    int ca = __builtin_amdgcn_readfirstlane(slot[0]), cb = __builtin_amdgcn_readfirstlane(slot[1]);
    float va[64], vb[64];
    if (ca < NCH) {
        cq_issue(va, p, ca, F.wave, F.lane);
        for (;;) {
            if (F.tid == 0) slot[2] = (int)__hip_atomic_fetch_add(qhead, 1u, __ATOMIC_RELAXED, __HIP_MEMORY_SCOPE_AGENT);
            cq_issue(vb, p, cb < NCH ? cb : NCH - 1, F.wave, F.lane);
            cq_finish(va, p, ca, F.wave, F.lane);
            __syncthreads();
            const int cn = __builtin_amdgcn_readfirstlane(slot[2]);
            if (cb >= NCH) break;
            if (F.tid == 0) slot[3] = (int)__hip_atomic_fetch_add(qhead, 1u, __ATOMIC_RELAXED, __HIP_MEMORY_SCOPE_AGENT);
            cq_issue(va, p, cn < NCH ? cn : NCH - 1, F.wave, F.lane);
            cq_finish(vb, p, cb, F.wave, F.lane);
            __syncthreads();
            const int cm = __builtin_amdgcn_readfirstlane(slot[3]);
            if (cn >= NCH) break;
            ca = cn; cb = cm;
        }
    }
    __syncthreads();
}
__device__ __forceinline__ void p0_router_prep(const Frame& F0, const P& p) { const Frame F = phase_frame(F0);
    bf16_t* RWT = (bf16_t*)(p.ws + OFF_RWT);
    for (int i = F.vcu * NWAVES * 64 + F.tid; i < NEXP * D_MODEL; i += F.G * NWAVES * 64) { const int e = i >> 11, k = i & 2047;
        const float w = p.norm2[k] * p.router_w[(size_t)k * NEXP + e]; const bf16_t hi = f2bf(w); RWT[i] = hi; RWT[NEXP * D_MODEL + i] = f2bf(w - bf2f(hi)); }
}
__device__ __forceinline__ void p0_rmsnorm(const Frame& F0, const P& p) { const Frame F = phase_frame(F0);
    LAS float* WF = (LAS float*)F.lds;
    LAS float* FLs = (LAS float*)(F.lds + 65536);
    unsigned char* H8 = p.ws + OFF_H8; float* HSC = (float*)(p.ws + OFF_HSC); float* C = (float*)(p.ws + OFF_C); float* BT = (float*)(p.ws + OFF_BT);
    for (int k = F.tid; k < D_MODEL; k += NWAVES * 64) { const float4* wr = (const float4*)(p.w_in + (size_t)k * IN_COLS + 7168); const float4 w0 = wr[0], w1 = wr[1];
        WF[0 * 2048 + k] = w0.x; WF[1 * 2048 + k] = w0.y; WF[2 * 2048 + k] = w0.z; WF[3 * 2048 + k] = w0.w; WF[4 * 2048 + k] = w1.x; WF[5 * 2048 + k] = w1.y; WF[6 * 2048 + k] = w1.z; WF[7 * 2048 + k] = w1.w; }
    __syncthreads();
    const int lane = F.lane;
    for (int blk = F.vcu; blk < T / 128; blk += F.G) {
        for (int pr = 0; pr < 8; ++pr) {
            const int lt = F.wave * 16 + 2 * pr, ta = blk * 128 + lt;
            const float4* xa = (const float4*)(p.x + (size_t)ta * D_MODEL); const float4* xb = xa + D_MODEL / 4;
            float4 va[8], vb[8]; float sa = 0.f, sb = 0.f;
#pragma unroll
            for (int i = 0; i < 8; ++i) { va[i] = xa[lane + 64 * i]; vb[i] = xb[lane + 64 * i];
                sa += va[i].x * va[i].x + va[i].y * va[i].y + va[i].z * va[i].z + va[i].w * va[i].w; sb += vb[i].x * vb[i].x + vb[i].y * vb[i].y + vb[i].z * vb[i].z + vb[i].w * vb[i].w; }
            const float ra = rsqrtf(wave_sum(sa) * (1.f / D_MODEL) + EPS), rb = rsqrtf(wave_sum(sb) * (1.f / D_MODEL) + EPS);
            float qa_ = 0.f, qb_ = 0.f;
#pragma unroll
            for (int i = 0; i < 8; ++i) { const float4 g = ((const float4*)p.norm1)[lane + 64 * i];
                qa_ = fmaxf(fmaxf(qa_, fmaxf(__builtin_fabsf(va[i].x * g.x), __builtin_fabsf(va[i].y * g.y))), fmaxf(__builtin_fabsf(va[i].z * g.z), __builtin_fabsf(va[i].w * g.w)));
                qb_ = fmaxf(fmaxf(qb_, fmaxf(__builtin_fabsf(vb[i].x * g.x), __builtin_fabsf(vb[i].y * g.y))), fmaxf(__builtin_fabsf(vb[i].z * g.z), __builtin_fabsf(vb[i].w * g.w))); }
            const float ma_ = fmaxf(wave_max(qa_) * ra, 1e-30f), mb_ = fmaxf(wave_max(qb_) * rb, 1e-30f), inva = 127.f / ma_, invb = 127.f / mb_;
            if (lane == 0) { HSC[ta] = ma_ * (1.f / 127.f); HSC[ta + 1] = mb_ * (1.f / 127.f); }
            float aa[8], ab[8];
#pragma unroll
            for (int j = 0; j < 8; ++j) { aa[j] = 0.f; ab[j] = 0.f; }
#pragma unroll
            for (int i = 0; i < 8; ++i) {
                const float4 g = ((const float4*)p.norm1)[lane + 64 * i]; const int k0 = 4 * (lane + 64 * i);
                const float4 ha = make_float4(va[i].x * ra * g.x, va[i].y * ra * g.y, va[i].z * ra * g.z, va[i].w * ra * g.w);
                const float4 hb = make_float4(vb[i].x * rb * g.x, vb[i].y * rb * g.y, vb[i].z * rb * g.z, vb[i].w * rb * g.w);
                *(unsigned*)(H8 + (size_t)ta * D_MODEL + k0) = pk4_i8(ha.x * inva, ha.y * inva, ha.z * inva, ha.w * inva); *(unsigned*)(H8 + (size_t)(ta + 1) * D_MODEL + k0) = pk4_i8(hb.x * invb, hb.y * invb, hb.z * invb, hb.w * invb);
#pragma unroll
                for (int j = 0; j < 8; ++j) { const f32x4 w = *(const LAS f32x4*)(WF + j * 2048 + k0);
                    aa[j] += ha.x * w[0] + ha.y * w[1] + ha.z * w[2] + ha.w * w[3]; ab[j] += hb.x * w[0] + hb.y * w[1] + hb.z * w[2] + hb.w * w[3]; }
            }
#pragma unroll
            for (int j = 0; j < 8; ++j) { aa[j] = wave_sum(aa[j]); ab[j] = wave_sum(ab[j]); }
            float ma = aa[0], mb = ab[0];
#pragma unroll
            for (int j = 1; j < 8; ++j) { ma = (lane == j) ? aa[j] : ma; mb = (lane == j) ? ab[j] : mb; }
            if (lane < 8) { const float fb = p.f_bias[lane]; FLs[lt * 8 + lane] = log_sigmoidf_(ma + fb); FLs[(lt + 1) * 8 + lane] = log_sigmoidf_(mb + fb); }
        }
        __syncthreads();
        if (F.tid < 8) { float c = 0.f; for (int tt = 0; tt < 128; ++tt) { c += FLs[tt * 8 + F.tid]; FLs[tt * 8 + F.tid] = c; } BT[blk * 8 + F.tid] = c; }
        __syncthreads();
        for (int e = F.tid; e < 1024; e += NWAVES * 64) C[(size_t)blk * 1024 + e] = FLs[e];
        __syncthreads();
    }
}
__device__ __forceinline__ void p1_fix_c(const Frame& F0, const P& p) { const Frame F = phase_frame(F0);
    float* C = (float*)(p.ws + OFF_C); const float* BT = (const float*)(p.ws + OFF_BT);
    for (int blk = F.vcu; blk < T / 128; blk += F.G) {
        const int j = F.tid & 7, b0 = (blk / 64) * 64; float off = 0.f;
        for (int w = b0; w < blk; ++w) off += BT[w * 8 + j];
        for (int e = F.tid; e < 1024; e += NWAVES * 64) C[(size_t)blk * 1024 + e] += off;
    }
}
struct EpiIn1 {
    static constexpr bool PERM = true;
    unsigned char* ws; const float* lb_logits; LAS float* NS; const float* fq_norm; const float* fk_norm;
    __device__ __forceinline__ void operator()(const f32x4 (&acc)[2][2][4][2], const pg8::Unit& u, int wr, int wc, int fr, int fq) const {
        const int pn = u.e; int seg, colt;
        if (pn < 28) { seg = pn >> 2; colt = (pn & 3) * 256; } else if (pn < 36) { seg = 7; colt = (pn - 28) * 256; } else { seg = 8; colt = (pn - 36) * 256; }
        const int ldc = seg < 7 ? 1024 : 2048;
        bf16_t* base = (bf16_t*)(ws + (seg < 7 ? OFF_HQ + (size_t)seg * 64 * MiB : OFF_GA + (size_t)(seg - 7) * 128 * MiB));
        const int row0 = u.pm * 256 + wr * 64 + fr, col0 = colt + wc * 32 + 8 * fq;
        const int mode = (seg == 0) ? 0 : (seg == 1) ? 1 : (seg == 3) ? 3 : (seg >= 7) ? 4 : 2;
        if (seg == 4 || seg == 5) {
            const float* gn = (seg == 4) ? fq_norm : fk_norm; const float gs = (seg == 4) ? 0.08838834764831845f : 1.f;
#pragma unroll
            for (int ai = 0; ai < 2; ++ai)
#pragma unroll
                for (int m = 0; m < 4; ++m)
#pragma unroll
                    for (int bj = 0; bj < 2; ++bj) { const f32x4 a = acc[ai][bj][m][0], b = acc[ai][bj][m][1];
                        float q = a[0] * a[0] + a[1] * a[1] + a[2] * a[2] + a[3] * a[3] + b[0] * b[0] + b[1] * b[1] + b[2] * b[2] + b[3] * b[3];
                        q += __shfl_xor(q, 16); q += __shfl_xor(q, 32);
                        if (fq == 0) NS[(ai * 128 + wr * 64 + m * 16 + fr) * 8 + bj * 4 + wc] = q; }
            asm volatile("s_waitcnt lgkmcnt(0)" ::: "memory");
            __builtin_amdgcn_s_barrier();
            const f32x4 g0 = *(const f32x4*)(gn + 32 * wc + 8 * fq) * gs, g1 = *(const f32x4*)(gn + 32 * wc + 8 * fq + 4) * gs;
#pragma unroll
            for (int ai = 0; ai < 2; ++ai)
#pragma unroll
                for (int m = 0; m < 4; ++m) { bf16_t* rowp = base + (size_t)(row0 + ai * 128 + m * 16) * ldc + col0;
#pragma unroll
                    for (int bj = 0; bj < 2; ++bj) { const f32x4 t = *(const LAS f32x4*)(NS + (ai * 128 + wr * 64 + m * 16 + fr) * 8 + bj * 4);
                        const float rs = rsqrtf((t[0] + t[1] + t[2] + t[3]) * (1.f / 128.f) + EPS);
                        const f32x4 v0 = acc[ai][bj][m][0] * rs * g0, v1 = acc[ai][bj][m][1] * rs * g1;
                        u32x4 w; w.x = cvt_pk_bf16(v0[0], v0[1]); w.y = cvt_pk_bf16(v0[2], v0[3]); w.z = cvt_pk_bf16(v1[0], v1[1]); w.w = cvt_pk_bf16(v1[2], v1[3]);
                        *(u32x4*)(rowp + bj * 128) = w; } }
            return;
        }
        f32x4 lbv[2][2];
        if (mode == 1) {
#pragma unroll
            for (int bj = 0; bj < 2; ++bj)
#pragma unroll
                for (int n = 0; n < 2; ++n) { const int cc = col0 + bj * 128 + 4 * n; const f32x4 l0 = *(const f32x4*)(lb_logits + cc), l1 = *(const f32x4*)(lb_logits + 1024 + cc);
#pragma unroll
                    for (int j = 0; j < 4; ++j) lbv[bj][n][j] = __builtin_amdgcn_rcpf(1.f + __expf(l1[j] - l0[j])); }
        }
#pragma unroll
        for (int ai = 0; ai < 2; ++ai)
#pragma unroll
            for (int m = 0; m < 4; ++m) { bf16_t* rowp = base + (size_t)(row0 + ai * 128 + m * 16) * ldc + col0;
#pragma unroll
                for (int bj = 0; bj < 2; ++bj) { f32x4 v[2] = {acc[ai][bj][m][0], acc[ai][bj][m][1]};
#pragma unroll
                    for (int n = 0; n < 2; ++n)
#pragma unroll
                        for (int j = 0; j < 4; ++j) { float x = v[n][j];
                            if (mode == 0) x = x * fast_sigmoid(x) * 0.08838834764831845f;
                            else if (mode == 1) { const float lb = lbv[bj][n][j]; x = __logf(lb + (1.f - lb) * fast_sigmoid(x)); }
                            else if (mode == 3) x = x * fast_sigmoid(x);
                            else if (mode == 4) x = fast_sigmoid(x);
                            v[n][j] = x; }
                    u32x4 w; w.x = cvt_pk_bf16(v[0][0], v[0][1]); w.y = cvt_pk_bf16(v[0][2], v[0][3]); w.z = cvt_pk_bf16(v[1][0], v[1][1]); w.w = cvt_pk_bf16(v[1][2], v[1][3]);
                    *(u32x4*)(rowp + bj * 128) = w; } }
    }
};

template <int HH> struct EpiMergeT {
    static constexpr bool PERM = true;
    unsigned char* ws;
    __device__ __forceinline__ void operator()(const f32x4 (&acc)[2][2][4][2], const pg8::Unit& u, int wr, int wc, int fr, int fq) const {
        const int row0 = u.pm * 256 + wr * 64 + fr, col0 = u.pn * 256 + wc * 32 + 8 * fq;
        const bf16_t* G = (const bf16_t*)(ws + (HH ? OFF_GB : OFF_GA)); bf16_t* TMP = (bf16_t*)(ws + OFF_X1); bf16_t* MRG = (bf16_t*)(ws + OFF_MRG);
#pragma unroll
        for (int ai = 0; ai < 2; ++ai)
#pragma unroll
            for (int m = 0; m < 4; ++m) { const size_t ro = (size_t)(row0 + ai * 128 + m * 16) * D_MODEL + col0;
#pragma unroll
                for (int bj = 0; bj < 2; ++bj) { const u32x4 g = *(const u32x4*)(G + ro + bj * 128);
                    f32x4 v0 = acc[ai][bj][m][0], v1 = acc[ai][bj][m][1];
                    v0[0] *= __uint_as_float(g.x << 16); v0[1] *= __uint_as_float(g.x & 0xffff0000u); v0[2] *= __uint_as_float(g.y << 16); v0[3] *= __uint_as_float(g.y & 0xffff0000u);
                    v1[0] *= __uint_as_float(g.z << 16); v1[1] *= __uint_as_float(g.z & 0xffff0000u); v1[2] *= __uint_as_float(g.w << 16); v1[3] *= __uint_as_float(g.w & 0xffff0000u);
                    if constexpr (HH != 0) { const u32x4 t = *(const u32x4*)(TMP + ro + bj * 128);
                        v0[0] += __uint_as_float(t.x << 16); v0[1] += __uint_as_float(t.x & 0xffff0000u); v0[2] += __uint_as_float(t.y << 16); v0[3] += __uint_as_float(t.y & 0xffff0000u);
                        v1[0] += __uint_as_float(t.z << 16); v1[1] += __uint_as_float(t.z & 0xffff0000u); v1[2] += __uint_as_float(t.w << 16); v1[3] += __uint_as_float(t.w & 0xffff0000u); }
                    u32x4 w; w.x = cvt_pk_bf16(v0[0], v0[1]); w.y = cvt_pk_bf16(v0[2], v0[3]); w.z = cvt_pk_bf16(v1[0], v1[1]); w.w = cvt_pk_bf16(v1[2], v1[3]);
                    *(u32x4*)((HH ? MRG : TMP) + ro + bj * 128) = w;
                    }
                asm volatile("" ::: "memory"); }
    }
};
struct EpiWout1 {
    static constexpr bool PERM = true;
    const float* x; bf16_t* X1;
    __device__ __forceinline__ void operator()(const f32x4 (&acc)[2][2][4][2], const pg8::Unit& u, int wr, int wc, int fr, int fq) const {
        const int row0 = u.pm * 256 + wr * 64 + fr, col0 = u.pn * 256 + wc * 32 + 8 * fq;
#pragma unroll
        for (int ai = 0; ai < 2; ++ai)
#pragma unroll
            for (int m = 0; m < 4; ++m) { const size_t ro = (size_t)(row0 + ai * 128 + m * 16) * D_MODEL + col0;
#pragma unroll
                for (int bj = 0; bj < 2; ++bj) { const f32x4 v0 = *(const f32x4*)(x + ro + bj * 128) + acc[ai][bj][m][0], v1 = *(const f32x4*)(x + ro + bj * 128 + 4) + acc[ai][bj][m][1];
                    u32x4 w; w.x = cvt_pk_bf16(v0[0], v0[1]); w.y = cvt_pk_bf16(v0[2], v0[3]); w.z = cvt_pk_bf16(v1[0], v1[1]); w.w = cvt_pk_bf16(v1[2], v1[3]);
                    *(u32x4*)(X1 + ro + bj * 128) = w; } }
    }
};
struct EpiGU1 {
    static constexpr bool PERM = true;
    const float* b_gu; unsigned char* ACT; const float* ROWRS;
    __device__ __forceinline__ void operator()(const f32x4 (&acc)[2][2][4][2], const pg8::Unit& u, int wr, int wc, int fr, int fq) const {
        const int row0 = u.pm * 256 + wr * 64 + fr, ca = u.pn * 128 + wc * 32 + 8 * fq;
        const float* bg = b_gu + (size_t)u.e * 4096 + ca;
        const f32x4 bg0 = *(const f32x4*)bg, bg1 = *(const f32x4*)(bg + 4), bu0 = *(const f32x4*)(bg + 2048), bu1 = *(const f32x4*)(bg + 2052);
#pragma unroll
        for (int ai = 0; ai < 2; ++ai)
#pragma unroll
            for (int m = 0; m < 4; ++m) {
                const float rs = ROWRS[row0 + ai * 128 + m * 16];
                f32x4 g[2] = {acc[ai][0][m][0] * rs + bg0, acc[ai][0][m][1] * rs + bg1}, up[2] = {acc[ai][1][m][0] * rs + bu0, acc[ai][1][m][1] * rs + bu1}; float o[8];
#pragma unroll
                for (int n = 0; n < 2; ++n)
#pragma unroll
                    for (int j = 0; j < 4; ++j) { const float gg = fminf(g[n][j], 7.f), uu = fminf(fmaxf(up[n][j], -7.f), 7.f); o[n * 4 + j] = (uu + 1.f) * gg * fast_sigmoid(1.702f * gg); }
                u32x2 w; w.x = pk4_fp8(o[0], o[1], o[2], o[3]); w.y = pk4_fp8(o[4], o[5], o[6], o[7]);
                *(u32x2*)(ACT + (size_t)(row0 + ai * 128 + m * 16) * D_MODEL + ca) = w; }
    }
};
constexpr float YR_SCALE = 32.f;
struct EpiDown1 {
    static constexpr bool PERM = true;
    const float* b_down; const float* ROWW; unsigned char* YR;
    __device__ __forceinline__ void operator()(const f32x4 (&acc)[2][2][4][2], const pg8::Unit& u, int wr, int wc, int fr, int fq) const {
        const int row0 = u.pm * 256 + wr * 64 + fr, col0 = u.pn * 256 + wc * 32 + 8 * fq;
        const float* bb = b_down + (size_t)u.e * 2048 + col0;
        f32x4 bv[2][2];
#pragma unroll
        for (int bj = 0; bj < 2; ++bj) { bv[bj][0] = *(const f32x4*)(bb + bj * 128); bv[bj][1] = *(const f32x4*)(bb + bj * 128 + 4); }
#pragma unroll
        for (int ai = 0; ai < 2; ++ai)
#pragma unroll
            for (int m = 0; m < 4; ++m) { const int r = row0 + ai * 128 + m * 16; const float rw = ROWW[r];
#pragma unroll
                for (int bj = 0; bj < 2; ++bj) { f32x4 v0 = (acc[ai][bj][m][0] + bv[bj][0]) * (rw * YR_SCALE), v1 = (acc[ai][bj][m][1] + bv[bj][1]) * (rw * YR_SCALE);
#pragma unroll
                    for (int j = 0; j < 4; ++j) { v0[j] = __builtin_amdgcn_fmed3f(v0[j], -448.f, 448.f); v1[j] = __builtin_amdgcn_fmed3f(v1[j], -448.f, 448.f); }
                    u32x2 w; w.x = pk4_fp8(v0[0], v0[1], v0[2], v0[3]); w.y = pk4_fp8(v1[0], v1[1], v1[2], v1[3]);
                    *(u32x2*)(YR + (size_t)r * D_MODEL + col0 + bj * 128) = w; } }
    }
};
constexpr int TILEE_LDS_OFF = MISC_OFF + 1024;
__device__ __forceinline__ int load_tile_table(const Frame& F0, const P& p) { const Frame F = phase_frame(F0);
    const int* TILEE = (const int*)(p.ws + OFF_TILEE); LAS int* tl = (LAS int*)(F.lds + TILEE_LDS_OFF);
    for (int i = F.tid; i <= NTILES_MAX; i += NWAVES * 64) tl[i] = TILEE[i];
    __syncthreads();
    return tl[NTILES_MAX];
}


typedef short s16x4 __attribute__((ext_vector_type(4)));
__device__ __forceinline__ int img_off(int row, int ch) { return 256 * row + 16 * (ch ^ (((row & 3) << 2) | ((row >> 2) & 3))); }
__device__ __forceinline__ void tr_frag_issue(s16x4& lo, s16x4& hi, LAS unsigned char* img, int r0, int ctile, int lane) {
    const int q = (lane & 15) >> 2, pp = lane & 3;
    lo = __builtin_amdgcn_ds_read_tr16_b64_v4i16((LAS s16x4*)(img + img_off(r0 + q, 2 * ctile + (pp >> 1)) + 8 * (pp & 1)));
    hi = __builtin_amdgcn_ds_read_tr16_b64_v4i16((LAS s16x4*)(img + img_off(r0 + 4 + q, 2 * ctile + (pp >> 1)) + 8 * (pp & 1)));
}
__device__ __forceinline__ bf16x8 frag8(const s16x4& lo, const s16x4& hi) { return (bf16x8){lo[0], lo[1], lo[2], lo[3], hi[0], hi[1], hi[2], hi[3]}; }
__device__ __forceinline__ float clamp80(float x) { return fminf(fmaxf(x, -80.f), 80.f); }
constexpr int HG_V = 0, HG_K = 16384, HG_Q = 32768, HG_QH = 49152, HG_P = 65536, HG_SEG = 73728, HG_RED = 77824;

__device__ __forceinline__ void hgrn_cumsum(const Frame& F, const unsigned (&lf)[8], float (&b0)[8], float (&b1)[8], float& B0, float& B1) {
    LAS float* SEG = (LAS float*)(F.lds + HG_SEG);
    float c0 = 0.f, c1 = 0.f;
#pragma unroll
    for (int r = 0; r < 8; ++r) { c0 += __uint_as_float(lf[r] << 16); c1 += __uint_as_float(lf[r] & 0xffff0000u); b0[r] = c0; b1[r] = c1; }
    *(LAS f32x2*)(SEG + F.wave * 128 + 2 * F.lane) = (f32x2){c0, c1};
    __syncthreads();
    float p0 = 0.f, p1 = 0.f; B0 = 0.f; B1 = 0.f;
#pragma unroll
    for (int j = 0; j < 8; ++j) { const f32x2 s = *(const LAS f32x2*)(SEG + j * 128 + 2 * F.lane); if (j < F.wave) { p0 += s[0]; p1 += s[1]; } B0 += s[0]; B1 += s[1]; }
#pragma unroll
    for (int r = 0; r < 8; ++r) { b0[r] += p0; b1[r] += p1; }
}
__device__ __forceinline__ void hgrn_v_to_lds(const Frame& F, const bf16_t* HV, size_t tok0, int h) {
#pragma unroll
    for (int i = 0; i < 2; ++i) { const int qd = F.tid + 512 * i, row = qd >> 4, ch = qd & 15;
        const u32x4 v = *(const u32x4*)(HV + (tok0 + row) * 1024 + h * 128 + ch * 8);
        *(LAS u32x4*)(F.lds + HG_V + img_off(row, ch)) = v; }
}
__device__ __forceinline__ void p2_hgrn_local(const Frame& F0, const P& p) { const Frame F = phase_frame(F0);
    const bf16_t* LOGF = (const bf16_t*)(p.ws + OFF_LOGF); const bf16_t* HV = (const bf16_t*)(p.ws + OFF_HV);
    bf16_t* SLOC = (bf16_t*)(p.ws + OFF_SLOC); float* DEC = (float*)(p.ws + OFF_DEC);
    const int w = F.wave, lane = F.lane, g = lane >> 4;
    for (int it = F.vcu; it < 4096; it += F.G) {
        const int bh = it >> 7, n = it & 127, b = bh >> 3, h = bh & 7; const size_t tok0 = (size_t)b * SEQ + n * 64;
        const size_t gbase = (tok0 + 8 * w) * 1024 + h * 128 + 2 * lane;
        unsigned lf[8];
#pragma unroll
        for (int r = 0; r < 8; ++r) lf[r] = *(const unsigned*)(LOGF + gbase + (size_t)r * 1024);
        hgrn_v_to_lds(F, HV, tok0, h);
        float b0[8], b1[8], B0, B1;
        hgrn_cumsum(F, lf, b0, b1, B0, B1);
#pragma unroll
        for (int r = 0; r < 8; ++r) { const float l0 = __uint_as_float(lf[r] << 16), l1 = __uint_as_float(lf[r] & 0xffff0000u);
            const float k0 = (1.f - __expf(l0)) * __expf(B0 - b0[r]), k1 = (1.f - __expf(l1)) * __expf(B1 - b1[r]);
            *(LAS unsigned*)(F.lds + HG_K + img_off(8 * w + r, lane >> 2) + (lane & 3) * 4) = cvt_pk_bf16(k0, k1); }
        if (w == 0) *(f32x2*)(DEC + (size_t)it * 128 + 2 * lane) = (f32x2){__expf(B0), __expf(B1)};
        __syncthreads();
        s16x4 al[2], ah[2];
#pragma unroll
        for (int ks = 0; ks < 2; ++ks) tr_frag_issue(al[ks], ah[ks], F.lds + HG_K, 32 * ks + 8 * g, w, lane);
        f32x4 acc[8];
#pragma unroll
        for (int vt = 0; vt < 8; ++vt) {
            s16x4 bl[2], bh2[2];
#pragma unroll
            for (int ks = 0; ks < 2; ++ks) tr_frag_issue(bl[ks], bh2[ks], F.lds + HG_V, 32 * ks + 8 * g, vt, lane);
            acc[vt] = (f32x4){0.f, 0.f, 0.f, 0.f};
#pragma unroll
            for (int ks = 0; ks < 2; ++ks) acc[vt] = __builtin_amdgcn_mfma_f32_16x16x32_bf16(frag8(al[ks], ah[ks]), frag8(bl[ks], bh2[ks]), acc[vt], 0, 0, 0);
        }
#pragma unroll
        for (int vt = 0; vt < 8; ++vt) { u32x2 o; o.x = cvt_pk_bf16(acc[vt][0], acc[vt][1]); o.y = cvt_pk_bf16(acc[vt][2], acc[vt][3]);
            *(u32x2*)(SLOC + (size_t)it * 16384 + (size_t)(16 * vt + (lane & 15)) * 128 + 16 * w + 4 * g) = o; }
        __syncthreads();
    }
}
__device__ __forceinline__ void p3_hgrn_scan(const Frame& F0, const P& p) { const Frame F = phase_frame(F0);
    const bf16_t* SLOC = (const bf16_t*)(p.ws + OFF_SLOC); const float* DEC = (const float*)(p.ws + OFF_DEC); bf16_t* STATE = (bf16_t*)(p.ws + OFF_STATE);
    for (int gid = F.vcu * 512 + F.tid; gid < 32 * 4096; gid += F.G * 512) {
        const int bh = gid >> 12, e = (gid & 4095) * 4, c = e & 127;
        f32x4 st = {0.f, 0.f, 0.f, 0.f};
        for (int n0 = 0; n0 < 128; n0 += 8) {
            u32x2 sl[8]; f32x4 dc[8];
#pragma unroll
            for (int j = 0; j < 8; ++j) { const size_t it = (size_t)bh * 128 + n0 + j; sl[j] = *(const u32x2*)(SLOC + it * 16384 + e); dc[j] = *(const f32x4*)(DEC + it * 128 + c); }
#pragma unroll
            for (int j = 0; j < 8; ++j) { const size_t it = (size_t)bh * 128 + n0 + j;
                u32x2 o; o.x = cvt_pk_bf16(st[0], st[1]); o.y = cvt_pk_bf16(st[2], st[3]); *(u32x2*)(STATE + it * 16384 + e) = o;
                st[0] = dc[j][0] * st[0] + __uint_as_float(sl[j].x << 16); st[1] = dc[j][1] * st[1] + __uint_as_float(sl[j].x & 0xffff0000u);
                st[2] = dc[j][2] * st[2] + __uint_as_float(sl[j].y << 16); st[3] = dc[j][3] * st[3] + __uint_as_float(sl[j].y & 0xffff0000u); }
        }
    }
}
__device__ __forceinline__ void p4_hgrn_out(const Frame& F0, const P& p) { const Frame F = phase_frame(F0);
    const bf16_t* HQ = (const bf16_t*)(p.ws + OFF_HQ); const bf16_t* LOGF = (const bf16_t*)(p.ws + OFF_LOGF); const bf16_t* HV = (const bf16_t*)(p.ws + OFF_HV); const bf16_t* HG = (const bf16_t*)(p.ws + OFF_HG);
    const bf16_t* STATE = (const bf16_t*)(p.ws + OFF_STATE); bf16_t* AOUT = (bf16_t*)(p.ws + OFF_AOUT);
    const int w = F.wave, lane = F.lane, g = lane >> 4, l15 = lane & 15, tt = w & 3, vh = w >> 2;
    LAS float* RED = (LAS float*)(F.lds + HG_RED);
    unsigned* qhead = (unsigned*)(p.ws + WS_CTL) + CW_QH; LAS int* slot = (LAS int*)(F.lds + MISC_OFF + 768);
    if (F.tid == 0) { slot[1] = (int)__hip_atomic_fetch_add(qhead, 1u, __ATOMIC_RELAXED, __HIP_MEMORY_SCOPE_AGENT); slot[2] = (int)__hip_atomic_fetch_add(qhead, 1u, __ATOMIC_RELAXED, __HIP_MEMORY_SCOPE_AGENT); }
    __syncthreads();
    int it = __builtin_amdgcn_readfirstlane(slot[1]), itn = __builtin_amdgcn_readfirstlane(slot[2]), par = 0;
    unsigned lfN[8], qqN[8]; u32x2 hgN[4]; u32x4 vN[2];
#define HGO_PRE(item) do { const int bh_ = (item) >> 7, n_ = (item) & 127, b_ = bh_ >> 3, h_ = bh_ & 7; const size_t tok_ = (size_t)b_ * SEQ + n_ * 64, gb_ = (tok_ + 8 * w) * 1024 + h_ * 128 + 2 * lane; \
        _Pragma("unroll") for (int r = 0; r < 8; ++r) { lfN[r] = *(const unsigned*)(LOGF + gb_ + (size_t)r * 1024); qqN[r] = *(const unsigned*)(HQ + gb_ + (size_t)r * 1024); } \
        _Pragma("unroll") for (int vt = 0; vt < 4; ++vt) hgN[vt] = *(const u32x2*)(HG + (tok_ + 16 * tt + l15) * 1024 + h_ * 128 + 64 * vh + 16 * vt + 4 * g); \
        _Pragma("unroll") for (int i = 0; i < 2; ++i) { const int qd = F.tid + 512 * i, row = qd >> 4, ch = qd & 15; vN[i] = *(const u32x4*)(HV + (tok_ + row) * 1024 + h_ * 128 + ch * 8); } } while (0)
    if (it < 4096) HGO_PRE(it);
    while (it < 4096) {
        if (F.tid == 0) slot[3 + par] = (int)__hip_atomic_fetch_add(qhead, 1u, __ATOMIC_RELAXED, __HIP_MEMORY_SCOPE_AGENT);
        const int bh = it >> 7, n = it & 127, b = bh >> 3, h = bh & 7; const size_t tok0 = (size_t)b * SEQ + n * 64;
        bf16x8 sfr[4][4];
#pragma unroll
        for (int vt = 0; vt < 4; ++vt)
#pragma unroll
            for (int ks = 0; ks < 4; ++ks) sfr[vt][ks] = *(const bf16x8*)(STATE + (size_t)it * 16384 + (size_t)(64 * vh + 16 * vt + l15) * 128 + 32 * ks + 8 * g);
        u32x2 hgv[4]; unsigned lf[8], qq[8];
#pragma unroll
        for (int vt = 0; vt < 4; ++vt) hgv[vt] = hgN[vt];
#pragma unroll
        for (int r = 0; r < 8; ++r) { lf[r] = lfN[r]; qq[r] = qqN[r]; }
#pragma unroll
        for (int i = 0; i < 2; ++i) { const int qd = F.tid + 512 * i, row = qd >> 4, ch = qd & 15; *(LAS u32x4*)(F.lds + HG_V + img_off(row, ch)) = vN[i]; }
        { const int nx = itn < 4096 ? itn : 4095; HGO_PRE(nx); }
        float b0[8], b1[8], B0, B1;
        hgrn_cumsum(F, lf, b0, b1, B0, B1);
        const float r0 = 0.5f * B0, r1 = 0.5f * B1;
#pragma unroll
        for (int r = 0; r < 8; ++r) { const float l0 = __uint_as_float(lf[r] << 16), l1 = __uint_as_float(lf[r] & 0xffff0000u), q0 = __uint_as_float(qq[r] << 16), q1 = __uint_as_float(qq[r] & 0xffff0000u);
            const int off = img_off(8 * w + r, lane >> 2) + (lane & 3) * 4;
            *(LAS unsigned*)(F.lds + HG_Q + off) = cvt_pk_bf16(q0 * __expf(clamp80(b0[r] - r0)), q1 * __expf(clamp80(b1[r] - r1)));
            *(LAS unsigned*)(F.lds + HG_K + off) = cvt_pk_bf16((1.f - __expf(l0)) * __expf(clamp80(r0 - b0[r])), (1.f - __expf(l1)) * __expf(clamp80(r1 - b1[r])));
            *(LAS unsigned*)(F.lds + HG_QH + off) = cvt_pk_bf16(q0 * __expf(b0[r]), q1 * __expf(b1[r])); }
        __syncthreads();
#pragma unroll
        for (int si = 0; si < 2; ++si) { const int st = 2 * vh + si; f32x4 sc = {0.f, 0.f, 0.f, 0.f};
#pragma unroll
            for (int ks = 0; ks < 4; ++ks) { const bf16x8 a = *(const LAS bf16x8*)(F.lds + HG_K + img_off(16 * st + l15, 4 * ks + g)), bq = *(const LAS bf16x8*)(F.lds + HG_Q + img_off(16 * tt + l15, 4 * ks + g));
                sc = __builtin_amdgcn_mfma_f32_16x16x32_bf16(a, bq, sc, 0, 0, 0); }
#pragma unroll
            for (int rg = 0; rg < 4; ++rg) sc[rg] = (16 * st + 4 * g + rg > 16 * tt + l15) ? 0.f : sc[rg];
            const int t = 16 * tt + l15, chunk = 2 * st + (g >> 1);
            u32x2 o; o.x = cvt_pk_bf16(sc[0], sc[1]); o.y = cvt_pk_bf16(sc[2], sc[3]);
            *(LAS u32x2*)(F.lds + HG_P + t * 128 + ((chunk ^ (t & 7)) * 16) + 8 * (g & 1)) = o; }
        __syncthreads();
        bf16x8 pb[2], qb[4];
        { const int t = 16 * tt + l15;
#pragma unroll
          for (int ks = 0; ks < 2; ++ks) pb[ks] = *(const LAS bf16x8*)(F.lds + HG_P + t * 128 + (((4 * ks + g) ^ (t & 7)) * 16));
#pragma unroll
          for (int ks = 0; ks < 4; ++ks) qb[ks] = *(const LAS bf16x8*)(F.lds + HG_QH + img_off(t, 4 * ks + g)); }
        f32x4 oacc[4]; float ssq = 0.f;
#pragma unroll
        for (int vt = 0; vt < 4; ++vt) {
            s16x4 vl[2], vhh[2];
#pragma unroll
            for (int ks = 0; ks < 2; ++ks) tr_frag_issue(vl[ks], vhh[ks], F.lds + HG_V, 32 * ks + 8 * g, 4 * vh + vt, lane);
            f32x4 a = {0.f, 0.f, 0.f, 0.f};
#pragma unroll
            for (int ks = 0; ks < 2; ++ks) a = __builtin_amdgcn_mfma_f32_16x16x32_bf16(frag8(vl[ks], vhh[ks]), pb[ks], a, 0, 0, 0);
#pragma unroll
            for (int ks = 0; ks < 4; ++ks) a = __builtin_amdgcn_mfma_f32_16x16x32_bf16(sfr[vt][ks], qb[ks], a, 0, 0, 0);
            oacc[vt] = a; ssq += a[0] * a[0] + a[1] * a[1] + a[2] * a[2] + a[3] * a[3];
        }
        ssq += __shfl_xor(ssq, 16); ssq += __shfl_xor(ssq, 32);
        if (g == 0) RED[(16 * tt + l15) * 2 + vh] = ssq;
        __syncthreads();
        { const int t = 16 * tt + l15; const float tot = RED[t * 2] + RED[t * 2 + 1], rs = rsqrtf(tot * (1.f / 128.f) + EPS);
#pragma unroll
          for (int vt = 0; vt < 4; ++vt) { const int v0 = 64 * vh + 16 * vt + 4 * g; const f32x4 gn = *(const f32x4*)(p.hg_norm + v0);
              const float y0 = oacc[vt][0] * rs * gn[0] * __uint_as_float(hgv[vt].x << 16), y1 = oacc[vt][1] * rs * gn[1] * __uint_as_float(hgv[vt].x & 0xffff0000u);
              const float y2 = oacc[vt][2] * rs * gn[2] * __uint_as_float(hgv[vt].y << 16), y3 = oacc[vt][3] * rs * gn[3] * __uint_as_float(hgv[vt].y & 0xffff0000u);
              u32x2 o; o.x = cvt_pk_bf16(y0, y1); o.y = cvt_pk_bf16(y2, y3);
              *(u32x2*)(AOUT + (tok0 + t) * 1024 + h * 128 + v0) = o; } }
        __syncthreads();
        it = itn; itn = __builtin_amdgcn_readfirstlane(slot[3 + par]); par ^= 1;
    }
#undef HGO_PRE
}

namespace fox {
constexpr int NW = 8, QBLK = 32, KVBLK = 64, QB = NW * QBLK, D = 128, RS = 1024;
constexpr int SHM_V = KVBLK * D * 2, SHM_K = KVBLK * D * 2;
constexpr int OFF_VL = 0, OFF_KL = 2 * SHM_V, OFF_WS = 2 * SHM_V + 2 * SHM_K, OFF_BIAS = OFF_WS + NW * 64 * 4, OFF_ITEM = OFF_BIAS + 2 * 64 * 4;
constexpr float THR = 8.f;
typedef float f32x16 __attribute__((ext_vector_type(16)));
#define KSWZ(row, colB) ((row) * 256 + ((colB) ^ (((row) & 7) << 4)))
#define SBAR() __builtin_amdgcn_sched_barrier(0)
__device__ __forceinline__ int v_st(int k, int c) { const int kk = (k & ~0xC) | ((k & 4) << 1) | ((k & 8) >> 1); return ((kk >> 3) * 4 + (c >> 5)) * 512 + ((kk & 7) * 32 + (c & 31)) * 2; }
__device__ __forceinline__ int v_rd_base(int lane) { return ((lane & 3) << 3) | (((lane >> 2) & 3) << 6) | (((lane >> 4) & 1) << 5) | (((lane >> 5) & 1) << 8); }
constexpr int v_rd_off(int d0, int ks, int half) { return d0 * 512 + ks * 4096 + half * 2048; }
__device__ __forceinline__ int crow(int r, int hi) { return (r & 3) + 8 * (r >> 2) + 4 * hi; }
__device__ __forceinline__ void mask_tile(f32x16& p0, f32x16& p1, int dq) {
    const float NEG = -__builtin_inff();
#pragma unroll
    for (int r = 0; r < 16; ++r) { const int c = (r & 3) + 8 * (r >> 2); if (dq - c < 0) p0[r] = NEG; if (dq - c - 32 < 0) p1[r] = NEG; }
}
__device__ __forceinline__ void partialSM(f32x16& p0, f32x16& p1, float& m_reg, float& mn, float& alpha) {
    float pmax = p0[0];
#pragma unroll
    for (int r = 1; r < 16; ++r) pmax = fmaxf(pmax, p0[r]);
#pragma unroll
    for (int r = 0; r < 16; ++r) pmax = fmaxf(pmax, p1[r]);
    { auto rr = __builtin_amdgcn_permlane32_swap(__float_as_uint(pmax), __float_as_uint(pmax), false, false); pmax = fmaxf(__uint_as_float(rr[0]), __uint_as_float(rr[1])); }
    constexpr float C2 = 1.4426950408889634f;
    if (__builtin_expect(__all((pmax - m_reg) <= THR), 1)) { mn = m_reg; alpha = 1.f; }
    else { mn = fmaxf(m_reg, pmax); alpha = __builtin_amdgcn_exp2f((m_reg - mn) * C2); m_reg = mn; }
    const float mnL = -mn * C2;
#pragma unroll
    for (int r = 0; r < 16; ++r) p0[r] = fmaf(p0[r], C2, mnL);
#pragma unroll
    for (int r = 0; r < 16; ++r) p1[r] = fmaf(p1[r], C2, mnL);
#pragma unroll
    for (int r = 0; r < 16; ++r) p0[r] = __builtin_amdgcn_exp2f(p0[r]);
}
__device__ __forceinline__ void finishSM(f32x16& p0, f32x16& p1, float alpha, float& l_reg, bf16x8& pa0, bf16x8& pa1, bf16x8& pa2, bf16x8& pa3) {
#pragma unroll
    for (int r = 0; r < 16; ++r) p1[r] = __builtin_amdgcn_exp2f(p1[r]);
    float ps = 0;
#pragma unroll
    for (int r = 0; r < 16; ++r) ps += p0[r];
#pragma unroll
    for (int r = 0; r < 16; ++r) ps += p1[r];
    { auto rr = __builtin_amdgcn_permlane32_swap(__float_as_uint(ps), __float_as_uint(ps), false, false); ps = __uint_as_float(rr[0]) + __uint_as_float(rr[1]); }
    l_reg = l_reg * alpha + ps;
#define PK4(P, B_, OUT) do { unsigned a0 = cvt_pk_bf16(P[B_+0], P[B_+1]), a1 = cvt_pk_bf16(P[B_+2], P[B_+3]); unsigned b0 = cvt_pk_bf16(P[B_+4], P[B_+5]), b1 = cvt_pk_bf16(P[B_+6], P[B_+7]); \
        auto r0 = __builtin_amdgcn_permlane32_swap(a0, b0, false, false); auto r1 = __builtin_amdgcn_permlane32_swap(a1, b1, false, false); \
        u32x4 w = {r0[0], r1[0], r0[1], r1[1]}; OUT = *reinterpret_cast<bf16x8*>(&w); } while (0)
    PK4(p0, 0, pa0); PK4(p0, 8, pa1); PK4(p1, 0, pa2); PK4(p1, 8, pa3);
#undef PK4
}
template <int KB>
__device__ __forceinline__ void qkt(f32x16& p0, f32x16& p1, const LAS char* lds, int r32, int hi, const bf16x8* qr) {
    const LAS float* bb = (const LAS float*)(lds + OFF_BIAS) + KB * 64 + 4 * hi;
#pragma unroll
    for (int j = 0; j < 4; ++j) { const f32x4 a = *(const LAS f32x4*)(bb + 8 * j), b = *(const LAS f32x4*)(bb + 32 + 8 * j);
        p0[4 * j] = a[0]; p0[4 * j + 1] = a[1]; p0[4 * j + 2] = a[2]; p0[4 * j + 3] = a[3]; p1[4 * j] = b[0]; p1[4 * j + 1] = b[1]; p1[4 * j + 2] = b[2]; p1[4 * j + 3] = b[3]; }
    const LAS char* kb[4];
#pragma unroll
    for (int dd = 0; dd < 4; ++dd) kb[dd] = lds + OFF_KL + KB * SHM_K + KSWZ(r32, (dd * 16 + hi * 8) * 2);
#pragma unroll
    for (int d0 = 0; d0 < 8; ++d0) { const LAS char* a = kb[d0 & 3] + (d0 >> 2) * 128;
        const bf16x8 b0 = *reinterpret_cast<const LAS bf16x8*>(a), b1 = *reinterpret_cast<const LAS bf16x8*>(a + 32 * 256);
        p0 = __builtin_amdgcn_mfma_f32_32x32x16_bf16(b0, qr[d0], p0, 0, 0, 0);
        p1 = __builtin_amdgcn_mfma_f32_32x32x16_bf16(b1, qr[d0], p1, 0, 0, 0); }
}
template <int VB>
__device__ __forceinline__ void pv_tile(f32x16* o, const LAS char* vb0, bf16x8 pa0, bf16x8 pa1, bf16x8 pa2, bf16x8 pa3) {
#define TRR(off) __builtin_amdgcn_ds_read_tr16_b64_v4i16((LAS s16x4*)(vb0 + (off)))
#define PV_D0(d0) do { constexpr int b_ = VB * SHM_V + v_rd_off(d0, 0, 0); \
        const s16x4 l0 = TRR(b_), h0 = TRR(b_ + 2048), l1 = TRR(b_ + 4096), h1 = TRR(b_ + 6144), l2 = TRR(b_ + 8192), h2 = TRR(b_ + 10240), l3 = TRR(b_ + 12288), h3 = TRR(b_ + 14336); \
        o[d0] = __builtin_amdgcn_mfma_f32_32x32x16_bf16(pa0, (bf16x8){l0[0], l0[1], l0[2], l0[3], h0[0], h0[1], h0[2], h0[3]}, o[d0], 0, 0, 0); \
        o[d0] = __builtin_amdgcn_mfma_f32_32x32x16_bf16(pa1, (bf16x8){l1[0], l1[1], l1[2], l1[3], h1[0], h1[1], h1[2], h1[3]}, o[d0], 0, 0, 0); \
        o[d0] = __builtin_amdgcn_mfma_f32_32x32x16_bf16(pa2, (bf16x8){l2[0], l2[1], l2[2], l2[3], h2[0], h2[1], h2[2], h2[3]}, o[d0], 0, 0, 0); \
        o[d0] = __builtin_amdgcn_mfma_f32_32x32x16_bf16(pa3, (bf16x8){l3[0], l3[1], l3[2], l3[3], h3[0], h3[1], h3[2], h3[3]}, o[d0], 0, 0, 0); } while (0)
    PV_D0(0); PV_D0(1); PV_D0(2); PV_D0(3);
#undef PV_D0
#undef TRR
}
struct BlockRef { const bf16_t* Q; const bf16_t* K; const bf16_t* V; bf16_t* O; const float* Cp; int P0, jlo; float cref; };
struct Seam { bf16x8 qr[8]; bf16x8 st_v0, st_v1, st_k0, st_k1; float sb0, sb1; };
#define ROW(p, k0, rr) ((p) + (size_t)((k0) + (rr)) * RS + sc)
#define VMW() asm volatile("s_waitcnt vmcnt(0)" ::: "memory")
#define VMWN(n) asm volatile("s_waitcnt vmcnt(%0)" :: "i"(n) : "memory")
#define SLOAD_H(R, k0) do { S.st_v0 = *(const bf16x8*)ROW((R).V, k0, sr); S.st_v1 = *(const bf16x8*)ROW((R).V, k0, 32 + sr); S.st_k0 = *(const bf16x8*)ROW((R).K, k0, sr); S.st_k1 = *(const bf16x8*)ROW((R).K, k0, 32 + sr); \
        S.sb0 = (R).Cp[(size_t)((k0) + sr) * 8]; S.sb1 = (R).Cp[(size_t)((k0) + 32 + sr) * 8]; } while (0)
#define SWRITE_HK(bf, cr) do { *(LAS bf16x8*)(K_lds + (bf) * SHM_K + kws) = S.st_k0; *(LAS bf16x8*)(K_lds + (bf) * SHM_K + kws + 32 * 256) = S.st_k1; \
        if (sc == 0) { BIASL[(bf) * 64 + sr] = (cr) - S.sb0; BIASL[(bf) * 64 + 32 + sr] = (cr) - S.sb1; } } while (0)
#define SWRITE_HV(bf) do { *(LAS bf16x8*)(V_lds + (bf) * SHM_V + vst0) = S.st_v0; *(LAS bf16x8*)(V_lds + (bf) * SHM_V + vst1) = S.st_v1; } while (0)
#define SWRITE_H(bf, cr) do { SWRITE_HV(bf); SWRITE_HK(bf, cr); } while (0)
__device__ __forceinline__ void prime(const BlockRef& cur, LAS char* lds, Seam& S) {
    int tid = threadIdx.x; asm volatile("" : "+v"(tid)); const int wid = __builtin_amdgcn_readfirstlane(tid >> 6), lane = tid & 63, r32 = lane & 31, hi = lane >> 5;
    const int sr = tid >> 4, sc = (tid & 15) * 8, kws = KSWZ(sr, sc * 2); LAS char* K_lds = lds + OFF_KL; LAS float* BIASL = (LAS float*)(lds + OFF_BIAS);
    const int kb0 = cur.jlo * KVBLK;
#pragma unroll
    for (int d0 = 0; d0 < 8; ++d0) S.qr[d0] = *(const bf16x8*)(cur.Q + (size_t)(wid * QBLK + r32) * RS + d0 * 16 + hi * 8);
    SLOAD_H(cur, kb0); VMW(); SWRITE_HK(0, cur.cref);
    __syncthreads();
}
__device__ __forceinline__ void block(const BlockRef& cur, const BlockRef& nxt, LAS char* lds, Seam& S) {
    const int tid = threadIdx.x, wid = __builtin_amdgcn_readfirstlane(tid >> 6), lane = tid & 63, r32 = lane & 31, hi = lane >> 5;
    const int j_lo = cur.jlo, j_hi = (cur.P0 + QB - 1) / KVBLK + 1, NT = j_hi - j_lo;
    const int kbn = nxt.jlo * KVBLK;
    const int qlo = cur.P0 + wid * QBLK, qm = qlo + r32 - 4 * hi;
    LAS char* V_lds = lds + OFF_VL; LAS char* K_lds = lds + OFF_KL; LAS float* BIASL = (LAS float*)(lds + OFF_BIAS);
    LAS float* ws = (LAS float*)(lds + OFF_WS) + wid * 64; LAS float* li_l = ws; LAS float* al_l = ws + 32;
    float m_reg = -1e30f, l_reg = 0; f32x16 o[4] = {};
    const int sr = tid >> 4, sc = (tid & 15) * 8, vst0 = v_st(sr, sc), vst1 = v_st(32 + sr, sc), kws = KSWZ(sr, sc * 2);
    const LAS char* vb0 = V_lds + v_rd_base(lane);
#define RESC(a) do { if (__any((a) < 1.f)) { if (hi == 0) al_l[r32] = (a); asm volatile("s_waitcnt lgkmcnt(0)" ::: "memory"); \
                     for (int d_ = 0; d_ < 4; ++d_) for (int r = 0; r < 16; ++r) o[d_][r] *= al_l[crow(r, hi)]; } } while (0)
#define KBASE(t) ((j_lo + (t)) * KVBLK)
#define MASKT(P0_, P1_, t) do { const int kb_ = KBASE(t); if (kb_ + KVBLK - 1 > qlo) mask_tile(P0_, P1_, qm - kb_); } while (0)
#define SEAM_K0() do { VMWN(8); SWRITE_HK(0, nxt.cref); SBAR(); } while (0)
    f32x16 pA0, pA1, pB0, pB1; float mnA, mnB, alA, alB; bf16x8 pa0, pa1, pa2, pa3;
    SWRITE_HV(0); SBAR();
    if (NT > 1) SLOAD_H(cur, KBASE(1));
    SBAR(); qkt<0>(pA0, pA1, lds, r32, hi, S.qr);
    mask_tile(pA0, pA1, qm - KBASE(0)); partialSM(pA0, pA1, m_reg, mnA, alA);
    if (NT > 1) { VMW(); SWRITE_H(1, cur.cref); }
    __syncthreads();
#define HALF_STEP(PX0, PX1, mnX, alX, PY0, PY1, alY, t, KB, VB, SB) do { \
        SBAR(); qkt<KB>(PX0, PX1, lds, r32, hi, S.qr); \
        finishSM(PY0, PY1, alY, l_reg, pa0, pa1, pa2, pa3); SBAR(); \
        if ((t) + 1 < NT) { SLOAD_H(cur, KBASE((t) + 1)); SBAR(); } \
        pv_tile<VB>(o, vb0, pa0, pa1, pa2, pa3); MASKT(PX0, PX1, (t)); partialSM(PX0, PX1, m_reg, mnX, alX); \
        __syncthreads(); \
        if ((t) + 1 < NT) { VMW(); SWRITE_H(SB, cur.cref); } \
        RESC(alX); __syncthreads(); } while (0)
    for (int t = 1; t + 1 < NT; t += 2) {
        HALF_STEP(pB0, pB1, mnB, alB, pA0, pA1, alA, t, 1, 0, 0);
        HALF_STEP(pA0, pA1, mnA, alA, pB0, pB1, alB, t + 1, 0, 1, 1);
    }
    const bool even = (NT & 1) == 0;
    if (even) { SBAR(); qkt<1>(pB0, pB1, lds, r32, hi, S.qr); SBAR(); }
    SLOAD_H(nxt, kbn); SBAR();
#pragma unroll
    for (int d0 = 0; d0 < 8; ++d0) S.qr[d0] = *(const bf16x8*)(nxt.Q + (size_t)(wid * QBLK + r32) * RS + d0 * 16 + hi * 8);
    SBAR();
    finishSM(pA0, pA1, alA, l_reg, pa0, pa1, pa2, pa3); SBAR();
    pv_tile<0>(o, vb0, pa0, pa1, pa2, pa3);
    if (even) { MASKT(pB0, pB1, NT - 1); partialSM(pB0, pB1, m_reg, mnB, alB); __syncthreads(); RESC(alB);
        finishSM(pB0, pB1, alB, l_reg, pa0, pa1, pa2, pa3); SBAR(); pv_tile<1>(o, vb0, pa0, pa1, pa2, pa3); }
    SBAR(); SEAM_K0();
    if (hi == 0) li_l[r32] = l_reg; asm volatile("s_waitcnt lgkmcnt(0)" ::: "memory");
    const __amdgpu_buffer_rsrc_t orsrc = __builtin_amdgcn_make_buffer_rsrc((void*)(cur.O + (size_t)(wid * QBLK) * RS), 0, QBLK * RS * 2, 0x00020000);
    const int ovoff = (hi * 4 * RS + r32) * 2;
#pragma unroll
    for (int r = 0; r < 16; ++r) { const int orow0 = (r & 3) + 8 * (r >> 2); const float rl = __builtin_amdgcn_rcpf(li_l[orow0 + 4 * hi]);
#pragma unroll
        for (int d0 = 0; d0 < 4; ++d0) { const float v = o[d0][r] * rl; const float vn = __shfl_xor(v, 1);
            if ((r32 & 1) == 0) __builtin_amdgcn_raw_buffer_store_b32(cvt_pk_bf16(v, vn), orsrc, ovoff, orow0 * RS * 2 + d0 * 64, 0); } }
    __syncthreads();
#undef RESC
#undef KBASE
#undef MASKT
#undef SEAM_K0
#undef HALF_STEP
}
#undef ROW
#undef VMW
#undef VMWN
#undef SLOAD_H
#undef SWRITE_HK
#undef SWRITE_HV
#undef SWRITE_H
#undef KSWZ
#undef SBAR
}
constexpr int CW_ATTQ = 64;
__device__ __forceinline__ void p2_jlo(const Frame& F0, const P& p) { const Frame F = phase_frame(F0);
    const float* C = (const float*)(p.ws + OFF_C); int* JLO = (int*)(p.ws + OFF_JLO);
    const int gw = F.vcu * NWAVES + F.wave, NGW = F.G * NWAVES, lane = F.lane;
    const float gq = wave_max(fmaxf(fabsf(p.fq_norm[2 * lane]), fabsf(p.fq_norm[2 * lane + 1]))), gk = wave_max(fmaxf(fabsf(p.fk_norm[2 * lane]), fabsf(p.fk_norm[2 * lane + 1])));
    const float th = -(2.f * 1.02f * gq * gk * 11.3137085f + 104.f);
    for (int e = gw; e < BATCH * HEADS * 32; e += NGW) {
        const int b = e >> 8, h = (e >> 5) & 7, qb = e & 31, P0 = qb * 256;
        const float* Cp = C + (size_t)b * SEQ * 8 + h; const float c0 = Cp[(size_t)P0 * 8];
        int cnt = 0;
#pragma unroll
        for (int i = 0; i < 2; ++i) { const int j = lane + 64 * i, kl = 64 * j + 63; const bool neg = (kl < P0) && (c0 - Cp[(size_t)(kl < SEQ ? kl : 0) * 8] < th); cnt += __popcll(__ballot(neg)); }
        if (lane == 0) JLO[e] = cnt;
    }
}
__device__ __forceinline__ void p4_attention(const Frame& F0, const P& p, int rep) { const Frame F = phase_frame(F0);
    LAS char* lds = (LAS char*)F.lds; LAS int* ITEM = (LAS int*)(lds + fox::OFF_ITEM);
    const bf16_t* FQ = (const bf16_t*)(p.ws + OFF_FQ); const bf16_t* FK = (const bf16_t*)(p.ws + OFF_FK); const bf16_t* FV = (const bf16_t*)(p.ws + OFF_FV); bf16_t* BOUT = (bf16_t*)(p.ws + OFF_BOUT);
    const float* C = (const float*)(p.ws + OFF_C); const int* JLO = (const int*)(p.ws + OFF_JLO);
    unsigned* qhead = (unsigned*)(p.ws + WS_CTL) + CW_ATTQ + 64 * rep;
    constexpr int TOTAL = BATCH * HEADS * 32;
    if (F.tid == 0) { float fb[8]; for (int i = 0; i < 8; ++i) fb[i] = p.f_bias[i];
        for (int r = 0; r < 8; ++r) { int best = 0; for (int i = 1; i < 8; ++i) if (fb[i] > fb[best]) best = i; ITEM[r] = best; fb[best] = -INFINITY; }
        ITEM[8] = (int)__hip_atomic_fetch_add(qhead, 1u, __ATOMIC_RELAXED, __HIP_MEMORY_SCOPE_AGENT); }
    __syncthreads();
    auto mkref = [&](int L) { fox::BlockRef r; const int hr = L >> 7, rr = L & 127, qb = 31 - (rr >> 2), b = rr & 3, h = __builtin_amdgcn_readfirstlane(ITEM[hr]); const size_t t0 = (size_t)b * SEQ;
        r.Q = FQ + (t0 + qb * 256) * 1024 + h * 128; r.K = FK + t0 * 1024 + h * 128; r.V = FV + t0 * 1024 + h * 128; r.O = BOUT + (t0 + qb * 256) * 1024 + h * 128;
        r.Cp = C + t0 * 8 + h; r.P0 = qb * 256; r.jlo = __builtin_amdgcn_readfirstlane(JLO[(b * 8 + h) * 32 + qb]);
        r.cref = __uint_as_float(__builtin_amdgcn_readfirstlane(__float_as_uint(r.Cp[(size_t)(qb * 256 + 255) * 8]))); return r; };
    int L = __builtin_amdgcn_readfirstlane(ITEM[8]);
    if (L >= TOTAL) return;
    if (F.tid == 0) ITEM[9] = (int)__hip_atomic_fetch_add(qhead, 1u, __ATOMIC_RELAXED, __HIP_MEMORY_SCOPE_AGENT);
    __syncthreads();
    int Ln = __builtin_amdgcn_readfirstlane(ITEM[9]);
    fox::BlockRef cur = mkref(L);
    fox::Seam S;
    fox::prime(cur, lds, S);
    for (int it = 0;; ++it) {
        const bool last = Ln >= TOTAL;
        if (!last && F.tid == 0) ITEM[8 + (it & 1)] = (int)__hip_atomic_fetch_add(qhead, 1u, __ATOMIC_RELAXED, __HIP_MEMORY_SCOPE_AGENT);
        const fox::BlockRef nxt = last ? cur : mkref(Ln);
        fox::block(cur, nxt, lds, S);
        if (last) break;
        cur = nxt; L = Ln; Ln = __builtin_amdgcn_readfirstlane(ITEM[8 + (it & 1)]);
    }
}
__device__ __forceinline__ void p2_qknorm(const Frame& F0, const P& p) { const Frame F = phase_frame(F0);
    bf16_t* FQ = (bf16_t*)(p.ws + OFF_FQ); bf16_t* FK = (bf16_t*)(p.ws + OFF_FK);
    const int gw = F.vcu * NWAVES + F.wave, NGW = F.G * NWAVES, lane = F.lane, d0 = (lane & 7) * 16;
    float gq[16], gk[16];
#pragma unroll
    for (int j = 0; j < 16; ++j) { gq[j] = p.fq_norm[d0 + j] * 0.08838834764831845f; gk[j] = p.fk_norm[d0 + j]; }
    for (int t = gw; t < T; t += NGW) {
#pragma unroll
        for (int which = 0; which < 2; ++which) {
            bf16_t* ptr = (which ? FK : FQ) + (size_t)t * 1024 + lane * 16;
            const u32x4 a = *(const u32x4*)ptr, b = *(const u32x4*)(ptr + 8); const unsigned w[8] = {a.x, a.y, a.z, a.w, b.x, b.y, b.z, b.w};
            float v[16]; float ss = 0.f;
#pragma unroll
            for (int j = 0; j < 8; ++j) { v[2 * j] = __uint_as_float(w[j] << 16); v[2 * j + 1] = __uint_as_float(w[j] & 0xffff0000u); ss += v[2 * j] * v[2 * j] + v[2 * j + 1] * v[2 * j + 1]; }
            ss += __shfl_xor(ss, 1); ss += __shfl_xor(ss, 2); ss += __shfl_xor(ss, 4);
            const float rs = rsqrtf(ss * (1.f / 128.f) + EPS);
            unsigned o[8];
#pragma unroll
            for (int j = 0; j < 8; ++j) o[j] = which ? cvt_pk_bf16(v[2 * j] * rs * gk[2 * j], v[2 * j + 1] * rs * gk[2 * j + 1]) : cvt_pk_bf16(v[2 * j] * rs * gq[2 * j], v[2 * j + 1] * rs * gq[2 * j + 1]);
            *(u32x4*)ptr = (u32x4){o[0], o[1], o[2], o[3]}; *(u32x4*)(ptr + 8) = (u32x4){o[4], o[5], o[6], o[7]};
        }
    }
}
__device__ __forceinline__ void p7_router(const Frame& F0, const P& p) { const Frame F = phase_frame(F0);
    LAS int* hist = (LAS int*)(F.lds + MISC_OFF + 512);
    const bf16_t* X1 = (const bf16_t*)(p.ws + OFF_X1B); unsigned char* H2 = p.ws + OFF_H2; const bf16_t* RWT = (const bf16_t*)(p.ws + OFF_RWT); float* RSTD = (float*)(p.ws + OFF_RSTD);
    int* TOPI = (int*)(p.ws + OFF_TOPI); float* GATE = (float*)(p.ws + OFF_GATE); int* CNT = (int*)(p.ws + OFF_CNT);
    const int lane = F.lane, l15 = lane & 15, kg = lane >> 4;
    for (int blk = F.vcu; blk < T / 128; blk += F.G) {
        if (F.tid < NEXP) hist[F.tid] = 0;
        __syncthreads();
        const int tok = blk * 128 + F.wave * 16 + l15;
        const bf16_t* xr = X1 + (size_t)tok * D_MODEL + 8 * kg; unsigned char* hr = H2 + (size_t)tok * D_MODEL + 8 * kg;
        f32x4 acc0 = {0.f, 0.f, 0.f, 0.f}, acc1 = {0.f, 0.f, 0.f, 0.f}; float ss = 0.f;
#pragma unroll 4
        for (int ks = 0; ks < 64; ++ks) {
            const u32x4 xw = *(const u32x4*)(xr + 32 * ks);
            const f32x4 xa = {__uint_as_float(xw.x << 16), __uint_as_float(xw.x & 0xffff0000u), __uint_as_float(xw.y << 16), __uint_as_float(xw.y & 0xffff0000u)}, xb = {__uint_as_float(xw.z << 16), __uint_as_float(xw.z & 0xffff0000u), __uint_as_float(xw.w << 16), __uint_as_float(xw.w & 0xffff0000u)};
            const f32x4 ga = *(const f32x4*)(p.norm2 + 32 * ks + 8 * kg), gb = *(const f32x4*)(p.norm2 + 32 * ks + 8 * kg + 4);
            const bf16x8 bh0 = *(const bf16x8*)(RWT + (size_t)l15 * D_MODEL + 32 * ks + 8 * kg), bh1 = *(const bf16x8*)(RWT + (size_t)(16 + l15) * D_MODEL + 32 * ks + 8 * kg);
            const bf16x8 bl0 = *(const bf16x8*)(RWT + (size_t)(NEXP + l15) * D_MODEL + 32 * ks + 8 * kg), bl1 = *(const bf16x8*)(RWT + (size_t)(NEXP + 16 + l15) * D_MODEL + 32 * ks + 8 * kg);
            ss += xa[0] * xa[0] + xa[1] * xa[1] + xa[2] * xa[2] + xa[3] * xa[3] + xb[0] * xb[0] + xb[1] * xb[1] + xb[2] * xb[2] + xb[3] * xb[3];
            u32x2 h8; h8.x = pk4_fp8(xa[0] * ga[0], xa[1] * ga[1], xa[2] * ga[2], xa[3] * ga[3]); h8.y = pk4_fp8(xb[0] * gb[0], xb[1] * gb[1], xb[2] * gb[2], xb[3] * gb[3]);
            *(u32x2*)(hr + 32 * ks) = h8;
            const bf16x8 ah = __builtin_bit_cast(bf16x8, xw);
            acc0 = __builtin_amdgcn_mfma_f32_16x16x32_bf16(ah, bh0, acc0, 0, 0, 0); acc1 = __builtin_amdgcn_mfma_f32_16x16x32_bf16(ah, bh1, acc1, 0, 0, 0);
            acc0 = __builtin_amdgcn_mfma_f32_16x16x32_bf16(ah, bl0, acc0, 0, 0, 0); acc1 = __builtin_amdgcn_mfma_f32_16x16x32_bf16(ah, bl1, acc1, 0, 0, 0);
        }
        ss += __shfl_xor(ss, 16); ss += __shfl_xor(ss, 32);
        const float rstd = rsqrtf(ss * (1.f / D_MODEL) + EPS);
        if (kg == 0) RSTD[tok] = rstd;
        const float rb0 = p.router_b[l15], rb1 = p.router_b[16 + l15];
        float v0[4], v1[4];
#pragma unroll
        for (int r = 0; r < 4; ++r) { const float rs = __shfl(rstd, 4 * kg + r); v0[r] = acc0[r] * rs + rb0; v1[r] = acc1[r] * rs + rb1; }
        float tv[4][4]; int ti[4][4];
#pragma unroll
        for (int k = 0; k < 4; ++k)
#pragma unroll
            for (int r = 0; r < 4; ++r) {
                float bv = v0[r]; int bi = l15; if (v1[r] > bv) { bv = v1[r]; bi = 16 + l15; }
#pragma unroll
                for (int msk = 1; msk < 16; msk <<= 1) { const float ov = __shfl_xor(bv, msk); const int oi = __shfl_xor(bi, msk); if (ov > bv || (ov == bv && oi < bi)) { bv = ov; bi = oi; } }
                tv[k][r] = bv; ti[k][r] = bi; if (bi == l15) v0[r] = -INFINITY; if (bi == 16 + l15) v1[r] = -INFINITY;
            }
        if (l15 == 0) {
#pragma unroll
            for (int r = 0; r < 4; ++r) { const int t = blk * 128 + F.wave * 16 + 4 * kg + r;
                const float e1 = __expf(tv[1][r] - tv[0][r]), e2 = __expf(tv[2][r] - tv[0][r]), e3 = __expf(tv[3][r] - tv[0][r]), inv = 1.f / (1.f + e1 + e2 + e3);
                *(int4*)(TOPI + (size_t)t * 4) = make_int4(ti[0][r], ti[1][r], ti[2][r], ti[3][r]); *(float4*)(GATE + (size_t)t * 4) = make_float4(inv, e1 * inv, e2 * inv, e3 * inv);
                atomicAdd((int*)&hist[ti[0][r]], 1); atomicAdd((int*)&hist[ti[1][r]], 1); atomicAdd((int*)&hist[ti[2][r]], 1); atomicAdd((int*)&hist[ti[3][r]], 1); }
        }
        __syncthreads();
        if (F.tid < NEXP) CNT[blk * NEXP + F.tid] = hist[F.tid];
        __syncthreads();
    }
}
__device__ __forceinline__ void p8_scatter(const Frame& F0, const P& p) { const Frame F = phase_frame(F0);
    LAS int* base = (LAS int*)(F.lds + 0); LAS int* tot = base + 32; LAS int* segs = base + 64; LAS int* spos = base + 128;
    const int tid = F.tid, lane = F.lane;
    const int* CNT = (const int*)(p.ws + OFF_CNT); const int* TOPI = (const int*)(p.ws + OFF_TOPI); const float* GATE = (const float*)(p.ws + OFF_GATE);
    int* POS = (int*)(p.ws + OFF_POS); float* ROWW = (float*)(p.ws + OFF_ROWW); int* TILEE = (int*)(p.ws + OFF_TILEE);
    int* ROWTOK = (int*)(p.ws + OFF_ROWTOK); float* ROWRS = (float*)(p.ws + OFF_ROWRS); const float* RSTD = (const float*)(p.ws + OFF_RSTD);
    for (int wg = F.vcu; wg < RT_WGS; wg += F.G) {
        { LAS int* redb = base + 1024; LAS int* redt = redb + 512;
          const int e = tid & 31, part = tid >> 5; int before = 0, total = 0;
#pragma unroll
          for (int j = 0; j < 16; ++j) { const int w = part * 16 + j; const int c = CNT[w * NEXP + e]; total += c; before += (w < wg) ? c : 0; }
          redb[tid] = before; redt[tid] = total;
          __syncthreads();
          if (tid < NEXP) { int b2 = 0, t2 = 0;
#pragma unroll
              for (int q = 0; q < 16; ++q) { b2 += redb[q * 32 + tid]; t2 += redt[q * 32 + tid]; }
              base[tid] = b2; tot[tid] = t2; } }
        __syncthreads();
        if (tid == 0) { int s = 0; for (int e = 0; e < NEXP; ++e) { segs[e] = s; s += (tot[e] + 255) & ~255; } segs[NEXP] = s; }
        __syncthreads();
        if (wg == 0) {
            for (int e = 0; e < NEXP; ++e) { const int t0 = segs[e] >> 8, t1 = segs[e + 1] >> 8; for (int tt = t0 + tid; tt < t1; tt += NWAVES * 64) TILEE[tt] = e; }
            if (tid == 0) TILEE[NTILES_MAX] = segs[NEXP] >> 8;
        }
        { LAS int* cw = base + 2048;
          const int f = F.wave * 64 + lane, e = TOPI[(size_t)wg * RT_TOK * 4 + f]; int mycnt = 0, within = 0;
          for (int ex = 0; ex < NEXP; ++ex) { const unsigned long long m = __ballot(e == ex); if (lane == ex) mycnt = __popcll(m); if (e == ex) within = __popcll(m & ((1ull << lane) - 1ull)); }
          if (lane < NEXP) cw[F.wave * NEXP + lane] = mycnt;
          __syncthreads();
          int prev = 0;
          for (int w2 = 0; w2 < F.wave; ++w2) prev += cw[w2 * NEXP + e];
          const int pos = segs[e] + base[e] + prev + within;
          POS[(size_t)wg * RT_TOK * 4 + f] = pos; ROWW[pos] = GATE[(size_t)wg * RT_TOK * 4 + f]; ROWTOK[pos] = wg * RT_TOK + (f >> 2); ROWRS[pos] = RSTD[wg * RT_TOK + (f >> 2)]; }
        __syncthreads();
        if (wg < NEXP) { const int r0 = segs[wg] + tot[wg], r1 = segs[wg + 1]; for (int r = r0 + tid; r < r1; r += NWAVES * 64) { ROWTOK[r] = 0; ROWW[r] = 0.f; ROWRS[r] = 0.f; } }
        __syncthreads();
    }
}
__device__ __forceinline__ void p11_combine(const Frame& F0, const P& p) { const Frame F = phase_frame(F0);
    const bf16_t* X1 = (const bf16_t*)(p.ws + OFF_X1B); const unsigned char* YR = p.ws + OFF_YR; const int* POS = (const int*)(p.ws + OFF_POS);
    const int gw = F.vcu * NWAVES + F.wave, NGW = F.G * NWAVES, lane = F.lane;
    for (int t = gw; t < T; t += NGW) {
        const int4 pos = *(const int4*)(POS + (size_t)t * 4); const int pp[4] = {pos.x, pos.y, pos.z, pos.w};
#pragma unroll
        for (int i = 0; i < 2; ++i) {
            const int c = 16 * (lane + 64 * i);
            const u32x4 xa = *(const u32x4*)(X1 + (size_t)t * D_MODEL + c), xb = *(const u32x4*)(X1 + (size_t)t * D_MODEL + c + 8);
            float s16[16];
#pragma unroll
            for (int j = 0; j < 16; ++j) s16[j] = 0.f;
#pragma unroll
            for (int k = 0; k < 4; ++k) { const u32x4 y = *(const u32x4*)(YR + (size_t)pp[k] * D_MODEL + c); const unsigned yw[4] = {y.x, y.y, y.z, y.w};
#pragma unroll
                for (int d = 0; d < 4; ++d) { const auto lo = __builtin_amdgcn_cvt_pk_f32_fp8((int)yw[d], false), hi = __builtin_amdgcn_cvt_pk_f32_fp8((int)yw[d], true);
                    s16[4 * d + 0] += lo[0]; s16[4 * d + 1] += lo[1]; s16[4 * d + 2] += hi[0]; s16[4 * d + 3] += hi[1]; } }
            const unsigned xw[8] = {xa.x, xa.y, xa.z, xa.w, xb.x, xb.y, xb.z, xb.w};
            constexpr float inv = 1.f / YR_SCALE;
#pragma unroll
            for (int q = 0; q < 4; ++q) { f32x4 o;
                o[0] = __uint_as_float(xw[2 * q] << 16) + s16[4 * q + 0] * inv; o[1] = __uint_as_float(xw[2 * q] & 0xffff0000u) + s16[4 * q + 1] * inv;
                o[2] = __uint_as_float(xw[2 * q + 1] << 16) + s16[4 * q + 2] * inv; o[3] = __uint_as_float(xw[2 * q + 1] & 0xffff0000u) + s16[4 * q + 3] * inv;
                *(f32x4*)(p.out + (size_t)t * D_MODEL + c + 4 * q) = o; }
        }
    }
}

__device__ __forceinline__ void p5_quant(const Frame& F0, const P& p) { const Frame F = phase_frame(F0);
    const int gw = F.vcu * NWAVES + F.wave, NGW = F.G * NWAVES, lane = F.lane;
    for (int e = gw; e < 2 * T; e += NGW) { const int br = e & 1, t = e >> 1;
        const bf16_t* src = (const bf16_t*)(p.ws + (br ? OFF_BOUT : OFF_AOUT)) + (size_t)t * WIDTH + 16 * lane;
        const u32x4 a = *(const u32x4*)src, b = *(const u32x4*)(src + 8); const unsigned w[8] = {a.x, a.y, a.z, a.w, b.x, b.y, b.z, b.w};
        float v[16]; float m = 0.f;
#pragma unroll
        for (int j = 0; j < 8; ++j) { v[2 * j] = __uint_as_float(w[j] << 16); v[2 * j + 1] = __uint_as_float(w[j] & 0xffff0000u); m = fmaxf(m, fmaxf(__builtin_fabsf(v[2 * j]), __builtin_fabsf(v[2 * j + 1]))); }
        const float mx = fmaxf(wave_max(m), 1e-30f), inv = 127.f / mx;
        u32x4 o; o.x = pk4_i8(v[0] * inv, v[1] * inv, v[2] * inv, v[3] * inv); o.y = pk4_i8(v[4] * inv, v[5] * inv, v[6] * inv, v[7] * inv); o.z = pk4_i8(v[8] * inv, v[9] * inv, v[10] * inv, v[11] * inv); o.w = pk4_i8(v[12] * inv, v[13] * inv, v[14] * inv, v[15] * inv);
        *(u32x4*)(p.ws + OFF_H8 + (size_t)br * 32 * MiB + (size_t)t * WIDTH + 16 * lane) = o;
        if (lane == 0) ((float*)(p.ws + (br ? OFF_HSC2 : OFF_HSC)))[t] = mx * (1.f / 127.f);
    }
}
__device__ __forceinline__ void p6_quant(const Frame& F0, const P& p) { const Frame F = phase_frame(F0);
    const bf16_t* MRG = (const bf16_t*)(p.ws + OFF_MRG); unsigned char* Q = p.ws + OFF_H8; float* HSC = (float*)(p.ws + OFF_HSC);
    const int gw = F.vcu * NWAVES + F.wave, NGW = F.G * NWAVES, lane = F.lane;
    for (int t = gw; t < T; t += NGW) {
        const bf16_t* src = MRG + (size_t)t * D_MODEL + 32 * lane; u32x4 in[4]; float m = 0.f;
#pragma unroll
        for (int i = 0; i < 4; ++i) { in[i] = *(const u32x4*)(src + 8 * i); const unsigned w[4] = {in[i].x, in[i].y, in[i].z, in[i].w};
#pragma unroll
            for (int j = 0; j < 4; ++j) m = fmaxf(m, fmaxf(__builtin_fabsf(__uint_as_float(w[j] << 16)), __builtin_fabsf(__uint_as_float(w[j] & 0xffff0000u)))); }
        const float mx = fmaxf(wave_max(m), 1e-30f), inv = 127.f / mx;
        u32x4 o[2];
#pragma unroll
        for (int i = 0; i < 4; ++i) { const unsigned w[4] = {in[i].x, in[i].y, in[i].z, in[i].w};
            const unsigned a = pk4_i8(__uint_as_float(w[0] << 16) * inv, __uint_as_float(w[0] & 0xffff0000u) * inv, __uint_as_float(w[1] << 16) * inv, __uint_as_float(w[1] & 0xffff0000u) * inv);
            const unsigned b = pk4_i8(__uint_as_float(w[2] << 16) * inv, __uint_as_float(w[2] & 0xffff0000u) * inv, __uint_as_float(w[3] << 16) * inv, __uint_as_float(w[3] & 0xffff0000u) * inv);
            if (i & 1) { o[i >> 1].z = a; o[i >> 1].w = b; } else { o[i >> 1].x = a; o[i >> 1].y = b; } }
        *(u32x4*)(Q + (size_t)t * D_MODEL + 32 * lane) = o[0]; *(u32x4*)(Q + (size_t)t * D_MODEL + 32 * lane + 16) = o[1];
        if (lane == 0) HSC[t] = mx * (1.f / 127.f);
    }
}
struct Args { P p; int ph_lo, ph_hi, li, pad; };
__global__ void __launch_bounds__(NWAVES * 64, 2) mk_fwd(Args args) {
    extern __shared__ __attribute__((aligned(16))) unsigned char lds_raw[];
    Frame F; F.lds = (LAS unsigned char*)lds_raw; F.MISC = (volatile LAS unsigned*)(F.lds + MISC_OFF);
    F.tid = threadIdx.x; F.lane = F.tid & 63; F.wave = __builtin_amdgcn_readfirstlane(F.tid >> 6);
    F.G = gridDim.x; { const int bx = blockIdx.x; F.vcu = (F.G % 8 == 0) ? (bx % 8) * (F.G / 8) + bx / 8 : bx; }
    const P& p = args.p;
    for (int u = F.tid; u < (LDS_BYTES - MISC_OFF) / 4; u += NWAVES * 64) ((LAS unsigned*)(F.lds + MISC_OFF))[u] = 0u;
    __syncthreads();
    XcdBarrier bar = xcd_barrier_post((unsigned*)(p.ws + WS_CTL) + CW_BAR + args.li * XCD_BAR_WORDS, F.MISC + 8);
    const int lo = args.ph_lo, hi = args.ph_hi;
#ifndef DUP_MASK
#define DUP_MASK 0
#endif
#define DUP(k) ((DUP_MASK >> (k)) & 1)
#define IN(k) (lo <= (k) && (k) < hi)
#define BOTH(k) (IN(k) && IN((k) + 1))
    if (IN(0)) { for (int rep = 0; rep <= DUP(0); ++rep) { p0_colmax(F, p); p0_weights(F, p); p0_router_prep(F, p); __syncthreads(); p0_rmsnorm(F, p); __syncthreads(); } if (BOTH(0)) xcd_barrier(bar); }
    if (IN(1)) {
        p1_fix_c(F, p);
        p0_win_i8(F, p);
        xcd_barrier(bar);
        { SchedIn<1> S{T / 256, NF8T, F.G, (int)blockIdx.x, (const char*)(p.ws + OFF_H8), (const char*)(p.ws + OFF_WIN8_T), (size_t)256 * D_MODEL, (const float*)(p.ws + OFF_HSC), (const unsigned*)(p.ws + WS_CTL) + CW_CMAX};
          EpiIn1 E{p.ws, p.lb_logits, (LAS float*)(F.lds + MISC_OFF + 4096), p.fq_norm, p.fk_norm};
          pg8::gemm_phase<EpiIn1, SchedIn<1>, true, false, true>(F.lds, D_MODEL / 2, S, E); }
        if (BOTH(1)) xcd_barrier(bar);
    }
    if (IN(2)) { p2_jlo(F, p); p2_hgrn_local(F, p);     if (BOTH(2)) xcd_barrier(bar); }
    if (IN(3)) { for (int rep = 0; rep <= DUP(3); ++rep) p3_hgrn_scan(F, p); if (BOTH(3)) xcd_barrier(bar); }
    if (IN(4)) { if (((blockIdx.x >> 3) & 3) == 3) convert_queue(F, p); p4_hgrn_out(F, p); __syncthreads(); p4_attention(F, p, 0); __syncthreads(); convert_queue(F, p); if (BOTH(4)) xcd_barrier(bar); }
    if (IN(5)) {
        p5_quant(F, p);
        xcd_barrier(bar);
        int kmerge = WIDTH / 2; asm volatile("" : "+s"(kmerge));
        { SchedI8 S{T / 256, D_MODEL / 256, F.G, (int)blockIdx.x, (const char*)(p.ws + OFF_H8), (const char*)(p.ws + OFF_WUPA_T), (size_t)256 * WIDTH, (const float*)(p.ws + OFF_HSC), (const unsigned*)(p.ws + WS_CTL) + CW_CMAXA};
          EpiMergeT<0> E{p.ws}; pg8::gemm_phase<EpiMergeT<0>, SchedI8, true, false, true>(F.lds, kmerge, S, E); }
        { SchedI8 S{T / 256, D_MODEL / 256, F.G, (int)blockIdx.x, (const char*)(p.ws + OFF_H8 + 32 * MiB), (const char*)(p.ws + OFF_WUPB_T), (size_t)256 * WIDTH, (const float*)(p.ws + OFF_HSC2), (const unsigned*)(p.ws + WS_CTL) + CW_CMAXB};
          EpiMergeT<1> E{p.ws}; pg8::gemm_phase<EpiMergeT<1>, SchedI8, true, false, true>(F.lds, kmerge, S, E); }
        if (BOTH(5)) xcd_barrier(bar);
    }
    if (IN(6)) {
        p6_quant(F, p);
        xcd_barrier(bar);
        SchedI8 S{T / 256, D_MODEL / 256, F.G, (int)blockIdx.x, (const char*)(p.ws + OFF_H8), (const char*)(p.ws + OFF_WOUT8_T), (size_t)256 * D_MODEL, (const float*)(p.ws + OFF_HSC), (const unsigned*)(p.ws + WS_CTL) + CW_CMAX2};
        EpiWout1 E{p.x, (bf16_t*)(p.ws + OFF_X1B)};
        for (int rep = 0; rep <= DUP(6); ++rep) pg8::gemm_phase<EpiWout1, SchedI8, true, false, true>(F.lds, D_MODEL / 2, S, E);
        if (BOTH(6)) xcd_barrier(bar);
    }
    if (IN(7)) { for (int rep = 0; rep <= DUP(7); ++rep) p7_router(F, p); if (BOTH(7)) xcd_barrier(bar); }
    if (IN(8)) { for (int rep = 0; rep <= DUP(8); ++rep) p8_scatter(F, p); if (BOTH(8)) xcd_barrier(bar); }
    if (IN(9)) {
        const int nT = load_tile_table(F, p);
        pg8::SchedMoe S{nT, 4096 / 256, F.G, (int)blockIdx.x, (const char*)(p.ws + OFF_H2), (const char*)(p.ws + OFF_WGU_T), (size_t)256 * D_MODEL, (size_t)4096 * D_MODEL, (const LAS int*)(F.lds + TILEE_LDS_OFF), true};
        EpiGU1 E{p.b_gu, p.ws + OFF_ACT, (const float*)(p.ws + OFF_ROWRS)};
        for (int rep = 0; rep <= DUP(9); ++rep) pg8::gemm_phase<EpiGU1, pg8::SchedMoe, true, true>(F.lds, D_MODEL / 2, S, E, (const int*)(p.ws + OFF_ROWTOK));
        if (BOTH(9)) xcd_barrier(bar);
    }
    if (IN(10)) {
        const int nT = load_tile_table(F, p);
        pg8::SchedMoe S{nT, D_MODEL / 256, F.G, (int)blockIdx.x, (const char*)(p.ws + OFF_ACT), (const char*)(p.ws + OFF_WDN_T), (size_t)256 * D_MODEL, (size_t)D_MODEL * D_MODEL, (const LAS int*)(F.lds + TILEE_LDS_OFF), false};
        EpiDown1 E{p.b_down, (const float*)(p.ws + OFF_ROWW), p.ws + OFF_YR};
        for (int rep = 0; rep <= DUP(10); ++rep) pg8::gemm_phase<EpiDown1, pg8::SchedMoe, true>(F.lds, D_MODEL / 2, S, E);
        if (BOTH(10)) xcd_barrier(bar);
    }
    if (IN(11)) { for (int rep = 0; rep <= DUP(11); ++rep) p11_combine(F, p); }
#undef IN
#undef BOTH
}
extern "C" void kernel_launch(void* const* d_in, const int* in_sizes, int n_in, void* d_out, int out_size, void* d_ws, size_t ws_size, hipStream_t stream) {
    static int grid = 0;
    if (grid == 0) {
        if (n_in != 18 || out_size != T * D_MODEL || ws_size < WS_END3) { fprintf(stderr, "kernel_launch: unexpected shapes (n_in %d out %d ws %zu need %zu)\n", n_in, out_size, ws_size, (size_t)WS_END3); grid = -1; return; }
        int dev = 0, cus = 0, per_cu = 0;
        if (hipGetDevice(&dev) != hipSuccess || hipDeviceGetAttribute(&cus, hipDeviceAttributeMultiprocessorCount, dev) != hipSuccess) { grid = -1; return; }
        if (hipFuncSetAttribute((const void*)mk_fwd, hipFuncAttributeMaxDynamicSharedMemorySize, LDS_BYTES) != hipSuccess) { fprintf(stderr, "kernel_launch: hipFuncSetAttribute failed\n"); grid = -1; return; }
        if (hipOccupancyMaxActiveBlocksPerMultiprocessor(&per_cu, (const void*)mk_fwd, NWAVES * 64, LDS_BYTES) != hipSuccess || per_cu < 1) fprintf(stderr, "kernel_launch: occupancy query says %d\n", per_cu);
        (void)hipGetLastError();
        grid = cus;
    }
    if (grid < 0) return;
    P p{};
    p.x = (const float*)d_in[0]; p.lb_logits = (const float*)d_in[1]; p.norm1 = (const float*)d_in[2]; p.w_in = (const float*)d_in[3]; p.hg_norm = (const float*)d_in[4];
    p.fq_norm = (const float*)d_in[5]; p.fk_norm = (const float*)d_in[6]; p.f_bias = (const float*)d_in[7]; p.w_up_hg = (const float*)d_in[8]; p.w_up_fox = (const float*)d_in[9];
    p.w_out = (const float*)d_in[10]; p.norm2 = (const float*)d_in[11]; p.router_w = (const float*)d_in[12]; p.router_b = (const float*)d_in[13]; p.w_gu = (const float*)d_in[14];
    p.b_gu = (const float*)d_in[15]; p.w_down = (const float*)d_in[16]; p.b_down = (const float*)d_in[17]; p.out = (float*)d_out; p.ws = (unsigned char*)d_ws;
    unsigned char* ws = p.ws;
    (void)hipMemsetAsync(ws + WS_CTL, 0, CTL_ZERO_BYTES, stream);
    Args a{}; a.p = p; a.ph_lo = 0; a.ph_hi = 12; a.li = 0; a.pad = 0;
    hipLaunchKernelGGL(mk_fwd, dim3(grid), dim3(NWAVES * 64), LDS_BYTES, stream, a);
}
```

```cpp
#define DUP_MASK 0
#include <hip/hip_runtime.h>
#include <cstdio>
#include <cstdint>

constexpr int D_MODEL = 2048, BATCH = 4, SEQ = 8192, T = BATCH * SEQ;
constexpr int HEADS = 8, HD = 128, WIDTH = 1024;
constexpr int IN_COLS = 11272, NEXP = 32, TOPK = 4, TK = T * TOPK;
constexpr int NROWS_MAX = TK + NEXP * 256;
constexpr int NTILES_MAX = NROWS_MAX / 256;
constexpr float EPS = 1e-6f;
constexpr int RT_TOK = 128, RT_WGS = T / RT_TOK;

typedef unsigned short bf16_t;
__device__ __forceinline__ float bf2f(bf16_t b) { return __uint_as_float(((unsigned)b) << 16); }
__device__ __forceinline__ bf16_t f2bf(float f) { unsigned u = __float_as_uint(f); u += 0x7fffu + ((u >> 16) & 1u); return (bf16_t)(u >> 16); }
__device__ __forceinline__ float wave_sum(float v) {
#pragma unroll
    for (int o = 1; o < 64; o <<= 1) v += __shfl_xor(v, o);
    return v;
}
__device__ __forceinline__ float wave_max(float v) {
#pragma unroll
    for (int o = 1; o < 64; o <<= 1) v = fmaxf(v, __shfl_xor(v, o));
    return v;
}
__device__ __forceinline__ float sigmoidf_(float x) { return 1.f / (1.f + __expf(-x)); }
__device__ __forceinline__ float siluf_(float x) { return x * sigmoidf_(x); }
__device__ __forceinline__ float log_sigmoidf_(float z) { return fminf(z, 0.f) - log1pf(__expf(-fabsf(z))); }

constexpr size_t MiB = 1u << 20;
constexpr size_t WS_CTL = 0;
constexpr size_t WS_SMALL = 1 * MiB;
constexpr size_t OFF_C = WS_SMALL;
constexpr size_t OFF_FL = OFF_C + 1 * MiB;
constexpr size_t OFF_TOPI = OFF_FL + 1 * MiB;
constexpr size_t OFF_GATE = OFF_TOPI + MiB / 2;
constexpr size_t OFF_POS = OFF_GATE + MiB / 2;
constexpr size_t OFF_ROWW = OFF_POS + MiB / 2;
constexpr size_t OFF_CNT = OFF_ROWW + 1 * MiB;
constexpr size_t OFF_TILEE = OFF_CNT + 64 * 1024;
constexpr size_t WS_BIG = 8 * MiB;
constexpr size_t OFF_X1 = WS_BIG;
constexpr size_t OFF_H2 = OFF_X1 + 256 * MiB;
constexpr size_t OFF_YR = OFF_H2 + 128 * MiB;
constexpr size_t OFF_A = OFF_YR + 544 * MiB;
constexpr size_t OFF_H = OFF_A;
constexpr size_t OFF_HQ = OFF_H + 128 * MiB;
constexpr size_t OFF_LOGF = OFF_HQ + 64 * MiB;
constexpr size_t OFF_HV = OFF_LOGF + 64 * MiB;
constexpr size_t OFF_HG = OFF_HV + 64 * MiB;
constexpr size_t OFF_FQ = OFF_HG + 64 * MiB;
constexpr size_t OFF_FK = OFF_FQ + 64 * MiB;
constexpr size_t OFF_FV = OFF_FK + 64 * MiB;
constexpr size_t OFF_GA = OFF_FV + 64 * MiB;
constexpr size_t OFF_GB = OFF_GA + 128 * MiB;
constexpr size_t OFF_AOUT = OFF_GB + 128 * MiB;
constexpr size_t OFF_BOUT = OFF_AOUT + 64 * MiB;
constexpr size_t OFF_MRG = OFF_BOUT + 64 * MiB;
constexpr size_t OFF_A_END = OFF_MRG + 128 * MiB;
constexpr size_t OFF_XS = OFF_A;
constexpr size_t OFF_ACT = OFF_XS + 544 * MiB;
constexpr size_t WS_END = (OFF_A_END > OFF_ACT + 544 * MiB) ? OFF_A_END : OFF_ACT + 544 * MiB;

struct P {
    const float *x, *lb_logits, *norm1, *w_in, *hg_norm, *fq_norm, *fk_norm, *f_bias, *w_up_hg, *w_up_fox, *w_out, *norm2, *router_w, *router_b, *w_gu, *b_gu, *w_down, *b_down;
    float* out; unsigned char* ws;
};

#define LAS __attribute__((address_space(3)))
#define GAS __attribute__((address_space(1)))
typedef short bf16x8 __attribute__((ext_vector_type(8)));
typedef float f32x4 __attribute__((ext_vector_type(4)));
typedef float f32x2 __attribute__((ext_vector_type(2)));
typedef unsigned u32x4 __attribute__((ext_vector_type(4)));
typedef unsigned u32x2 __attribute__((ext_vector_type(2)));
#define LDS_WAIT() asm volatile("s_waitcnt lgkmcnt(0)" ::: "memory")
#define VM_WAIT() asm volatile("s_waitcnt vmcnt(0)" ::: "memory")
__device__ __forceinline__ unsigned cvt_pk_bf16(float lo, float hi) { unsigned r; asm volatile("v_cvt_pk_bf16_f32 %0, %1, %2" : "=v"(r) : "v"(lo), "v"(hi)); return r; }
__device__ __forceinline__ float fast_sigmoid(float x) { return __builtin_amdgcn_rcpf(1.f + __builtin_amdgcn_exp2f(-1.4426950408889634f * x)); }

constexpr size_t OFF_WIN_T = OFF_A_END;
constexpr size_t OFF_WUPA_T = OFF_WIN_T + 44 * MiB;
constexpr size_t OFF_WUPB_T = OFF_WUPA_T + 4 * MiB;
constexpr size_t OFF_WOUT_T = OFF_WUPB_T + 4 * MiB;
constexpr size_t OFF_WGU_T = OFF_WOUT_T + 8 * MiB;
constexpr size_t OFF_WDN_T = OFF_WGU_T + 512 * MiB;
constexpr size_t WS_END2 = OFF_WDN_T + 256 * MiB;
constexpr size_t OFF_SLOC = WS_END2;
constexpr size_t OFF_STATE = OFF_SLOC + 128 * MiB;
constexpr size_t OFF_DEC = OFF_STATE + 128 * MiB;
constexpr size_t OFF_H8 = OFF_DEC + 2 * MiB;
constexpr size_t OFF_WIN8_T = OFF_H8 + 64 * MiB;
constexpr size_t OFF_WOUT8_T = OFF_WIN8_T + 24 * MiB;
constexpr size_t WS_END3 = OFF_WIN8_T + 28 * MiB;
constexpr size_t OFF_BT = OFF_TILEE + 4096;
constexpr size_t OFF_JLO = OFF_BT + 8192 + 4096;
constexpr size_t OFF_RWT = 7 * MiB + 128 * 1024;
constexpr size_t OFF_HSC2 = 7 * MiB + 768 * 1024;
constexpr size_t OFF_HSC = 7 * MiB + 640 * 1024;
constexpr int CW_CMAXA = 51200, CW_CMAXB = 53248;
constexpr int CW_CMAX2 = 49152, CW_RMAX = 65536;
constexpr int CW_CMAX = 32768;
constexpr size_t OFF_RSTD = 7 * MiB + 512 * 1024;
constexpr size_t OFF_ROWRS = 6 * MiB + 576 * 1024;
constexpr size_t OFF_ROWTOK = 6 * MiB;
static_assert(OFF_ROWTOK + (size_t)NROWS_MAX * 4 <= OFF_ROWRS && OFF_ROWRS + (size_t)NROWS_MAX * 4 <= OFF_RWT && OFF_RWT + 2 * NEXP * D_MODEL * 2 <= OFF_RSTD && OFF_RSTD + (size_t)T * 4 <= WS_BIG && OFF_JLO + 4096 <= OFF_ROWTOK, "small-table map");
constexpr size_t OFF_X1B = OFF_H;
constexpr int CW_BAR = 4096;
constexpr size_t CTL_ZERO_BYTES = 512 * 1024;

#define XB_TMO      128
#define XB_XCNT(j)  (256  + 64 * (j))
#define XB_XSUB(j)  (1280 + 64 * (j))
#define XB_XGEN(j)  (2304 + 64 * (j))
#define XB_TOP      3328
#define XB_TOPGEN   3392
#define XCD_BAR_WORDS 3456
#define XB_SPIN_CAP (1u << 18)
__device__ __forceinline__ unsigned xb_ld(unsigned* p)              { return __hip_atomic_load(p, __ATOMIC_RELAXED, __HIP_MEMORY_SCOPE_AGENT); }
__device__ __forceinline__ unsigned xb_add(unsigned* p, unsigned v) { return __hip_atomic_fetch_add(p, v, __ATOMIC_RELAXED, __HIP_MEMORY_SCOPE_AGENT); }
__device__ __forceinline__ unsigned xb_xcc_id() { return (unsigned)__builtin_amdgcn_s_getreg((3 << 11) | 20) & 0xFu; }
#define XB_SPIN(cond, bar) do { unsigned _sp = 0; while (cond) { __builtin_amdgcn_s_sleep(1); \
    if ((++_sp & 255u) == 0u) { if (xb_ld(&(bar)[XB_TMO])) break; if (_sp > XB_SPIN_CAP) { atomicAdd(&(bar)[XB_TMO], 1u); break; } } } } while (0)
struct XcdBarrier { unsigned* bar; unsigned x; volatile LAS unsigned* st; };
__device__ __forceinline__ XcdBarrier xcd_barrier_post(unsigned* bar, volatile LAS unsigned* st) {
    XcdBarrier b; b.bar = bar; b.x = xb_xcc_id(); b.st = st;
    if (threadIdx.x == 0) (void)xb_add(&bar[XB_XCNT(b.x)], 1u);
    return b;
}
__device__ __forceinline__ void xcd_barrier_complete(unsigned* bar, unsigned x, unsigned& nloc, unsigned& nx) {
    const unsigned G = gridDim.x * gridDim.y * gridDim.z;
    unsigned sum, cnt, mine, sp = 0u;
    for (;;) {
        sum = 0u; cnt = 0u; mine = 0u;
#pragma unroll
        for (unsigned j = 0; j < 16; ++j) { const unsigned c = xb_ld(&bar[XB_XCNT(j)]); sum += c; cnt += (c > 0u) ? 1u : 0u; mine = (j == x) ? c : mine; }
        if (sum == G) break;
        __builtin_amdgcn_s_sleep(1);
        if ((++sp & 255u) == 0u) { if (xb_ld(&bar[XB_TMO])) break; if (sp > XB_SPIN_CAP) { atomicAdd(&bar[XB_TMO], 1u); break; } }
    }
    nloc = mine > 0u ? mine : 1u; nx = cnt > 0u ? cnt : 1u;
}
__device__ __forceinline__ void xcd_barrier(const XcdBarrier& b) {
    asm volatile("s_waitcnt vmcnt(0)" ::: "memory");
    __syncthreads();
    if (threadIdx.x == 0) {
        unsigned* bar = b.bar;
        __builtin_amdgcn_s_waitcnt(0);
        unsigned nloc = b.st[0], nx = b.st[1];
        if (nloc == 0u) { xcd_barrier_complete(bar, b.x, nloc, nx); b.st[0] = nloc; b.st[1] = nx; }
        const unsigned old = xb_add(&bar[XB_XSUB(b.x)], 1u);
        const unsigned gen = old / nloc;
        if (old + 1u == (gen + 1u) * nloc) {
            __builtin_amdgcn_fence(__ATOMIC_RELEASE, "agent");
            asm volatile("s_waitcnt vmcnt(0)" ::: "memory");
            const unsigned og = xb_add(&bar[XB_TOP], 1u);
            const unsigned tg = og / nx;
            if (og + 1u == (tg + 1u) * nx) xb_add(&bar[XB_TOPGEN], 1u);
            else XB_SPIN(xb_ld(&bar[XB_TOPGEN]) == tg, bar);
            __builtin_amdgcn_fence(__ATOMIC_ACQUIRE, "agent");
            xb_add(&bar[XB_XGEN(b.x)], 1u);
            asm volatile("s_waitcnt vmcnt(0)" ::: "memory");
        } else {
            XB_SPIN(xb_ld(&bar[XB_XGEN(b.x)]) == gen, bar);
            __builtin_amdgcn_fence(__ATOMIC_ACQUIRE, "agent");
            asm volatile("s_waitcnt vmcnt(0)" ::: "memory");
        }
    }
    __syncthreads();
}

namespace pg8 {
constexpr int BM = 256, BK = 64, HALF = 128, HTB = HALF * BK * 2, STAGE_BYTES = 8 * HTB, NXCD = 8, WGM = 8;
__host__ __device__ __forceinline__ int lds_byte(int r, int c) { const int st = (r >> 4) * 2 + (c >> 5), rr = r & 15, cc = c & 31, ob = rr * 64 + cc * 2; return st * 1024 + (ob ^ (((ob >> 9) & 1) << 5)); }
__host__ __device__ __forceinline__ void stage_rc(int b, int& R, int& C) { const int st = b / 1024, sb = b % 1024, swz = sb ^ (((sb >> 9) & 1) << 5); R = (st >> 1) * 16 + swz / 64; C = (st & 1) * 32 + (swz % 64) / 2; }
__host__ __device__ __forceinline__ int perm32(int rho) { const int n = rho >> 4, i = rho & 15; return 8 * (i >> 2) + 4 * n + (i & 3); }
struct Unit { int pm, pn, e, h; };
__device__ __forceinline__ void tile_map(int wgid, int nM, int nN, int& pm, int& pn) {
    const int nwg = nM * nN; { const int q = nwg / NXCD, r = nwg % NXCD, xcd = wgid % NXCD, off = wgid / NXCD; wgid = (xcd < r ? xcd * (q + 1) : r * (q + 1) + (xcd - r) * q) + off; }
    const int nig = WGM * nN, gid = wgid / nig, fm = gid * WGM, gsz = (nM - fm) < WGM ? (nM - fm) : WGM;
    pm = fm + ((wgid % nig) % gsz); pn = (wgid % nig) / gsz;
}
typedef int i32x8 __attribute__((ext_vector_type(8)));
typedef int i32x4 __attribute__((ext_vector_type(4)));
template <class Epi, class Sched, bool FP8 = false, bool GATHER = false, bool I8 = false>
__device__ __forceinline__ void gemm_phase(LAS unsigned char* lds, const int K, const Sched& S, const Epi& E, const int* rowtok = nullptr) {
    int tid = threadIdx.x; asm volatile("" : "+v"(tid));
    const int wid = __builtin_amdgcn_readfirstlane(tid >> 6), lane = tid & 63, wr = wid >> 2, wc = wid & 3, fr = lane & 15, fq = lane >> 4;
    const int nt = K / BK;
    unsigned voffA[2], voffB[2];
#pragma unroll
    for (int i = 0; i < 2; ++i) { int R, C; stage_rc(tid * 16 + i * 8192, R, C); const int Rb = Epi::PERM ? ((R & ~31) + perm32(R & 31)) : R;
        voffA[i] = (unsigned)(R * K + C) * 2u; voffB[i] = (unsigned)(Rb * K + C) * 2u; }
    const size_t kstep = (size_t)(BK * 2);
    const size_t hstep = (size_t)HALF * K * 2;
    const unsigned ldsw = (unsigned)wid * 1024u;
    const int aoff = lds_byte(wr * 64 + fr, fq * 8), boff = lds_byte(wc * 32 + fr, fq * 8);
#define PG8_SA(b, h) (((b) * 2 + (h)) * HTB)
#define PG8_SB(b, h) ((4 + (b) * 2 + (h)) * HTB)
#define PG8_STAGE(bufoff, gbase, voff) do { _Pragma("unroll") for (int _i = 0; _i < 2; ++_i) \
        __builtin_amdgcn_global_load_lds((const unsigned*)((const char*)(gbase) + (voff)[_i]), (LAS unsigned*)(lds + (bufoff) + ldsw + _i * 8192), 16, 0, 0); } while (0)
#define PG8_LDA(dst, b, h) do { _Pragma("unroll") for (int m = 0; m < 4; ++m) { const i32x4 _x = *(const LAS i32x4*)(lds + PG8_SA(b, h) + aoff + m * 2048), _y = *(const LAS i32x4*)(lds + PG8_SA(b, h) + aoff + m * 2048 + 1024); \
        dst[m] = __builtin_shufflevector(_x, _y, 0, 1, 2, 3, 4, 5, 6, 7); } } while (0)
#define PG8_LDB(dst, b, h) do { _Pragma("unroll") for (int n = 0; n < 2; ++n) { const i32x4 _x = *(const LAS i32x4*)(lds + PG8_SB(b, h) + boff + n * 2048), _y = *(const LAS i32x4*)(lds + PG8_SB(b, h) + boff + n * 2048 + 1024); \
        dst[n] = __builtin_shufflevector(_x, _y, 0, 1, 2, 3, 4, 5, 6, 7); } } while (0)
#define PG8_LO(v) __builtin_bit_cast(bf16x8, __builtin_shufflevector(v, v, 0, 1, 2, 3))
#define PG8_HI(v) __builtin_bit_cast(bf16x8, __builtin_shufflevector(v, v, 4, 5, 6, 7))
#define PG8_MMA(ai, bj, At, Bt) do { __builtin_amdgcn_s_setprio(1); if constexpr (I8) { _Pragma("unroll") for (int m = 0; m < 4; ++m) _Pragma("unroll") for (int n = 0; n < 2; ++n) { \
        i32x4 _c = __builtin_bit_cast(i32x4, acc[ai][bj][m][n]); \
        _c = __builtin_amdgcn_mfma_i32_16x16x64_i8(__builtin_shufflevector(Bt[n], Bt[n], 0, 1, 2, 3), __builtin_shufflevector(At[m], At[m], 0, 1, 2, 3), _c, 0, 0, 0); \
        _c = __builtin_amdgcn_mfma_i32_16x16x64_i8(__builtin_shufflevector(Bt[n], Bt[n], 4, 5, 6, 7), __builtin_shufflevector(At[m], At[m], 4, 5, 6, 7), _c, 0, 0, 0); \
        acc[ai][bj][m][n] = __builtin_bit_cast(f32x4, _c); } } else if constexpr (FP8) { _Pragma("unroll") for (int m = 0; m < 4; ++m) _Pragma("unroll") for (int n = 0; n < 2; ++n) \
        asm volatile("v_mfma_scale_f32_16x16x128_f8f6f4 %0, %1, %2, %0, %3, %4 op_sel_hi:[0,0,0]" : "+v"(acc[ai][bj][m][n]) : "v"(Bt[n]), "v"(At[m]), "v"(sc_w), "v"(sc_a)); } else { \
        _Pragma("unroll") for (int m = 0; m < 4; ++m) _Pragma("unroll") for (int n = 0; n < 2; ++n) { \
        acc[ai][bj][m][n] = __builtin_amdgcn_mfma_f32_16x16x32_bf16(PG8_LO(Bt[n]), PG8_LO(At[m]), acc[ai][bj][m][n], 0, 0, 0); \
        acc[ai][bj][m][n] = __builtin_amdgcn_mfma_f32_16x16x32_bf16(PG8_HI(Bt[n]), PG8_HI(At[m]), acc[ai][bj][m][n], 0, 0, 0); } } __builtin_amdgcn_s_setprio(0); } while (0)
#define PG8_WAIT_V(n) asm volatile("s_waitcnt vmcnt(" #n ")" ::: "memory")
#define PG8_WAIT_L(n) asm volatile("s_waitcnt lgkmcnt(" #n ")" ::: "memory")
#define PG8_BAR __builtin_amdgcn_s_barrier()
#define PG8_SCHED __builtin_amdgcn_sched_barrier(0)
    Unit cur, nxt; int ui = 0;
    if (!S.next(0, cur)) return;
    unsigned gA[2][2], gN[2][2], arow[2];
    if constexpr (GATHER) {
#pragma unroll
        for (int i = 0; i < 2; ++i) { int R, C; stage_rc(tid * 16 + i * 8192, R, C); arow[i] = (unsigned)R; voffA[i] = (unsigned)C * 2u; }
#pragma unroll
        for (int h = 0; h < 2; ++h)
#pragma unroll
            for (int i = 0; i < 2; ++i) gA[h][i] = (unsigned)rowtok[cur.pm * 256 + h * 128 + (int)arow[i]] * (unsigned)(K * 2) + voffA[i];
    }
#define PG8_STAGE_A(bufoff, gbase, h, last_) do { if constexpr (GATHER) { if (last_) { _Pragma("unroll") for (int _i = 0; _i < 2; ++_i) \
        __builtin_amdgcn_global_load_lds((const unsigned*)((const char*)(gbase) + gN[h][_i]), (LAS unsigned*)(lds + (bufoff) + ldsw + _i * 8192), 16, 0, 0); } else { _Pragma("unroll") for (int _i = 0; _i < 2; ++_i) \
        __builtin_amdgcn_global_load_lds((const unsigned*)((const char*)(gbase) + gA[h][_i]), (LAS unsigned*)(lds + (bufoff) + ldsw + _i * 8192), 16, 0, 0); } } \
        else { PG8_STAGE(bufoff, (const char*)(gbase) + (h) * hstep, voffA); } } while (0)
    f32x4 acc[2][2][4][2];
#pragma unroll
    for (int a = 0; a < 2; ++a)
#pragma unroll
        for (int b = 0; b < 2; ++b)
#pragma unroll
            for (int m = 0; m < 4; ++m)
#pragma unroll
                for (int n = 0; n < 2; ++n) acc[a][b][m][n] = (f32x4){0.f, 0.f, 0.f, 0.f};
    i32x8 At[4], B0[2], B1[2];
    int sc_w = 121, sc_a = 127; asm volatile("" : "+v"(sc_w), "+v"(sc_a));
    const char* cA = S.aptr(cur); const char* cB = S.bptr(cur);
    PG8_STAGE(PG8_SB(0, 0), cB, voffB); PG8_STAGE(PG8_SB(0, 1), cB + hstep, voffB); PG8_STAGE_A(PG8_SA(0, 0), cA, 0, false); PG8_STAGE_A(PG8_SA(0, 1), cA, 1, false);
    if (wr == 1) PG8_BAR;
    PG8_WAIT_V(2); PG8_BAR;
    PG8_STAGE(PG8_SB(1, 0), cB + kstep, voffB); PG8_STAGE_A(PG8_SA(1, 0), cA + kstep, 0, false); PG8_STAGE(PG8_SB(1, 1), cB + hstep + kstep, voffB);
    PG8_WAIT_V(6); PG8_BAR;
    for (;;) {
        const bool has_next = S.next(ui + 1, nxt);
        const char* nA = has_next ? S.aptr(nxt) : cA; const char* nB = has_next ? S.bptr(nxt) : cB;
        if constexpr (GATHER) { const int pmn = has_next ? nxt.pm : cur.pm;
#pragma unroll
            for (int h = 0; h < 2; ++h)
#pragma unroll
                for (int i = 0; i < 2; ++i) gN[h][i] = (unsigned)rowtok[pmn * 256 + h * 128 + (int)arow[i]] * (unsigned)(K * 2) + voffA[i]; }
        for (int t = 0; t < nt; t += 2) {
            const bool last = (t == nt - 2);
            const char* a1 = cA + (size_t)(t + 1) * kstep;
            const char* a2 = last ? nA : cA + (size_t)(t + 2) * kstep; const char* b2 = last ? nB : cB + (size_t)(t + 2) * kstep;
            const char* a3 = a2 + kstep; const char* b3 = b2 + kstep;
            PG8_LDB(B0, 0, 0); PG8_LDB(B1, 0, 1); PG8_SCHED; PG8_LDA(At, 0, 0); PG8_STAGE_A(PG8_SA(1, 1), a1, 1, false);
            PG8_WAIT_V(8); PG8_WAIT_L(0); PG8_BAR; PG8_MMA(0, 0, At, B0); PG8_MMA(0, 1, At, B1); PG8_BAR; PG8_SCHED;
            PG8_LDA(At, 0, 1); PG8_STAGE(PG8_SB(0, 0), b2, voffB); PG8_STAGE(PG8_SB(0, 1), b2 + hstep, voffB); PG8_STAGE_A(PG8_SA(0, 0), a2, 0, last);
            PG8_WAIT_V(8); PG8_WAIT_L(0); PG8_BAR; PG8_MMA(1, 0, At, B0); PG8_MMA(1, 1, At, B1); PG8_BAR; PG8_SCHED;
            PG8_LDB(B0, 1, 0); PG8_LDB(B1, 1, 1); PG8_SCHED; PG8_LDA(At, 1, 0); PG8_STAGE_A(PG8_SA(0, 1), a2, 1, last);
            PG8_WAIT_V(8); PG8_WAIT_L(0); PG8_BAR; PG8_MMA(0, 0, At, B0); PG8_MMA(0, 1, At, B1); PG8_BAR; PG8_SCHED;
            PG8_LDA(At, 1, 1); PG8_STAGE(PG8_SB(1, 0), b3, voffB); PG8_STAGE(PG8_SB(1, 1), b3 + hstep, voffB); PG8_STAGE_A(PG8_SA(1, 0), a3, 0, last);
            PG8_WAIT_V(8); PG8_WAIT_L(0); PG8_BAR; PG8_MMA(1, 0, At, B0); PG8_MMA(1, 1, At, B1); PG8_BAR; PG8_SCHED;
        }
        if (wr == 0) PG8_BAR;
        if constexpr (FP8 && !I8) asm volatile("s_nop 15\n\ts_nop 15" ::: "memory");
        if constexpr (I8) {
            const float* rsp = S.rowscale(cur) + cur.pm * 256 + wr * 64 + fr; const unsigned* csb = S.colmax(cur); const int colb = cur.e * 256 + wc * 32 + 8 * fq;
            f32x4 cs[2][2];
#pragma unroll
            for (int bj = 0; bj < 2; ++bj)
#pragma unroll
                for (int n = 0; n < 2; ++n) { const int c0 = S.ccol(colb + bj * 128 + 4 * n); const u32x4 cb = *(const u32x4*)(csb + c0);
                    cs[bj][n] = (f32x4){__uint_as_float(cb.x), __uint_as_float(cb.y), __uint_as_float(cb.z), __uint_as_float(cb.w)} * (1.f / 127.f); }
#pragma unroll
            for (int ai = 0; ai < 2; ++ai)
#pragma unroll
                for (int m = 0; m < 4; ++m) { const float r = rsp[ai * 128 + m * 16];
#pragma unroll
                    for (int bj = 0; bj < 2; ++bj)
#pragma unroll
                        for (int n = 0; n < 2; ++n) { const i32x4 ci = __builtin_bit_cast(i32x4, acc[ai][bj][m][n]);
                            acc[ai][bj][m][n] = (f32x4){(float)ci[0], (float)ci[1], (float)ci[2], (float)ci[3]} * (cs[bj][n] * r); } }
        }
        E(acc, cur, wr, wc, fr, fq);
#ifdef EPI_DUP
        E(acc, cur, wr, wc, fr, fq);
#endif
        if (!has_next) break;
#pragma unroll
        for (int a = 0; a < 2; ++a)
#pragma unroll
            for (int b = 0; b < 2; ++b)
#pragma unroll
                for (int m = 0; m < 4; ++m)
#pragma unroll
                    for (int n = 0; n < 2; ++n) acc[a][b][m][n] = (f32x4){0.f, 0.f, 0.f, 0.f};
        cur = nxt; cA = nA; cB = nB; ++ui;
        if constexpr (GATHER) { gA[0][0] = gN[0][0]; gA[0][1] = gN[0][1]; gA[1][0] = gN[1][0]; gA[1][1] = gN[1][1]; }
        if (wr == 1) PG8_BAR;
    }
    PG8_WAIT_V(0);
    PG8_BAR;
#undef PG8_SA
#undef PG8_SB
#undef PG8_STAGE
#undef PG8_STAGE_A
#undef PG8_LDA
#undef PG8_LDB
#undef PG8_LO
#undef PG8_HI
#undef PG8_MMA
#undef PG8_WAIT_V
#undef PG8_WAIT_L
#undef PG8_BAR
#undef PG8_SCHED
}
struct SchedDense {
    int nM, nN, G, c; const char* A; const char* Bt; size_t tstep;
    __device__ __forceinline__ bool next(int i, Unit& u) const { const long L = (long)i * G + c; if (L >= (long)nM * nN) return false; tile_map((int)L, nM, nN, u.pm, u.pn); u.e = 0; u.h = 0; return true; }
    __device__ __forceinline__ const char* aptr(const Unit& u) const { return A + (size_t)u.pm * tstep; }
    __device__ __forceinline__ const char* bptr(const Unit& u) const { return Bt + (size_t)u.pn * tstep; }
};
struct SchedMerge {
    int nM, nN, G, c; const char *A0, *A1, *B0, *B1; size_t tstep;
    __device__ __forceinline__ bool next(int i, Unit& u) const { const long L = (long)(i >> 1) * G + c; if (L >= (long)nM * nN) return false; tile_map((int)L, nM, nN, u.pm, u.pn); u.e = 0; u.h = i & 1; return true; }
    __device__ __forceinline__ const char* aptr(const Unit& u) const { return (u.h ? A1 : A0) + (size_t)u.pm * tstep; }
    __device__ __forceinline__ const char* bptr(const Unit& u) const { return (u.h ? B1 : B0) + (size_t)u.pn * tstep; }
};
struct SchedMoe {
    int nM, nN, G, c; const char* A; const char* Bt; size_t tstep, estride; const LAS int* tilee; bool gather;
    __device__ __forceinline__ bool next(int i, Unit& u) const { const long L = (long)i * G + c; if (L >= (long)nM * nN) return false; tile_map((int)L, nM, nN, u.pm, u.pn); u.e = __builtin_amdgcn_readfirstlane(tilee[u.pm]); u.h = 0; return true; }
    __device__ __forceinline__ const char* aptr(const Unit& u) const { return gather ? A : A + (size_t)u.pm * tstep; }
    __device__ __forceinline__ const char* bptr(const Unit& u) const { return Bt + (size_t)u.e * estride + (size_t)u.pn * tstep; }
};
}

constexpr int NWAVES = 8;
constexpr int RING_BYTES = 131072, MISC_OFF = RING_BYTES, LDS_BYTES = 147456;
struct Frame { LAS unsigned char* lds; volatile LAS unsigned* MISC; int tid, lane, wave, vcu, G; };
__device__ __forceinline__ Frame phase_frame(const Frame& F0) { Frame F = F0; int t = threadIdx.x; asm volatile("" : "+v"(t)); F.tid = t; F.lane = t & 63; F.wave = __builtin_amdgcn_readfirstlane(t >> 6); return F; }

struct MapId { __device__ __forceinline__ int operator()(int c) const { return c; } };
struct MapWin { __device__ __forceinline__ int operator()(int c) const { return c < 7168 ? c : (c < 7176 ? -1 : c - 8); } };
#ifndef FP8_GROUPS
#define FP8_GROUPS 0x7fu
#endif
__host__ __device__ constexpr int fp8_rank(int g) { int r = 0; for (int i = 0; i < g; ++i) r += (FP8_GROUPS >> i) & 1; return r; }
constexpr int N8G = fp8_rank(7), NB16T = 4 * (7 - N8G), NF8T = 4 * N8G + 16;
template <int SEL> __device__ __forceinline__ int in_tile_of(int l) { int cnt = 0, out = SEL ? 28 + (l - 4 * N8G) : 0;
#pragma unroll
    for (int g = 0; g < 7; ++g) if ((int)((FP8_GROUPS >> g) & 1u) == SEL) { if (l >= 4 * cnt && l < 4 * cnt + 4) out = 4 * g + (l - 4 * cnt); ++cnt; }
    return out; }
struct SchedI8 {
    int nM, nN, G, c; const char* A; const char* Bt; size_t tstep; const float* rs; const unsigned* cs;
    __device__ __forceinline__ bool next(int i, pg8::Unit& u) const { const long L = (long)i * G + c; if (L >= (long)nM * nN) return false; pg8::tile_map((int)L, nM, nN, u.pm, u.pn); u.e = u.pn; u.h = 0; return true; }
    __device__ __forceinline__ const char* aptr(const pg8::Unit& u) const { return A + (size_t)u.pm * tstep; }
    __device__ __forceinline__ const char* bptr(const pg8::Unit& u) const { return Bt + (size_t)u.pn * tstep; }
    __device__ __forceinline__ int ccol(int c0) const { return c0; }
    __device__ __forceinline__ const float* rowscale(const pg8::Unit&) const { return rs; }
    __device__ __forceinline__ const unsigned* colmax(const pg8::Unit&) const { return cs; }
};
template <int SEL> struct SchedIn {
    int nM, nN, G, c; const char* A; const char* Bt; size_t tstep; const float* rs; const unsigned* cs;
    __device__ __forceinline__ bool next(int i, pg8::Unit& u) const { const long L = (long)i * G + c; if (L >= (long)nM * nN) return false; pg8::tile_map((int)L, nM, nN, u.pm, u.pn); u.e = in_tile_of<SEL>(u.pn); u.h = 0; return true; }
    __device__ __forceinline__ const char* aptr(const pg8::Unit& u) const { return A + (size_t)u.pm * tstep; }
    __device__ __forceinline__ const char* bptr(const pg8::Unit& u) const { return Bt + (size_t)(SEL ? u.pn : u.e) * tstep; }
    __device__ __forceinline__ int ccol(int c0) const { return c0 < 7168 ? c0 : c0 + 8; }
    __device__ __forceinline__ const float* rowscale(const pg8::Unit&) const { return rs; }
    __device__ __forceinline__ const unsigned* colmax(const pg8::Unit&) const { return cs; }
};
struct MapWinG { __device__ __forceinline__ int operator()(int c) const { if (c >= 7176) return c - 7176 + 1024 * N8G; if (c >= 7168) return -1; const int g = c >> 10; int r = 0;
#pragma unroll
        for (int i = 0; i < 7; ++i) r += (i < g) ? (int)((FP8_GROUPS >> i) & 1u) : 0;
        return ((FP8_GROUPS >> g) & 1u) ? r * 1024 + (c & 1023) : -1; } };
struct MapGu { __device__ __forceinline__ int operator()(int c) const { const int bj = c >> 11, j = c & 2047; return ((j >> 7) << 8) + (bj << 7) + (j & 127); } };
__device__ __forceinline__ unsigned pk4_fp8(float a, float b, float c, float d) { int r = __builtin_amdgcn_cvt_pk_fp8_f32(a, b, 0, false); r = __builtin_amdgcn_cvt_pk_fp8_f32(c, d, r, true); return (unsigned)r; }
constexpr float W8_SCALE = 64.f;
__device__ __forceinline__ unsigned pk4_i8(float a, float b, float c, float d) { const int q0 = (int)__builtin_rintf(__builtin_amdgcn_fmed3f(a, -127.f, 127.f)), q1 = (int)__builtin_rintf(__builtin_amdgcn_fmed3f(b, -127.f, 127.f)), q2 = (int)__builtin_rintf(__builtin_amdgcn_fmed3f(c, -127.f, 127.f)), q3 = (int)__builtin_rintf(__builtin_amdgcn_fmed3f(d, -127.f, 127.f)); return (unsigned)(q0 & 255) | ((unsigned)(q1 & 255) << 8) | ((unsigned)(q2 & 255) << 16) | ((unsigned)q3 << 24); }
template <class Map, bool Q8 = false, bool I8 = false>
__device__ __forceinline__ void p0_transpose_item(const float* W, int K, int N, void* WTv, LAS float* scr, int item, int lane, Map map, const unsigned* cmax = nullptr) {
    const int nblk = (N + 31) / 32, kb = item / nblk, nb = item % nblk, k0 = 64 * kb, n0 = 32 * nb;
    const int col = n0 + (lane & 31); const bool okc = col < N;
    float v[32];
#pragma unroll
    for (int i = 0; i < 32; ++i) { const int kk = 2 * i + (lane >> 5); v[i] = okc ? W[(size_t)(k0 + kk) * N + col] : 0.f; }
#pragma unroll
    for (int i = 0; i < 32; ++i) { const int kk = 2 * i + (lane >> 5); scr[kk * 33 + (lane & 31)] = v[i]; }
    LDS_WAIT(); asm volatile("" ::: "memory");
    const int c = lane & 7;
#pragma unroll
    for (int j = 0; j < 4; ++j) { const int n = (lane >> 3) + 8 * j; const LAS float* s = scr + (8 * c) * 33 + n;
        const int dr = (n0 + n < N) ? map(n0 + n) : -1;
        if constexpr (Q8) { u32x2 o;
            if constexpr (I8) { const float inv = 127.f / fmaxf(__uint_as_float(cmax[(n0 + n < N) ? n0 + n : 0]), 1e-30f);
                o.x = pk4_i8(s[0 * 33] * inv, s[1 * 33] * inv, s[2 * 33] * inv, s[3 * 33] * inv); o.y = pk4_i8(s[4 * 33] * inv, s[5 * 33] * inv, s[6 * 33] * inv, s[7 * 33] * inv); }
            else { o.x = pk4_fp8(s[0 * 33] * W8_SCALE, s[1 * 33] * W8_SCALE, s[2 * 33] * W8_SCALE, s[3 * 33] * W8_SCALE); o.y = pk4_fp8(s[4 * 33] * W8_SCALE, s[5 * 33] * W8_SCALE, s[6 * 33] * W8_SCALE, s[7 * 33] * W8_SCALE); }
            if (dr >= 0) *(u32x2*)((unsigned char*)WTv + (size_t)dr * K + k0 + 8 * c) = o; }
        else { u32x4 o; o.x = cvt_pk_bf16(s[0 * 33], s[1 * 33]); o.y = cvt_pk_bf16(s[2 * 33], s[3 * 33]); o.z = cvt_pk_bf16(s[4 * 33], s[5 * 33]); o.w = cvt_pk_bf16(s[6 * 33], s[7 * 33]);
            if (dr >= 0) *(u32x4*)((bf16_t*)WTv + (size_t)dr * K + k0 + 8 * c) = o; } }
    LDS_WAIT(); asm volatile("" ::: "memory");
}
template <class Map>
__device__ __forceinline__ void p0_fp8_load(float (&v)[64], const float* W, int N, int item, int lane) {
    const int nblk = N / 32, kb = item / nblk, nb = item % nblk, k0 = 128 * kb + 64 * (lane >> 5), col = 32 * nb + (lane & 31);
    const float* src = W + (size_t)k0 * N + col;
#pragma unroll
    for (int i = 0; i < 64; ++i) v[i] = __builtin_nontemporal_load(src + (size_t)i * N);
}
template <class Map>
__device__ __forceinline__ void p0_fp8_finish(const float (&v)[64], int K, int N, unsigned char* WT, int item, int lane, Map map) {
    const int nblk = N / 32, kb = item / nblk, nb = item % nblk, k0 = 128 * kb + 64 * (lane >> 5), col = 32 * nb + (lane & 31);
    u32x4 o[4];
#pragma unroll
    for (int q = 0; q < 4; ++q) {
        o[q].x = pk4_fp8(v[16 * q + 0] * W8_SCALE, v[16 * q + 1] * W8_SCALE, v[16 * q + 2] * W8_SCALE, v[16 * q + 3] * W8_SCALE);
        o[q].y = pk4_fp8(v[16 * q + 4] * W8_SCALE, v[16 * q + 5] * W8_SCALE, v[16 * q + 6] * W8_SCALE, v[16 * q + 7] * W8_SCALE);
        o[q].z = pk4_fp8(v[16 * q + 8] * W8_SCALE, v[16 * q + 9] * W8_SCALE, v[16 * q + 10] * W8_SCALE, v[16 * q + 11] * W8_SCALE);
        o[q].w = pk4_fp8(v[16 * q + 12] * W8_SCALE, v[16 * q + 13] * W8_SCALE, v[16 * q + 14] * W8_SCALE, v[16 * q + 15] * W8_SCALE); }
#define XCHG(pa, pb, bit, msk) do { const bool b_ = (lane & (bit)) != 0; u32x4 s_ = b_ ? o[pa] : o[pb]; \
        s_.x = (unsigned)__shfl_xor((int)s_.x, msk); s_.y = (unsigned)__shfl_xor((int)s_.y, msk); s_.z = (unsigned)__shfl_xor((int)s_.z, msk); s_.w = (unsigned)__shfl_xor((int)s_.w, msk); \
        if (b_) o[pa] = s_; else o[pb] = s_; } while (0)
    XCHG(0, 1, 1, 1); XCHG(2, 3, 1, 1); XCHG(0, 2, 2, 2); XCHG(1, 3, 2, 2);
#undef XCHG
    const int j = lane & 3, colb = col - j;
#pragma unroll
    for (int q = 0; q < 4; ++q) *(u32x4*)(WT + (size_t)map(colb + q) * K + k0 + 16 * j) = o[q];
}
constexpr int CW_QH = 128, CW_QC = 192;
__device__ __forceinline__ void p0_weights(const Frame& F0, const P& p) { const Frame F = phase_frame(F0);
    LAS float* scr = (LAS float*)(F.lds + F.wave * 8448);
    const int gw = F.vcu * NWAVES + F.wave, NGW = F.G * NWAVES;
    constexpr int I_IN = (2048 / 64) * ((IN_COLS + 31) / 32), I_UP = (1024 / 64) * (2048 / 32), NB16 = I_IN + 2 * I_UP;
    unsigned char* ws = p.ws;
    (void)scr; (void)gw; (void)NGW; (void)ws; (void)NB16;
}
template <int NCOLS, int KROWS = 2048> __device__ __forceinline__ void p0_colmax_t(const Frame& F0, const float* W, unsigned* CMAX) { const Frame F = phase_frame(F0);
    const int gw = F.vcu * NWAVES + F.wave, NGW = F.G * NWAVES, lane = F.lane;
    constexpr int NBLK = (NCOLS + 31) / 32, I_IN = (KROWS / 64) * NBLK;
    for (int it = gw; it < I_IN; it += NGW) { const int kb = it / NBLK, nb = it % NBLK, k0 = 64 * kb, col = 32 * nb + (lane & 31); const bool okc = col < NCOLS;
        float m = 0.f;
#pragma unroll
        for (int i = 0; i < 32; ++i) { const int kk = 2 * i + (lane >> 5); m = fmaxf(m, __builtin_fabsf(okc ? W[(size_t)(k0 + kk) * NCOLS + col] : 0.f)); }
        m = fmaxf(m, __shfl_xor(m, 32));
        if (lane < 32 && okc) atomicMax(CMAX + col, __float_as_uint(m)); }
}
__device__ __forceinline__ void p0_colmax(const Frame& F0, const P& p) { p0_colmax_t<IN_COLS>(F0, p.w_in, (unsigned*)(p.ws + WS_CTL) + CW_CMAX); p0_colmax_t<2048>(F0, p.w_out, (unsigned*)(p.ws + WS_CTL) + CW_CMAX2);
    p0_colmax_t<2048, 1024>(F0, p.w_up_hg, (unsigned*)(p.ws + WS_CTL) + CW_CMAXA); p0_colmax_t<2048, 1024>(F0, p.w_up_fox, (unsigned*)(p.ws + WS_CTL) + CW_CMAXB); }
__device__ __forceinline__ void p0_win_i8(const Frame& F0, const P& p) { const Frame F = phase_frame(F0);
    LAS float* scr = (LAS float*)(F.lds + F.wave * 8448);
    const unsigned* CMAX = (const unsigned*)(p.ws + WS_CTL) + CW_CMAX;
    const int gw = F.vcu * NWAVES + F.wave, NGW = F.G * NWAVES;
    constexpr int I_IN = (2048 / 64) * ((IN_COLS + 31) / 32);
    for (int it = gw; it < I_IN; it += NGW) p0_transpose_item<MapWinG, true, true>(p.w_in, 2048, IN_COLS, p.ws + OFF_WIN8_T, scr, it, F.lane, MapWinG{}, CMAX);
    constexpr int I_OUT = (2048 / 64) * (2048 / 32);
    for (int it = gw; it < I_OUT; it += NGW) p0_transpose_item<MapId, true, true>(p.w_out, 2048, 2048, p.ws + OFF_WOUT8_T, scr, it, F.lane, MapId{}, (const unsigned*)(p.ws + WS_CTL) + CW_CMAX2);
    constexpr int I_UP = (1024 / 64) * (2048 / 32);
    for (int it = gw; it < I_UP; it += NGW) { p0_transpose_item<MapId, true, true>(p.w_up_hg, 1024, 2048, p.ws + OFF_WUPA_T, scr, it, F.lane, MapId{}, (const unsigned*)(p.ws + WS_CTL) + CW_CMAXA);
        p0_transpose_item<MapId, true, true>(p.w_up_fox, 1024, 2048, p.ws + OFF_WUPB_T, scr, it, F.lane, MapId{}, (const unsigned*)(p.ws + WS_CTL) + CW_CMAXB); }
}
template <class Map>
__device__ __forceinline__ void p0_quant_strip(const Frame& F, const float* W, const int K, const int N, const int strip, unsigned char* WT, unsigned* CMAX, Map map) {
    LAS bf16_t* img = (LAS bf16_t*)F.lds; LAS float* red = (LAS float*)(F.lds + MISC_OFF + 4096); LAS float* invs = red + 512;
    const int tid = F.tid, lane = F.lane, n0 = 32 * strip;
    { const int c = tid & 31, r = tid >> 5, col = n0 + c; const bool okc = col < N; float m = 0.f;
      for (int kb = 0; kb < K; kb += 512) { float v[32];
#pragma unroll
          for (int j = 0; j < 32; ++j) v[j] = okc ? W[(size_t)(kb + 16 * j + r) * N + col] : 0.f;
#pragma unroll
          for (int j = 0; j < 32; ++j) { m = fmaxf(m, __builtin_fabsf(v[j])); img[(kb + 16 * j + r) * 32 + c] = f2bf(v[j]); } }
      red[r * 32 + c] = m; }
    __syncthreads();
    if (tid < 32) { float mm = 0.f;
#pragma unroll
        for (int q = 0; q < 16; ++q) mm = fmaxf(mm, red[q * 32 + tid]);
        invs[tid] = 127.f / fmaxf(mm, 1e-30f); if (n0 + tid < N) CMAX[n0 + tid] = __float_as_uint(mm); }
    __syncthreads();
    { const int kq = lane & 7, cs = lane >> 3, c = F.wave * 4 + (cs & 3), hf = cs >> 2, col = n0 + c; const int dr = (col < N) ? map(col) : -1; const float inv = invs[c];
      for (int ch = hf; ch < K / 128; ch += 2) { const int k0 = ch * 128 + 16 * kq; float f[16];
#pragma unroll
          for (int e = 0; e < 16; ++e) f[e] = bf2f(img[(k0 + e) * 32 + c]) * inv;
          u32x4 o; o.x = pk4_i8(f[0], f[1], f[2], f[3]); o.y = pk4_i8(f[4], f[5], f[6], f[7]); o.z = pk4_i8(f[8], f[9], f[10], f[11]); o.w = pk4_i8(f[12], f[13], f[14], f[15]);
          if (dr >= 0) *(u32x4*)(WT + (size_t)dr * K + k0) = o; } }
    __syncthreads();
}
__device__ __forceinline__ void p0_quant_weights(const Frame& F0, const P& p) { const Frame F = phase_frame(F0);
    unsigned* ctl = (unsigned*)(p.ws + WS_CTL);
    constexpr int S_IN = (IN_COLS + 31) / 32, S_SQ = 2048 / 32, S_ALL = S_IN + 3 * S_SQ;
    for (int s0 = F.vcu; s0 < S_ALL; s0 += F.G) { int st = s0;
        if (st < S_IN) { p0_quant_strip(F, p.w_in, 2048, IN_COLS, st, p.ws + OFF_WIN8_T, ctl + CW_CMAX, MapWinG{}); continue; } st -= S_IN;
        if (st < S_SQ) { p0_quant_strip(F, p.w_out, 2048, 2048, st, p.ws + OFF_WOUT8_T, ctl + CW_CMAX2, MapId{}); continue; } st -= S_SQ;
        if (st < S_SQ) { p0_quant_strip(F, p.w_up_hg, 1024, 2048, st, p.ws + OFF_WUPA_T, ctl + CW_CMAXA, MapId{}); continue; } st -= S_SQ;
        p0_quant_strip(F, p.w_up_fox, 1024, 2048, st, p.ws + OFF_WUPB_T, ctl + CW_CMAXB, MapId{}); }
}
struct MapGuOrId { int gu; __device__ __forceinline__ int operator()(int c) const { const int bj = c >> 11, j = c & 2047; return gu ? ((j >> 7) << 8) + (bj << 7) + (j & 127) : c; } };
__device__ __forceinline__ void cq_issue(float (&v)[64], const P& p, int c, int wave, int lane) {
    constexpr int I_GU = (2048 / 128) * (4096 / 32), I_DN = (2048 / 128) * (2048 / 32);
    const int r = __builtin_amdgcn_readfirstlane(c * 8 + wave); const bool gu = r < NEXP * I_GU; const int q = gu ? r : r - NEXP * I_GU, per = gu ? I_GU : I_DN, e = q / per, N = gu ? 4096 : 2048;
    const float* W = gu ? p.w_gu + (size_t)e * 2048 * 4096 : p.w_down + (size_t)e * 2048 * 2048;
    p0_fp8_load<MapId>(v, W, N, q - e * per, lane);
}
__device__ __forceinline__ void cq_finish(const float (&v)[64], const P& p, int c, int wave, int lane) {
    constexpr int I_GU = (2048 / 128) * (4096 / 32), I_DN = (2048 / 128) * (2048 / 32);
    const int r = __builtin_amdgcn_readfirstlane(c * 8 + wave); const bool gu = r < NEXP * I_GU; const int q = gu ? r : r - NEXP * I_GU, per = gu ? I_GU : I_DN, e = q / per, N = gu ? 4096 : 2048;
    unsigned char* WT = gu ? p.ws + OFF_WGU_T + (size_t)e * 4096 * 2048 : p.ws + OFF_WDN_T + (size_t)e * 2048 * 2048;
    p0_fp8_finish(v, 2048, N, WT, q - e * per, lane, MapGuOrId{gu ? 1 : 0});
}
__device__ __forceinline__ void convert_queue(const Frame& F0, const P& p) { const Frame F = phase_frame(F0);
    constexpr int I_GU = (2048 / 128) * (4096 / 32), I_DN = (2048 / 128) * (2048 / 32), NCONV = NEXP * (I_GU + I_DN), NCH = NCONV / 8;
    unsigned* qhead = (unsigned*)(p.ws + WS_CTL) + CW_QC; LAS int* slot = (LAS int*)(F.lds + MISC_OFF + 768);
    if (F.tid == 0) { slot[0] = (int)__hip_atomic_fetch_add(qhead, 1u, __ATOMIC_RELAXED, __HIP_MEMORY_SCOPE_AGENT); slot[1] = (int)__hip_atomic_fetch_add(qhead, 1u, __ATOMIC_RELAXED, __HIP_MEMORY_SCOPE_AGENT); }
    __syncthreads();
    int ca = __builtin_amdgcn_readfirstlane(slot[0]), cb = __builtin_amdgcn_readfirstlane(slot[1]);
    float va[64], vb[64];
    if (ca < NCH) {
        cq_issue(va, p, ca, F.wave, F.lane);
        for (;;) {
            if (F.tid == 0) slot[2] = (int)__hip_atomic_fetch_add(qhead, 1u, __ATOMIC_RELAXED, __HIP_MEMORY_SCOPE_AGENT);
            cq_issue(vb, p, cb < NCH ? cb : NCH - 1, F.wave, F.lane);
            cq_finish(va, p, ca, F.wave, F.lane);
            __syncthreads();
            const int cn = __builtin_amdgcn_readfirstlane(slot[2]);
            if (cb >= NCH) break;
            if (F.tid == 0) slot[3] = (int)__hip_atomic_fetch_add(qhead, 1u, __ATOMIC_RELAXED, __HIP_MEMORY_SCOPE_AGENT);
            cq_issue(va, p, cn < NCH ? cn : NCH - 1, F.wave, F.lane);
            cq_finish(vb, p, cb, F.wave, F.lane);
            __syncthreads();
            const int cm = __builtin_amdgcn_readfirstlane(slot[3]);
            if (cn >= NCH) break;
            ca = cn; cb = cm;
        }
    }
    __syncthreads();
}
__device__ __forceinline__ void p0_router_prep(const Frame& F0, const P& p) { const Frame F = phase_frame(F0);
    bf16_t* RWT = (bf16_t*)(p.ws + OFF_RWT);
    for (int i = F.vcu * NWAVES * 64 + F.tid; i < NEXP * D_MODEL; i += F.G * NWAVES * 64) { const int e = i >> 11, k = i & 2047;
        const float w = p.norm2[k] * p.router_w[(size_t)k * NEXP + e]; const bf16_t hi = f2bf(w); RWT[i] = hi; RWT[NEXP * D_MODEL + i] = f2bf(w - bf2f(hi)); }
}
__device__ __forceinline__ void p0_rmsnorm(const Frame& F0, const P& p) { const Frame F = phase_frame(F0);
    LAS float* WF = (LAS float*)F.lds;
    LAS float* FLs = (LAS float*)(F.lds + 65536);
    unsigned char* H8 = p.ws + OFF_H8; float* HSC = (float*)(p.ws + OFF_HSC); float* C = (float*)(p.ws + OFF_C); float* BT = (float*)(p.ws + OFF_BT);
    for (int k = F.tid; k < D_MODEL; k += NWAVES * 64) { const float4* wr = (const float4*)(p.w_in + (size_t)k * IN_COLS + 7168); const float4 w0 = wr[0], w1 = wr[1];
        WF[0 * 2048 + k] = w0.x; WF[1 * 2048 + k] = w0.y; WF[2 * 2048 + k] = w0.z; WF[3 * 2048 + k] = w0.w; WF[4 * 2048 + k] = w1.x; WF[5 * 2048 + k] = w1.y; WF[6 * 2048 + k] = w1.z; WF[7 * 2048 + k] = w1.w; }
    __syncthreads();
    const int lane = F.lane;
    for (int blk = F.vcu; blk < T / 128; blk += F.G) {
        for (int pr = 0; pr < 8; ++pr) {
            const int lt = F.wave * 16 + 2 * pr, ta = blk * 128 + lt;
            const float4* xa = (const float4*)(p.x + (size_t)ta * D_MODEL); const float4* xb = xa + D_MODEL / 4;
            float4 va[8], vb[8]; float sa = 0.f, sb = 0.f;
#pragma unroll
            for (int i = 0; i < 8; ++i) { va[i] = xa[lane + 64 * i]; vb[i] = xb[lane + 64 * i];
                sa += va[i].x * va[i].x + va[i].y * va[i].y + va[i].z * va[i].z + va[i].w * va[i].w; sb += vb[i].x * vb[i].x + vb[i].y * vb[i].y + vb[i].z * vb[i].z + vb[i].w * vb[i].w; }
            const float ra = rsqrtf(wave_sum(sa) * (1.f / D_MODEL) + EPS), rb = rsqrtf(wave_sum(sb) * (1.f / D_MODEL) + EPS);
            float qa_ = 0.f, qb_ = 0.f;
#pragma unroll
            for (int i = 0; i < 8; ++i) { const float4 g = ((const float4*)p.norm1)[lane + 64 * i];
                qa_ = fmaxf(fmaxf(qa_, fmaxf(__builtin_fabsf(va[i].x * g.x), __builtin_fabsf(va[i].y * g.y))), fmaxf(__builtin_fabsf(va[i].z * g.z), __builtin_fabsf(va[i].w * g.w)));
                qb_ = fmaxf(fmaxf(qb_, fmaxf(__builtin_fabsf(vb[i].x * g.x), __builtin_fabsf(vb[i].y * g.y))), fmaxf(__builtin_fabsf(vb[i].z * g.z), __builtin_fabsf(vb[i].w * g.w))); }
            const float ma_ = fmaxf(wave_max(qa_) * ra, 1e-30f), mb_ = fmaxf(wave_max(qb_) * rb, 1e-30f), inva = 127.f / ma_, invb = 127.f / mb_;
            if (lane == 0) { HSC[ta] = ma_ * (1.f / 127.f); HSC[ta + 1] = mb_ * (1.f / 127.f); }
            float aa[8], ab[8];
#pragma unroll
            for (int j = 0; j < 8; ++j) { aa[j] = 0.f; ab[j] = 0.f; }
#pragma unroll
            for (int i = 0; i < 8; ++i) {
                const float4 g = ((const float4*)p.norm1)[lane + 64 * i]; const int k0 = 4 * (lane + 64 * i);
                const float4 ha = make_float4(va[i].x * ra * g.x, va[i].y * ra * g.y, va[i].z * ra * g.z, va[i].w * ra * g.w);
                const float4 hb = make_float4(vb[i].x * rb * g.x, vb[i].y * rb * g.y, vb[i].z * rb * g.z, vb[i].w * rb * g.w);
                *(unsigned*)(H8 + (size_t)ta * D_MODEL + k0) = pk4_i8(ha.x * inva, ha.y * inva, ha.z * inva, ha.w * inva); *(unsigned*)(H8 + (size_t)(ta + 1) * D_MODEL + k0) = pk4_i8(hb.x * invb, hb.y * invb, hb.z * invb, hb.w * invb);
#pragma unroll
                for (int j = 0; j < 8; ++j) { const f32x4 w = *(const LAS f32x4*)(WF + j * 2048 + k0);
                    aa[j] += ha.x * w[0] + ha.y * w[1] + ha.z * w[2] + ha.w * w[3]; ab[j] += hb.x * w[0] + hb.y * w[1] + hb.z * w[2] + hb.w * w[3]; }
            }
#pragma unroll
            for (int j = 0; j < 8; ++j) { aa[j] = wave_sum(aa[j]); ab[j] = wave_sum(ab[j]); }
            float ma = aa[0], mb = ab[0];
#pragma unroll
            for (int j = 1; j < 8; ++j) { ma = (lane == j) ? aa[j] : ma; mb = (lane == j) ? ab[j] : mb; }
            if (lane < 8) { const float fb = p.f_bias[lane]; FLs[lt * 8 + lane] = log_sigmoidf_(ma + fb); FLs[(lt + 1) * 8 + lane] = log_sigmoidf_(mb + fb); }
        }
        __syncthreads();
        if (F.tid < 8) { float c = 0.f; for (int tt = 0; tt < 128; ++tt) { c += FLs[tt * 8 + F.tid]; FLs[tt * 8 + F.tid] = c; } BT[blk * 8 + F.tid] = c; }
        __syncthreads();
        for (int e = F.tid; e < 1024; e += NWAVES * 64) C[(size_t)blk * 1024 + e] = FLs[e];
        __syncthreads();
    }
}
__device__ __forceinline__ void p1_fix_c(const Frame& F0, const P& p) { const Frame F = phase_frame(F0);
    float* C = (float*)(p.ws + OFF_C); const float* BT = (const float*)(p.ws + OFF_BT);
    for (int blk = F.vcu; blk < T / 128; blk += F.G) {
        const int j = F.tid & 7, b0 = (blk / 64) * 64; float off = 0.f;
        for (int w = b0; w < blk; ++w) off += BT[w * 8 + j];
        for (int e = F.tid; e < 1024; e += NWAVES * 64) C[(size_t)blk * 1024 + e] += off;
    }
}
struct EpiIn1 {
    static constexpr bool PERM = true;
    unsigned char* ws; const float* lb_logits; LAS float* NS; const float* fq_norm; const float* fk_norm;
    __device__ __forceinline__ void operator()(const f32x4 (&acc)[2][2][4][2], const pg8::Unit& u, int wr, int wc, int fr, int fq) const {
        const int pn = u.e; int seg, colt;
        if (pn < 28) { seg = pn >> 2; colt = (pn & 3) * 256; } else if (pn < 36) { seg = 7; colt = (pn - 28) * 256; } else { seg = 8; colt = (pn - 36) * 256; }
        const int ldc = seg < 7 ? 1024 : 2048;
        bf16_t* base = (bf16_t*)(ws + (seg < 7 ? OFF_HQ + (size_t)seg * 64 * MiB : OFF_GA + (size_t)(seg - 7) * 128 * MiB));
        const int row0 = u.pm * 256 + wr * 64 + fr, col0 = colt + wc * 32 + 8 * fq;
        const int mode = (seg == 0) ? 0 : (seg == 1) ? 1 : (seg == 3) ? 3 : (seg >= 7) ? 4 : 2;
        if (seg == 4 || seg == 5) {
            const float* gn = (seg == 4) ? fq_norm : fk_norm; const float gs = (seg == 4) ? 0.08838834764831845f : 1.f;
#pragma unroll
            for (int ai = 0; ai < 2; ++ai)
#pragma unroll
                for (int m = 0; m < 4; ++m)
#pragma unroll
                    for (int bj = 0; bj < 2; ++bj) { const f32x4 a = acc[ai][bj][m][0], b = acc[ai][bj][m][1];
                        float q = a[0] * a[0] + a[1] * a[1] + a[2] * a[2] + a[3] * a[3] + b[0] * b[0] + b[1] * b[1] + b[2] * b[2] + b[3] * b[3];
                        q += __shfl_xor(q, 16); q += __shfl_xor(q, 32);
                        if (fq == 0) NS[(ai * 128 + wr * 64 + m * 16 + fr) * 8 + bj * 4 + wc] = q; }
            asm volatile("s_waitcnt lgkmcnt(0)" ::: "memory");
            __builtin_amdgcn_s_barrier();
            const f32x4 g0 = *(const f32x4*)(gn + 32 * wc + 8 * fq) * gs, g1 = *(const f32x4*)(gn + 32 * wc + 8 * fq + 4) * gs;
#pragma unroll
            for (int ai = 0; ai < 2; ++ai)
#pragma unroll
                for (int m = 0; m < 4; ++m) { bf16_t* rowp = base + (size_t)(row0 + ai * 128 + m * 16) * ldc + col0;
#pragma unroll
                    for (int bj = 0; bj < 2; ++bj) { const f32x4 t = *(const LAS f32x4*)(NS + (ai * 128 + wr * 64 + m * 16 + fr) * 8 + bj * 4);
                        const float rs = rsqrtf((t[0] + t[1] + t[2] + t[3]) * (1.f / 128.f) + EPS);
                        const f32x4 v0 = acc[ai][bj][m][0] * rs * g0, v1 = acc[ai][bj][m][1] * rs * g1;
                        u32x4 w; w.x = cvt_pk_bf16(v0[0], v0[1]); w.y = cvt_pk_bf16(v0[2], v0[3]); w.z = cvt_pk_bf16(v1[0], v1[1]); w.w = cvt_pk_bf16(v1[2], v1[3]);
                        *(u32x4*)(rowp + bj * 128) = w; } }
            return;
        }
        f32x4 lbv[2][2];
        if (mode == 1) {
#pragma unroll
            for (int bj = 0; bj < 2; ++bj)
#pragma unroll
                for (int n = 0; n < 2; ++n) { const int cc = col0 + bj * 128 + 4 * n; const f32x4 l0 = *(const f32x4*)(lb_logits + cc), l1 = *(const f32x4*)(lb_logits + 1024 + cc);
#pragma unroll
                    for (int j = 0; j < 4; ++j) lbv[bj][n][j] = __builtin_amdgcn_rcpf(1.f + __expf(l1[j] - l0[j])); }
        }
#pragma unroll
        for (int ai = 0; ai < 2; ++ai)
#pragma unroll
            for (int m = 0; m < 4; ++m) { bf16_t* rowp = base + (size_t)(row0 + ai * 128 + m * 16) * ldc + col0;
#pragma unroll
                for (int bj = 0; bj < 2; ++bj) { f32x4 v[2] = {acc[ai][bj][m][0], acc[ai][bj][m][1]};
#pragma unroll
                    for (int n = 0; n < 2; ++n)
#pragma unroll
                        for (int j = 0; j < 4; ++j) { float x = v[n][j];
                            if (mode == 0) x = x * fast_sigmoid(x) * 0.08838834764831845f;
                            else if (mode == 1) { const float lb = lbv[bj][n][j]; x = __logf(lb + (1.f - lb) * fast_sigmoid(x)); }
                            else if (mode == 3) x = x * fast_sigmoid(x);
                            else if (mode == 4) x = fast_sigmoid(x);
                            v[n][j] = x; }
                    u32x4 w; w.x = cvt_pk_bf16(v[0][0], v[0][1]); w.y = cvt_pk_bf16(v[0][2], v[0][3]); w.z = cvt_pk_bf16(v[1][0], v[1][1]); w.w = cvt_pk_bf16(v[1][2], v[1][3]);
                    *(u32x4*)(rowp + bj * 128) = w; } }
    }
};

template <int HH> struct EpiMergeT {
    static constexpr bool PERM = true;
    unsigned char* ws;
    __device__ __forceinline__ void operator()(const f32x4 (&acc)[2][2][4][2], const pg8::Unit& u, int wr, int wc, int fr, int fq) const {
        const int row0 = u.pm * 256 + wr * 64 + fr, col0 = u.pn * 256 + wc * 32 + 8 * fq;
        const bf16_t* G = (const bf16_t*)(ws + (HH ? OFF_GB : OFF_GA)); bf16_t* TMP = (bf16_t*)(ws + OFF_X1); bf16_t* MRG = (bf16_t*)(ws + OFF_MRG);
#pragma unroll
        for (int ai = 0; ai < 2; ++ai)
#pragma unroll
            for (int m = 0; m < 4; ++m) { const size_t ro = (size_t)(row0 + ai * 128 + m * 16) * D_MODEL + col0;
#pragma unroll
                for (int bj = 0; bj < 2; ++bj) { const u32x4 g = *(const u32x4*)(G + ro + bj * 128);
                    f32x4 v0 = acc[ai][bj][m][0], v1 = acc[ai][bj][m][1];
                    v0[0] *= __uint_as_float(g.x << 16); v0[1] *= __uint_as_float(g.x & 0xffff0000u); v0[2] *= __uint_as_float(g.y << 16); v0[3] *= __uint_as_float(g.y & 0xffff0000u);
                    v1[0] *= __uint_as_float(g.z << 16); v1[1] *= __uint_as_float(g.z & 0xffff0000u); v1[2] *= __uint_as_float(g.w << 16); v1[3] *= __uint_as_float(g.w & 0xffff0000u);
                    if constexpr (HH != 0) { const u32x4 t = *(const u32x4*)(TMP + ro + bj * 128);
                        v0[0] += __uint_as_float(t.x << 16); v0[1] += __uint_as_float(t.x & 0xffff0000u); v0[2] += __uint_as_float(t.y << 16); v0[3] += __uint_as_float(t.y & 0xffff0000u);
                        v1[0] += __uint_as_float(t.z << 16); v1[1] += __uint_as_float(t.z & 0xffff0000u); v1[2] += __uint_as_float(t.w << 16); v1[3] += __uint_as_float(t.w & 0xffff0000u); }
                    u32x4 w; w.x = cvt_pk_bf16(v0[0], v0[1]); w.y = cvt_pk_bf16(v0[2], v0[3]); w.z = cvt_pk_bf16(v1[0], v1[1]); w.w = cvt_pk_bf16(v1[2], v1[3]);
                    *(u32x4*)((HH ? MRG : TMP) + ro + bj * 128) = w;
                    }
                asm volatile("" ::: "memory"); }
    }
};
struct EpiWout1 {
    static constexpr bool PERM = true;
    const float* x; bf16_t* X1;
    __device__ __forceinline__ void operator()(const f32x4 (&acc)[2][2][4][2], const pg8::Unit& u, int wr, int wc, int fr, int fq) const {
        const int row0 = u.pm * 256 + wr * 64 + fr, col0 = u.pn * 256 + wc * 32 + 8 * fq;
#pragma unroll
        for (int ai = 0; ai < 2; ++ai)
#pragma unroll
            for (int m = 0; m < 4; ++m) { const size_t ro = (size_t)(row0 + ai * 128 + m * 16) * D_MODEL + col0;
#pragma unroll
                for (int bj = 0; bj < 2; ++bj) { const f32x4 v0 = *(const f32x4*)(x + ro + bj * 128) + acc[ai][bj][m][0], v1 = *(const f32x4*)(x + ro + bj * 128 + 4) + acc[ai][bj][m][1];
                    u32x4 w; w.x = cvt_pk_bf16(v0[0], v0[1]); w.y = cvt_pk_bf16(v0[2], v0[3]); w.z = cvt_pk_bf16(v1[0], v1[1]); w.w = cvt_pk_bf16(v1[2], v1[3]);
                    *(u32x4*)(X1 + ro + bj * 128) = w; } }
    }
};
struct EpiGU1 {
    static constexpr bool PERM = true;
    const float* b_gu; unsigned char* ACT; const float* ROWRS;
    __device__ __forceinline__ void operator()(const f32x4 (&acc)[2][2][4][2], const pg8::Unit& u, int wr, int wc, int fr, int fq) const {
        const int row0 = u.pm * 256 + wr * 64 + fr, ca = u.pn * 128 + wc * 32 + 8 * fq;
        const float* bg = b_gu + (size_t)u.e * 4096 + ca;
        const f32x4 bg0 = *(const f32x4*)bg, bg1 = *(const f32x4*)(bg + 4), bu0 = *(const f32x4*)(bg + 2048), bu1 = *(const f32x4*)(bg + 2052);
#pragma unroll
        for (int ai = 0; ai < 2; ++ai)
#pragma unroll
            for (int m = 0; m < 4; ++m) {
                const float rs = ROWRS[row0 + ai * 128 + m * 16];
                f32x4 g[2] = {acc[ai][0][m][0] * rs + bg0, acc[ai][0][m][1] * rs + bg1}, up[2] = {acc[ai][1][m][0] * rs + bu0, acc[ai][1][m][1] * rs + bu1}; float o[8];
#pragma unroll
                for (int n = 0; n < 2; ++n)
#pragma unroll
                    for (int j = 0; j < 4; ++j) { const float gg = fminf(g[n][j], 7.f), uu = fminf(fmaxf(up[n][j], -7.f), 7.f); o[n * 4 + j] = (uu + 1.f) * gg * fast_sigmoid(1.702f * gg); }
                u32x2 w; w.x = pk4_fp8(o[0], o[1], o[2], o[3]); w.y = pk4_fp8(o[4], o[5], o[6], o[7]);
                *(u32x2*)(ACT + (size_t)(row0 + ai * 128 + m * 16) * D_MODEL + ca) = w; }
    }
};
constexpr float YR_SCALE = 32.f;
struct EpiDown1 {
    static constexpr bool PERM = true;
    const float* b_down; const float* ROWW; unsigned char* YR;
    __device__ __forceinline__ void operator()(const f32x4 (&acc)[2][2][4][2], const pg8::Unit& u, int wr, int wc, int fr, int fq) const {
        const int row0 = u.pm * 256 + wr * 64 + fr, col0 = u.pn * 256 + wc * 32 + 8 * fq;
        const float* bb = b_down + (size_t)u.e * 2048 + col0;
        f32x4 bv[2][2];
#pragma unroll
        for (int bj = 0; bj < 2; ++bj) { bv[bj][0] = *(const f32x4*)(bb + bj * 128); bv[bj][1] = *(const f32x4*)(bb + bj * 128 + 4); }
#pragma unroll
        for (int ai = 0; ai < 2; ++ai)
#pragma unroll
            for (int m = 0; m < 4; ++m) { const int r = row0 + ai * 128 + m * 16; const float rw = ROWW[r];
#pragma unroll
                for (int bj = 0; bj < 2; ++bj) { f32x4 v0 = (acc[ai][bj][m][0] + bv[bj][0]) * (rw * YR_SCALE), v1 = (acc[ai][bj][m][1] + bv[bj][1]) * (rw * YR_SCALE);
#pragma unroll
                    for (int j = 0; j < 4; ++j) { v0[j] = __builtin_amdgcn_fmed3f(v0[j], -448.f, 448.f); v1[j] = __builtin_amdgcn_fmed3f(v1[j], -448.f, 448.f); }
                    u32x2 w; w.x = pk4_fp8(v0[0], v0[1], v0[2], v0[3]); w.y = pk4_fp8(v1[0], v1[1], v1[2], v1[3]);
                    *(u32x2*)(YR + (size_t)r * D_MODEL + col0 + bj * 128) = w; } }
    }
};
constexpr int TILEE_LDS_OFF = MISC_OFF + 1024;
__device__ __forceinline__ int load_tile_table(const Frame& F0, const P& p) { const Frame F = phase_frame(F0);
    const int* TILEE = (const int*)(p.ws + OFF_TILEE); LAS int* tl = (LAS int*)(F.lds + TILEE_LDS_OFF);
    for (int i = F.tid; i <= NTILES_MAX; i += NWAVES * 64) tl[i] = TILEE[i];
    __syncthreads();
    return tl[NTILES_MAX];
}


typedef short s16x4 __attribute__((ext_vector_type(4)));
__device__ __forceinline__ int img_off(int row, int ch) { return 256 * row + 16 * (ch ^ (((row & 3) << 2) | ((row >> 2) & 3))); }
__device__ __forceinline__ void tr_frag_issue(s16x4& lo, s16x4& hi, LAS unsigned char* img, int r0, int ctile, int lane) {
    const int q = (lane & 15) >> 2, pp = lane & 3;
    lo = __builtin_amdgcn_ds_read_tr16_b64_v4i16((LAS s16x4*)(img + img_off(r0 + q, 2 * ctile + (pp >> 1)) + 8 * (pp & 1)));
    hi = __builtin_amdgcn_ds_read_tr16_b64_v4i16((LAS s16x4*)(img + img_off(r0 + 4 + q, 2 * ctile + (pp >> 1)) + 8 * (pp & 1)));
}
__device__ __forceinline__ bf16x8 frag8(const s16x4& lo, const s16x4& hi) { return (bf16x8){lo[0], lo[1], lo[2], lo[3], hi[0], hi[1], hi[2], hi[3]}; }
__device__ __forceinline__ float clamp80(float x) { return fminf(fmaxf(x, -80.f), 80.f); }
constexpr int HG_V = 0, HG_K = 16384, HG_Q = 32768, HG_QH = 49152, HG_P = 65536, HG_SEG = 73728, HG_RED = 77824;

__device__ __forceinline__ void hgrn_cumsum(const Frame& F, const unsigned (&lf)[8], float (&b0)[8], float (&b1)[8], float& B0, float& B1) {
    LAS float* SEG = (LAS float*)(F.lds + HG_SEG);
    float c0 = 0.f, c1 = 0.f;
#pragma unroll
    for (int r = 0; r < 8; ++r) { c0 += __uint_as_float(lf[r] << 16); c1 += __uint_as_float(lf[r] & 0xffff0000u); b0[r] = c0; b1[r] = c1; }
    *(LAS f32x2*)(SEG + F.wave * 128 + 2 * F.lane) = (f32x2){c0, c1};
    __syncthreads();
    float p0 = 0.f, p1 = 0.f; B0 = 0.f; B1 = 0.f;
#pragma unroll
    for (int j = 0; j < 8; ++j) { const f32x2 s = *(const LAS f32x2*)(SEG + j * 128 + 2 * F.lane); if (j < F.wave) { p0 += s[0]; p1 += s[1]; } B0 += s[0]; B1 += s[1]; }
#pragma unroll
    for (int r = 0; r < 8; ++r) { b0[r] += p0; b1[r] += p1; }
}
__device__ __forceinline__ void hgrn_v_to_lds(const Frame& F, const bf16_t* HV, size_t tok0, int h) {
#pragma unroll
    for (int i = 0; i < 2; ++i) { const int qd = F.tid + 512 * i, row = qd >> 4, ch = qd & 15;
        const u32x4 v = *(const u32x4*)(HV + (tok0 + row) * 1024 + h * 128 + ch * 8);
        *(LAS u32x4*)(F.lds + HG_V + img_off(row, ch)) = v; }
}
__device__ __forceinline__ void p2_hgrn_local(const Frame& F0, const P& p) { const Frame F = phase_frame(F0);
    const bf16_t* LOGF = (const bf16_t*)(p.ws + OFF_LOGF); const bf16_t* HV = (const bf16_t*)(p.ws + OFF_HV);
    bf16_t* SLOC = (bf16_t*)(p.ws + OFF_SLOC); float* DEC = (float*)(p.ws + OFF_DEC);
    const int w = F.wave, lane = F.lane, g = lane >> 4;
    for (int it = F.vcu; it < 4096; it += F.G) {
        const int bh = it >> 7, n = it & 127, b = bh >> 3, h = bh & 7; const size_t tok0 = (size_t)b * SEQ + n * 64;
        const size_t gbase = (tok0 + 8 * w) * 1024 + h * 128 + 2 * lane;
        unsigned lf[8];
#pragma unroll
        for (int r = 0; r < 8; ++r) lf[r] = *(const unsigned*)(LOGF + gbase + (size_t)r * 1024);
        hgrn_v_to_lds(F, HV, tok0, h);
        float b0[8], b1[8], B0, B1;
        hgrn_cumsum(F, lf, b0, b1, B0, B1);
#pragma unroll
        for (int r = 0; r < 8; ++r) { const float l0 = __uint_as_float(lf[r] << 16), l1 = __uint_as_float(lf[r] & 0xffff0000u);
            const float k0 = (1.f - __expf(l0)) * __expf(B0 - b0[r]), k1 = (1.f - __expf(l1)) * __expf(B1 - b1[r]);
            *(LAS unsigned*)(F.lds + HG_K + img_off(8 * w + r, lane >> 2) + (lane & 3) * 4) = cvt_pk_bf16(k0, k1); }
        if (w == 0) *(f32x2*)(DEC + (size_t)it * 128 + 2 * lane) = (f32x2){__expf(B0), __expf(B1)};
        __syncthreads();
        s16x4 al[2], ah[2];
#pragma unroll
        for (int ks = 0; ks < 2; ++ks) tr_frag_issue(al[ks], ah[ks], F.lds + HG_K, 32 * ks + 8 * g, w, lane);
        f32x4 acc[8];
#pragma unroll
        for (int vt = 0; vt < 8; ++vt) {
            s16x4 bl[2], bh2[2];
#pragma unroll
            for (int ks = 0; ks < 2; ++ks) tr_frag_issue(bl[ks], bh2[ks], F.lds + HG_V, 32 * ks + 8 * g, vt, lane);
            acc[vt] = (f32x4){0.f, 0.f, 0.f, 0.f};
#pragma unroll
            for (int ks = 0; ks < 2; ++ks) acc[vt] = __builtin_amdgcn_mfma_f32_16x16x32_bf16(frag8(al[ks], ah[ks]), frag8(bl[ks], bh2[ks]), acc[vt], 0, 0, 0);
        }
#pragma unroll
        for (int vt = 0; vt < 8; ++vt) { u32x2 o; o.x = cvt_pk_bf16(acc[vt][0], acc[vt][1]); o.y = cvt_pk_bf16(acc[vt][2], acc[vt][3]);
            *(u32x2*)(SLOC + (size_t)it * 16384 + (size_t)(16 * vt + (lane & 15)) * 128 + 16 * w + 4 * g) = o; }
        __syncthreads();
    }
}
__device__ __forceinline__ void p3_hgrn_scan(const Frame& F0, const P& p) { const Frame F = phase_frame(F0);
    const bf16_t* SLOC = (const bf16_t*)(p.ws + OFF_SLOC); const float* DEC = (const float*)(p.ws + OFF_DEC); bf16_t* STATE = (bf16_t*)(p.ws + OFF_STATE);
    for (int gid = F.vcu * 512 + F.tid; gid < 32 * 4096; gid += F.G * 512) {
        const int bh = gid >> 12, e = (gid & 4095) * 4, c = e & 127;
        f32x4 st = {0.f, 0.f, 0.f, 0.f};
        for (int n0 = 0; n0 < 128; n0 += 8) {
            u32x2 sl[8]; f32x4 dc[8];
#pragma unroll
            for (int j = 0; j < 8; ++j) { const size_t it = (size_t)bh * 128 + n0 + j; sl[j] = *(const u32x2*)(SLOC + it * 16384 + e); dc[j] = *(const f32x4*)(DEC + it * 128 + c); }
#pragma unroll
            for (int j = 0; j < 8; ++j) { const size_t it = (size_t)bh * 128 + n0 + j;
                u32x2 o; o.x = cvt_pk_bf16(st[0], st[1]); o.y = cvt_pk_bf16(st[2], st[3]); *(u32x2*)(STATE + it * 16384 + e) = o;
                st[0] = dc[j][0] * st[0] + __uint_as_float(sl[j].x << 16); st[1] = dc[j][1] * st[1] + __uint_as_float(sl[j].x & 0xffff0000u);
                st[2] = dc[j][2] * st[2] + __uint_as_float(sl[j].y << 16); st[3] = dc[j][3] * st[3] + __uint_as_float(sl[j].y & 0xffff0000u); }
        }
    }
}
__device__ __forceinline__ void p4_hgrn_out(const Frame& F0, const P& p) { const Frame F = phase_frame(F0);
    const bf16_t* HQ = (const bf16_t*)(p.ws + OFF_HQ); const bf16_t* LOGF = (const bf16_t*)(p.ws + OFF_LOGF); const bf16_t* HV = (const bf16_t*)(p.ws + OFF_HV); const bf16_t* HG = (const bf16_t*)(p.ws + OFF_HG);
    const bf16_t* STATE = (const bf16_t*)(p.ws + OFF_STATE); bf16_t* AOUT = (bf16_t*)(p.ws + OFF_AOUT);
    const int w = F.wave, lane = F.lane, g = lane >> 4, l15 = lane & 15, tt = w & 3, vh = w >> 2;
    LAS float* RED = (LAS float*)(F.lds + HG_RED);
    unsigned* qhead = (unsigned*)(p.ws + WS_CTL) + CW_QH; LAS int* slot = (LAS int*)(F.lds + MISC_OFF + 768);
    if (F.tid == 0) { slot[1] = (int)__hip_atomic_fetch_add(qhead, 1u, __ATOMIC_RELAXED, __HIP_MEMORY_SCOPE_AGENT); slot[2] = (int)__hip_atomic_fetch_add(qhead, 1u, __ATOMIC_RELAXED, __HIP_MEMORY_SCOPE_AGENT); }
    __syncthreads();
    int it = __builtin_amdgcn_readfirstlane(slot[1]), itn = __builtin_amdgcn_readfirstlane(slot[2]), par = 0;
    unsigned lfN[8], qqN[8]; u32x2 hgN[4]; u32x4 vN[2];
#define HGO_PRE(item) do { const int bh_ = (item) >> 7, n_ = (item) & 127, b_ = bh_ >> 3, h_ = bh_ & 7; const size_t tok_ = (size_t)b_ * SEQ + n_ * 64, gb_ = (tok_ + 8 * w) * 1024 + h_ * 128 + 2 * lane; \
        _Pragma("unroll") for (int r = 0; r < 8; ++r) { lfN[r] = *(const unsigned*)(LOGF + gb_ + (size_t)r * 1024); qqN[r] = *(const unsigned*)(HQ + gb_ + (size_t)r * 1024); } \
        _Pragma("unroll") for (int vt = 0; vt < 4; ++vt) hgN[vt] = *(const u32x2*)(HG + (tok_ + 16 * tt + l15) * 1024 + h_ * 128 + 64 * vh + 16 * vt + 4 * g); \
        _Pragma("unroll") for (int i = 0; i < 2; ++i) { const int qd = F.tid + 512 * i, row = qd >> 4, ch = qd & 15; vN[i] = *(const u32x4*)(HV + (tok_ + row) * 1024 + h_ * 128 + ch * 8); } } while (0)
    if (it < 4096) HGO_PRE(it);
    while (it < 4096) {
        if (F.tid == 0) slot[3 + par] = (int)__hip_atomic_fetch_add(qhead, 1u, __ATOMIC_RELAXED, __HIP_MEMORY_SCOPE_AGENT);
        const int bh = it >> 7, n = it & 127, b = bh >> 3, h = bh & 7; const size_t tok0 = (size_t)b * SEQ + n * 64;
        bf16x8 sfr[4][4];
#pragma unroll
        for (int vt = 0; vt < 4; ++vt)
#pragma unroll
            for (int ks = 0; ks < 4; ++ks) sfr[vt][ks] = *(const bf16x8*)(STATE + (size_t)it * 16384 + (size_t)(64 * vh + 16 * vt + l15) * 128 + 32 * ks + 8 * g);
        u32x2 hgv[4]; unsigned lf[8], qq[8];
#pragma unroll
        for (int vt = 0; vt < 4; ++vt) hgv[vt] = hgN[vt];
#pragma unroll
        for (int r = 0; r < 8; ++r) { lf[r] = lfN[r]; qq[r] = qqN[r]; }
#pragma unroll
        for (int i = 0; i < 2; ++i) { const int qd = F.tid + 512 * i, row = qd >> 4, ch = qd & 15; *(LAS u32x4*)(F.lds + HG_V + img_off(row, ch)) = vN[i]; }
        { const int nx = itn < 4096 ? itn : 4095; HGO_PRE(nx); }
        float b0[8], b1[8], B0, B1;
        hgrn_cumsum(F, lf, b0, b1, B0, B1);
        const float r0 = 0.5f * B0, r1 = 0.5f * B1;
#pragma unroll
        for (int r = 0; r < 8; ++r) { const float l0 = __uint_as_float(lf[r] << 16), l1 = __uint_as_float(lf[r] & 0xffff0000u), q0 = __uint_as_float(qq[r] << 16), q1 = __uint_as_float(qq[r] & 0xffff0000u);
            const int off = img_off(8 * w + r, lane >> 2) + (lane & 3) * 4;
            *(LAS unsigned*)(F.lds + HG_Q + off) = cvt_pk_bf16(q0 * __expf(clamp80(b0[r] - r0)), q1 * __expf(clamp80(b1[r] - r1)));
            *(LAS unsigned*)(F.lds + HG_K + off) = cvt_pk_bf16((1.f - __expf(l0)) * __expf(clamp80(r0 - b0[r])), (1.f - __expf(l1)) * __expf(clamp80(r1 - b1[r])));
            *(LAS unsigned*)(F.lds + HG_QH + off) = cvt_pk_bf16(q0 * __expf(b0[r]), q1 * __expf(b1[r])); }
        __syncthreads();
#pragma unroll
        for (int si = 0; si < 2; ++si) { const int st = 2 * vh + si; f32x4 sc = {0.f, 0.f, 0.f, 0.f};
#pragma unroll
            for (int ks = 0; ks < 4; ++ks) { const bf16x8 a = *(const LAS bf16x8*)(F.lds + HG_K + img_off(16 * st + l15, 4 * ks + g)), bq = *(const LAS bf16x8*)(F.lds + HG_Q + img_off(16 * tt + l15, 4 * ks + g));
                sc = __builtin_amdgcn_mfma_f32_16x16x32_bf16(a, bq, sc, 0, 0, 0); }
#pragma unroll
            for (int rg = 0; rg < 4; ++rg) sc[rg] = (16 * st + 4 * g + rg > 16 * tt + l15) ? 0.f : sc[rg];
            const int t = 16 * tt + l15, chunk = 2 * st + (g >> 1);
            u32x2 o; o.x = cvt_pk_bf16(sc[0], sc[1]); o.y = cvt_pk_bf16(sc[2], sc[3]);
            *(LAS u32x2*)(F.lds + HG_P + t * 128 + ((chunk ^ (t & 7)) * 16) + 8 * (g & 1)) = o; }
        __syncthreads();
        bf16x8 pb[2], qb[4];
        { const int t = 16 * tt + l15;
#pragma unroll
          for (int ks = 0; ks < 2; ++ks) pb[ks] = *(const LAS bf16x8*)(F.lds + HG_P + t * 128 + (((4 * ks + g) ^ (t & 7)) * 16));
#pragma unroll
          for (int ks = 0; ks < 4; ++ks) qb[ks] = *(const LAS bf16x8*)(F.lds + HG_QH + img_off(t, 4 * ks + g)); }
        f32x4 oacc[4]; float ssq = 0.f;
#pragma unroll
        for (int vt = 0; vt < 4; ++vt) {
            s16x4 vl[2], vhh[2];
#pragma unroll
            for (int ks = 0; ks < 2; ++ks) tr_frag_issue(vl[ks], vhh[ks], F.lds + HG_V, 32 * ks + 8 * g, 4 * vh + vt, lane);
            f32x4 a = {0.f, 0.f, 0.f, 0.f};
#pragma unroll
            for (int ks = 0; ks < 2; ++ks) a = __builtin_amdgcn_mfma_f32_16x16x32_bf16(frag8(vl[ks], vhh[ks]), pb[ks], a, 0, 0, 0);
#pragma unroll
            for (int ks = 0; ks < 4; ++ks) a = __builtin_amdgcn_mfma_f32_16x16x32_bf16(sfr[vt][ks], qb[ks], a, 0, 0, 0);
            oacc[vt] = a; ssq += a[0] * a[0] + a[1] * a[1] + a[2] * a[2] + a[3] * a[3];
        }
        ssq += __shfl_xor(ssq, 16); ssq += __shfl_xor(ssq, 32);
        if (g == 0) RED[(16 * tt + l15) * 2 + vh] = ssq;
        __syncthreads();
        { const int t = 16 * tt + l15; const float tot = RED[t * 2] + RED[t * 2 + 1], rs = rsqrtf(tot * (1.f / 128.f) + EPS);
#pragma unroll
          for (int vt = 0; vt < 4; ++vt) { const int v0 = 64 * vh + 16 * vt + 4 * g; const f32x4 gn = *(const f32x4*)(p.hg_norm + v0);
              const float y0 = oacc[vt][0] * rs * gn[0] * __uint_as_float(hgv[vt].x << 16), y1 = oacc[vt][1] * rs * gn[1] * __uint_as_float(hgv[vt].x & 0xffff0000u);
              const float y2 = oacc[vt][2] * rs * gn[2] * __uint_as_float(hgv[vt].y << 16), y3 = oacc[vt][3] * rs * gn[3] * __uint_as_float(hgv[vt].y & 0xffff0000u);
              u32x2 o; o.x = cvt_pk_bf16(y0, y1); o.y = cvt_pk_bf16(y2, y3);
              *(u32x2*)(AOUT + (tok0 + t) * 1024 + h * 128 + v0) = o; } }
        __syncthreads();
        it = itn; itn = __builtin_amdgcn_readfirstlane(slot[3 + par]); par ^= 1;
    }
#undef HGO_PRE
}

namespace fox {
constexpr int NW = 8, QBLK = 32, KVBLK = 64, QB = NW * QBLK, D = 128, RS = 1024;
constexpr int SHM_V = KVBLK * D * 2, SHM_K = KVBLK * D * 2;
constexpr int OFF_VL = 0, OFF_KL = 2 * SHM_V, OFF_WS = 2 * SHM_V + 2 * SHM_K, OFF_BIAS = OFF_WS + NW * 64 * 4, OFF_ITEM = OFF_BIAS + 2 * 64 * 4;
constexpr float THR = 8.f;
typedef float f32x16 __attribute__((ext_vector_type(16)));
#define KSWZ(row, colB) ((row) * 256 + ((colB) ^ (((row) & 7) << 4)))
#define SBAR() __builtin_amdgcn_sched_barrier(0)
__device__ __forceinline__ int v_st(int k, int c) { const int kk = (k & ~0xC) | ((k & 4) << 1) | ((k & 8) >> 1); return ((kk >> 3) * 4 + (c >> 5)) * 512 + ((kk & 7) * 32 + (c & 31)) * 2; }
__device__ __forceinline__ int v_rd_base(int lane) { return ((lane & 3) << 3) | (((lane >> 2) & 3) << 6) | (((lane >> 4) & 1) << 5) | (((lane >> 5) & 1) << 8); }
constexpr int v_rd_off(int d0, int ks, int half) { return d0 * 512 + ks * 4096 + half * 2048; }
__device__ __forceinline__ int crow(int r, int hi) { return (r & 3) + 8 * (r >> 2) + 4 * hi; }
__device__ __forceinline__ void mask_tile(f32x16& p0, f32x16& p1, int dq) {
    const float NEG = -__builtin_inff();
#pragma unroll
    for (int r = 0; r < 16; ++r) { const int c = (r & 3) + 8 * (r >> 2); if (dq - c < 0) p0[r] = NEG; if (dq - c - 32 < 0) p1[r] = NEG; }
}
__device__ __forceinline__ void partialSM(f32x16& p0, f32x16& p1, float& m_reg, float& mn, float& alpha) {
    float pmax = p0[0];
#pragma unroll
    for (int r = 1; r < 16; ++r) pmax = fmaxf(pmax, p0[r]);
#pragma unroll
    for (int r = 0; r < 16; ++r) pmax = fmaxf(pmax, p1[r]);
    { auto rr = __builtin_amdgcn_permlane32_swap(__float_as_uint(pmax), __float_as_uint(pmax), false, false); pmax = fmaxf(__uint_as_float(rr[0]), __uint_as_float(rr[1])); }
    constexpr float C2 = 1.4426950408889634f;
    if (__builtin_expect(__all((pmax - m_reg) <= THR), 1)) { mn = m_reg; alpha = 1.f; }
    else { mn = fmaxf(m_reg, pmax); alpha = __builtin_amdgcn_exp2f((m_reg - mn) * C2); m_reg = mn; }
    const float mnL = -mn * C2;
#pragma unroll
    for (int r = 0; r < 16; ++r) p0[r] = fmaf(p0[r], C2, mnL);
#pragma unroll
    for (int r = 0; r < 16; ++r) p1[r] = fmaf(p1[r], C2, mnL);
#pragma unroll
    for (int r = 0; r < 16; ++r) p0[r] = __builtin_amdgcn_exp2f(p0[r]);
}
__device__ __forceinline__ void finishSM(f32x16& p0, f32x16& p1, float alpha, float& l_reg, bf16x8& pa0, bf16x8& pa1, bf16x8& pa2, bf16x8& pa3) {
#pragma unroll
    for (int r = 0; r < 16; ++r) p1[r] = __builtin_amdgcn_exp2f(p1[r]);
    float ps = 0;
#pragma unroll
    for (int r = 0; r < 16; ++r) ps += p0[r];
#pragma unroll
    for (int r = 0; r < 16; ++r) ps += p1[r];
    { auto rr = __builtin_amdgcn_permlane32_swap(__float_as_uint(ps), __float_as_uint(ps), false, false); ps = __uint_as_float(rr[0]) + __uint_as_float(rr[1]); }
    l_reg = l_reg * alpha + ps;
#define PK4(P, B_, OUT) do { unsigned a0 = cvt_pk_bf16(P[B_+0], P[B_+1]), a1 = cvt_pk_bf16(P[B_+2], P[B_+3]); unsigned b0 = cvt_pk_bf16(P[B_+4], P[B_+5]), b1 = cvt_pk_bf16(P[B_+6], P[B_+7]); \
        auto r0 = __builtin_amdgcn_permlane32_swap(a0, b0, false, false); auto r1 = __builtin_amdgcn_permlane32_swap(a1, b1, false, false); \
        u32x4 w = {r0[0], r1[0], r0[1], r1[1]}; OUT = *reinterpret_cast<bf16x8*>(&w); } while (0)
    PK4(p0, 0, pa0); PK4(p0, 8, pa1); PK4(p1, 0, pa2); PK4(p1, 8, pa3);
#undef PK4
}
template <int KB>
__device__ __forceinline__ void qkt(f32x16& p0, f32x16& p1, const LAS char* lds, int r32, int hi, const bf16x8* qr) {
    const LAS float* bb = (const LAS float*)(lds + OFF_BIAS) + KB * 64 + 4 * hi;
#pragma unroll
    for (int j = 0; j < 4; ++j) { const f32x4 a = *(const LAS f32x4*)(bb + 8 * j), b = *(const LAS f32x4*)(bb + 32 + 8 * j);
        p0[4 * j] = a[0]; p0[4 * j + 1] = a[1]; p0[4 * j + 2] = a[2]; p0[4 * j + 3] = a[3]; p1[4 * j] = b[0]; p1[4 * j + 1] = b[1]; p1[4 * j + 2] = b[2]; p1[4 * j + 3] = b[3]; }
    const LAS char* kb[4];
#pragma unroll
    for (int dd = 0; dd < 4; ++dd) kb[dd] = lds + OFF_KL + KB * SHM_K + KSWZ(r32, (dd * 16 + hi * 8) * 2);
#pragma unroll
    for (int d0 = 0; d0 < 8; ++d0) { const LAS char* a = kb[d0 & 3] + (d0 >> 2) * 128;
        const bf16x8 b0 = *reinterpret_cast<const LAS bf16x8*>(a), b1 = *reinterpret_cast<const LAS bf16x8*>(a + 32 * 256);
        p0 = __builtin_amdgcn_mfma_f32_32x32x16_bf16(b0, qr[d0], p0, 0, 0, 0);
        p1 = __builtin_amdgcn_mfma_f32_32x32x16_bf16(b1, qr[d0], p1, 0, 0, 0); }
}
template <int VB>
__device__ __forceinline__ void pv_tile(f32x16* o, const LAS char* vb0, bf16x8 pa0, bf16x8 pa1, bf16x8 pa2, bf16x8 pa3) {
#define TRR(off) __builtin_amdgcn_ds_read_tr16_b64_v4i16((LAS s16x4*)(vb0 + (off)))
#define PV_D0(d0) do { constexpr int b_ = VB * SHM_V + v_rd_off(d0, 0, 0); \
        const s16x4 l0 = TRR(b_), h0 = TRR(b_ + 2048), l1 = TRR(b_ + 4096), h1 = TRR(b_ + 6144), l2 = TRR(b_ + 8192), h2 = TRR(b_ + 10240), l3 = TRR(b_ + 12288), h3 = TRR(b_ + 14336); \
        o[d0] = __builtin_amdgcn_mfma_f32_32x32x16_bf16(pa0, (bf16x8){l0[0], l0[1], l0[2], l0[3], h0[0], h0[1], h0[2], h0[3]}, o[d0], 0, 0, 0); \
        o[d0] = __builtin_amdgcn_mfma_f32_32x32x16_bf16(pa1, (bf16x8){l1[0], l1[1], l1[2], l1[3], h1[0], h1[1], h1[2], h1[3]}, o[d0], 0, 0, 0); \
        o[d0] = __builtin_amdgcn_mfma_f32_32x32x16_bf16(pa2, (bf16x8){l2[0], l2[1], l2[2], l2[3], h2[0], h2[1], h2[2], h2[3]}, o[d0], 0, 0, 0); \
        o[d0] = __builtin_amdgcn_mfma_f32_32x32x16_bf16(pa3, (bf16x8){l3[0], l3[1], l3[2], l3[3], h3[0], h3[1], h3[2], h3[3]}, o[d0], 0, 0, 0); } while (0)
    PV_D0(0); PV_D0(1); PV_D0(2); PV_D0(3);
#undef PV_D0
#undef TRR
}
struct BlockRef { const bf16_t* Q; const bf16_t* K; const bf16_t* V; bf16_t* O; const float* Cp; int P0, jlo; float cref; };
struct Seam { bf16x8 qr[8]; bf16x8 st_v0, st_v1, st_k0, st_k1; float sb0, sb1; };
#define ROW(p, k0, rr) ((p) + (size_t)((k0) + (rr)) * RS + sc)
#define VMW() asm volatile("s_waitcnt vmcnt(0)" ::: "memory")
#define VMWN(n) asm volatile("s_waitcnt vmcnt(%0)" :: "i"(n) : "memory")
#define SLOAD_H(R, k0) do { S.st_v0 = *(const bf16x8*)ROW((R).V, k0, sr); S.st_v1 = *(const bf16x8*)ROW((R).V, k0, 32 + sr); S.st_k0 = *(const bf16x8*)ROW((R).K, k0, sr); S.st_k1 = *(const bf16x8*)ROW((R).K, k0, 32 + sr); \
        S.sb0 = (R).Cp[(size_t)((k0) + sr) * 8]; S.sb1 = (R).Cp[(size_t)((k0) + 32 + sr) * 8]; } while (0)
#define SWRITE_HK(bf, cr) do { *(LAS bf16x8*)(K_lds + (bf) * SHM_K + kws) = S.st_k0; *(LAS bf16x8*)(K_lds + (bf) * SHM_K + kws + 32 * 256) = S.st_k1; \
        if (sc == 0) { BIASL[(bf) * 64 + sr] = (cr) - S.sb0; BIASL[(bf) * 64 + 32 + sr] = (cr) - S.sb1; } } while (0)
#define SWRITE_HV(bf) do { *(LAS bf16x8*)(V_lds + (bf) * SHM_V + vst0) = S.st_v0; *(LAS bf16x8*)(V_lds + (bf) * SHM_V + vst1) = S.st_v1; } while (0)
#define SWRITE_H(bf, cr) do { SWRITE_HV(bf); SWRITE_HK(bf, cr); } while (0)
__device__ __forceinline__ void prime(const BlockRef& cur, LAS char* lds, Seam& S) {
    int tid = threadIdx.x; asm volatile("" : "+v"(tid)); const int wid = __builtin_amdgcn_readfirstlane(tid >> 6), lane = tid & 63, r32 = lane & 31, hi = lane >> 5;
    const int sr = tid >> 4, sc = (tid & 15) * 8, kws = KSWZ(sr, sc * 2); LAS char* K_lds = lds + OFF_KL; LAS float* BIASL = (LAS float*)(lds + OFF_BIAS);
    const int kb0 = cur.jlo * KVBLK;
#pragma unroll
    for (int d0 = 0; d0 < 8; ++d0) S.qr[d0] = *(const bf16x8*)(cur.Q + (size_t)(wid * QBLK + r32) * RS + d0 * 16 + hi * 8);
    SLOAD_H(cur, kb0); VMW(); SWRITE_HK(0, cur.cref);
    __syncthreads();
}
__device__ __forceinline__ void block(const BlockRef& cur, const BlockRef& nxt, LAS char* lds, Seam& S) {
    const int tid = threadIdx.x, wid = __builtin_amdgcn_readfirstlane(tid >> 6), lane = tid & 63, r32 = lane & 31, hi = lane >> 5;
    const int j_lo = cur.jlo, j_hi = (cur.P0 + QB - 1) / KVBLK + 1, NT = j_hi - j_lo;
    const int kbn = nxt.jlo * KVBLK;
    const int qlo = cur.P0 + wid * QBLK, qm = qlo + r32 - 4 * hi;
    LAS char* V_lds = lds + OFF_VL; LAS char* K_lds = lds + OFF_KL; LAS float* BIASL = (LAS float*)(lds + OFF_BIAS);
    LAS float* ws = (LAS float*)(lds + OFF_WS) + wid * 64; LAS float* li_l = ws; LAS float* al_l = ws + 32;
    float m_reg = -1e30f, l_reg = 0; f32x16 o[4] = {};
    const int sr = tid >> 4, sc = (tid & 15) * 8, vst0 = v_st(sr, sc), vst1 = v_st(32 + sr, sc), kws = KSWZ(sr, sc * 2);
    const LAS char* vb0 = V_lds + v_rd_base(lane);
#define RESC(a) do { if (__any((a) < 1.f)) { if (hi == 0) al_l[r32] = (a); asm volatile("s_waitcnt lgkmcnt(0)" ::: "memory"); \
                     for (int d_ = 0; d_ < 4; ++d_) for (int r = 0; r < 16; ++r) o[d_][r] *= al_l[crow(r, hi)]; } } while (0)
#define KBASE(t) ((j_lo + (t)) * KVBLK)
#define MASKT(P0_, P1_, t) do { const int kb_ = KBASE(t); if (kb_ + KVBLK - 1 > qlo) mask_tile(P0_, P1_, qm - kb_); } while (0)
#define SEAM_K0() do { VMWN(8); SWRITE_HK(0, nxt.cref); SBAR(); } while (0)
    f32x16 pA0, pA1, pB0, pB1; float mnA, mnB, alA, alB; bf16x8 pa0, pa1, pa2, pa3;
    SWRITE_HV(0); SBAR();
    if (NT > 1) SLOAD_H(cur, KBASE(1));
    SBAR(); qkt<0>(pA0, pA1, lds, r32, hi, S.qr);
    mask_tile(pA0, pA1, qm - KBASE(0)); partialSM(pA0, pA1, m_reg, mnA, alA);
    if (NT > 1) { VMW(); SWRITE_H(1, cur.cref); }
    __syncthreads();
#define HALF_STEP(PX0, PX1, mnX, alX, PY0, PY1, alY, t, KB, VB, SB) do { \
        SBAR(); qkt<KB>(PX0, PX1, lds, r32, hi, S.qr); \
        finishSM(PY0, PY1, alY, l_reg, pa0, pa1, pa2, pa3); SBAR(); \
        if ((t) + 1 < NT) { SLOAD_H(cur, KBASE((t) + 1)); SBAR(); } \
        pv_tile<VB>(o, vb0, pa0, pa1, pa2, pa3); MASKT(PX0, PX1, (t)); partialSM(PX0, PX1, m_reg, mnX, alX); \
        __syncthreads(); \
        if ((t) + 1 < NT) { VMW(); SWRITE_H(SB, cur.cref); } \
        RESC(alX); __syncthreads(); } while (0)
    for (int t = 1; t + 1 < NT; t += 2) {
        HALF_STEP(pB0, pB1, mnB, alB, pA0, pA1, alA, t, 1, 0, 0);
        HALF_STEP(pA0, pA1, mnA, alA, pB0, pB1, alB, t + 1, 0, 1, 1);
    }
    const bool even = (NT & 1) == 0;
    if (even) { SBAR(); qkt<1>(pB0, pB1, lds, r32, hi, S.qr); SBAR(); }
    SLOAD_H(nxt, kbn); SBAR();
#pragma unroll
    for (int d0 = 0; d0 < 8; ++d0) S.qr[d0] = *(const bf16x8*)(nxt.Q + (size_t)(wid * QBLK + r32) * RS + d0 * 16 + hi * 8);
    SBAR();
    finishSM(pA0, pA1, alA, l_reg, pa0, pa1, pa2, pa3); SBAR();
    pv_tile<0>(o, vb0, pa0, pa1, pa2, pa3);
    if (even) { MASKT(pB0, pB1, NT - 1); partialSM(pB0, pB1, m_reg, mnB, alB); __syncthreads(); RESC(alB);
        finishSM(pB0, pB1, alB, l_reg, pa0, pa1, pa2, pa3); SBAR(); pv_tile<1>(o, vb0, pa0, pa1, pa2, pa3); }
    SBAR(); SEAM_K0();
    if (hi == 0) li_l[r32] = l_reg; asm volatile("s_waitcnt lgkmcnt(0)" ::: "memory");
    const __amdgpu_buffer_rsrc_t orsrc = __builtin_amdgcn_make_buffer_rsrc((void*)(cur.O + (size_t)(wid * QBLK) * RS), 0, QBLK * RS * 2, 0x00020000);
    const int ovoff = (hi * 4 * RS + r32) * 2;
#pragma unroll
    for (int r = 0; r < 16; ++r) { const int orow0 = (r & 3) + 8 * (r >> 2); const float rl = __builtin_amdgcn_rcpf(li_l[orow0 + 4 * hi]);
#pragma unroll
        for (int d0 = 0; d0 < 4; ++d0) { const float v = o[d0][r] * rl; const float vn = __shfl_xor(v, 1);
            if ((r32 & 1) == 0) __builtin_amdgcn_raw_buffer_store_b32(cvt_pk_bf16(v, vn), orsrc, ovoff, orow0 * RS * 2 + d0 * 64, 0); } }
    __syncthreads();
#undef RESC
#undef KBASE
#undef MASKT
#undef SEAM_K0
#undef HALF_STEP
}
#undef ROW
#undef VMW
#undef VMWN
#undef SLOAD_H
#undef SWRITE_HK
#undef SWRITE_HV
#undef SWRITE_H
#undef KSWZ
#undef SBAR
}
constexpr int CW_ATTQ = 64;
__device__ __forceinline__ void p2_jlo(const Frame& F0, const P& p) { const Frame F = phase_frame(F0);
    const float* C = (const float*)(p.ws + OFF_C); int* JLO = (int*)(p.ws + OFF_JLO);
    const int gw = F.vcu * NWAVES + F.wave, NGW = F.G * NWAVES, lane = F.lane;
    const float gq = wave_max(fmaxf(fabsf(p.fq_norm[2 * lane]), fabsf(p.fq_norm[2 * lane + 1]))), gk = wave_max(fmaxf(fabsf(p.fk_norm[2 * lane]), fabsf(p.fk_norm[2 * lane + 1])));
    const float th = -(2.f * 1.02f * gq * gk * 11.3137085f + 104.f);
    for (int e = gw; e < BATCH * HEADS * 32; e += NGW) {
        const int b = e >> 8, h = (e >> 5) & 7, qb = e & 31, P0 = qb * 256;
        const float* Cp = C + (size_t)b * SEQ * 8 + h; const float c0 = Cp[(size_t)P0 * 8];
        int cnt = 0;
#pragma unroll
        for (int i = 0; i < 2; ++i) { const int j = lane + 64 * i, kl = 64 * j + 63; const bool neg = (kl < P0) && (c0 - Cp[(size_t)(kl < SEQ ? kl : 0) * 8] < th); cnt += __popcll(__ballot(neg)); }
        if (lane == 0) JLO[e] = cnt;
    }
}
__device__ __forceinline__ void p4_attention(const Frame& F0, const P& p, int rep) { const Frame F = phase_frame(F0);
    LAS char* lds = (LAS char*)F.lds; LAS int* ITEM = (LAS int*)(lds + fox::OFF_ITEM);
    const bf16_t* FQ = (const bf16_t*)(p.ws + OFF_FQ); const bf16_t* FK = (const bf16_t*)(p.ws + OFF_FK); const bf16_t* FV = (const bf16_t*)(p.ws + OFF_FV); bf16_t* BOUT = (bf16_t*)(p.ws + OFF_BOUT);
    const float* C = (const float*)(p.ws + OFF_C); const int* JLO = (const int*)(p.ws + OFF_JLO);
    unsigned* qhead = (unsigned*)(p.ws + WS_CTL) + CW_ATTQ + 64 * rep;
    constexpr int TOTAL = BATCH * HEADS * 32;
    if (F.tid == 0) { float fb[8]; for (int i = 0; i < 8; ++i) fb[i] = p.f_bias[i];
        for (int r = 0; r < 8; ++r) { int best = 0; for (int i = 1; i < 8; ++i) if (fb[i] > fb[best]) best = i; ITEM[r] = best; fb[best] = -INFINITY; }
        ITEM[8] = (int)__hip_atomic_fetch_add(qhead, 1u, __ATOMIC_RELAXED, __HIP_MEMORY_SCOPE_AGENT); }
    __syncthreads();
    auto mkref = [&](int L) { fox::BlockRef r; const int hr = L >> 7, rr = L & 127, qb = 31 - (rr >> 2), b = rr & 3, h = __builtin_amdgcn_readfirstlane(ITEM[hr]); const size_t t0 = (size_t)b * SEQ;
        r.Q = FQ + (t0 + qb * 256) * 1024 + h * 128; r.K = FK + t0 * 1024 + h * 128; r.V = FV + t0 * 1024 + h * 128; r.O = BOUT + (t0 + qb * 256) * 1024 + h * 128;
        r.Cp = C + t0 * 8 + h; r.P0 = qb * 256; r.jlo = __builtin_amdgcn_readfirstlane(JLO[(b * 8 + h) * 32 + qb]);
        r.cref = __uint_as_float(__builtin_amdgcn_readfirstlane(__float_as_uint(r.Cp[(size_t)(qb * 256 + 255) * 8]))); return r; };
    int L = __builtin_amdgcn_readfirstlane(ITEM[8]);
    if (L >= TOTAL) return;
    if (F.tid == 0) ITEM[9] = (int)__hip_atomic_fetch_add(qhead, 1u, __ATOMIC_RELAXED, __HIP_MEMORY_SCOPE_AGENT);
    __syncthreads();
    int Ln = __builtin_amdgcn_readfirstlane(ITEM[9]);
    fox::BlockRef cur = mkref(L);
    fox::Seam S;
    fox::prime(cur, lds, S);
    for (int it = 0;; ++it) {
        const bool last = Ln >= TOTAL;
        if (!last && F.tid == 0) ITEM[8 + (it & 1)] = (int)__hip_atomic_fetch_add(qhead, 1u, __ATOMIC_RELAXED, __HIP_MEMORY_SCOPE_AGENT);
        const fox::BlockRef nxt = last ? cur : mkref(Ln);
        fox::block(cur, nxt, lds, S);
        if (last) break;
        cur = nxt; L = Ln; Ln = __builtin_amdgcn_readfirstlane(ITEM[8 + (it & 1)]);
    }
}
__device__ __forceinline__ void p2_qknorm(const Frame& F0, const P& p) { const Frame F = phase_frame(F0);
    bf16_t* FQ = (bf16_t*)(p.ws + OFF_FQ); bf16_t* FK = (bf16_t*)(p.ws + OFF_FK);
    const int gw = F.vcu * NWAVES + F.wave, NGW = F.G * NWAVES, lane = F.lane, d0 = (lane & 7) * 16;
    float gq[16], gk[16];
#pragma unroll
    for (int j = 0; j < 16; ++j) { gq[j] = p.fq_norm[d0 + j] * 0.08838834764831845f; gk[j] = p.fk_norm[d0 + j]; }
    for (int t = gw; t < T; t += NGW) {
#pragma unroll
        for (int which = 0; which < 2; ++which) {
            bf16_t* ptr = (which ? FK : FQ) + (size_t)t * 1024 + lane * 16;
            const u32x4 a = *(const u32x4*)ptr, b = *(const u32x4*)(ptr + 8); const unsigned w[8] = {a.x, a.y, a.z, a.w, b.x, b.y, b.z, b.w};
            float v[16]; float ss = 0.f;
#pragma unroll
            for (int j = 0; j < 8; ++j) { v[2 * j] = __uint_as_float(w[j] << 16); v[2 * j + 1] = __uint_as_float(w[j] & 0xffff0000u); ss += v[2 * j] * v[2 * j] + v[2 * j + 1] * v[2 * j + 1]; }
            ss += __shfl_xor(ss, 1); ss += __shfl_xor(ss, 2); ss += __shfl_xor(ss, 4);
            const float rs = rsqrtf(ss * (1.f / 128.f) + EPS);
            unsigned o[8];
#pragma unroll
            for (int j = 0; j < 8; ++j) o[j] = which ? cvt_pk_bf16(v[2 * j] * rs * gk[2 * j], v[2 * j + 1] * rs * gk[2 * j + 1]) : cvt_pk_bf16(v[2 * j] * rs * gq[2 * j], v[2 * j + 1] * rs * gq[2 * j + 1]);
            *(u32x4*)ptr = (u32x4){o[0], o[1], o[2], o[3]}; *(u32x4*)(ptr + 8) = (u32x4){o[4], o[5], o[6], o[7]};
        }
    }
}
__device__ __forceinline__ void p7_router(const Frame& F0, const P& p) { const Frame F = phase_frame(F0);
    LAS int* hist = (LAS int*)(F.lds + MISC_OFF + 512);
    const bf16_t* X1 = (const bf16_t*)(p.ws + OFF_X1B); unsigned char* H2 = p.ws + OFF_H2; const bf16_t* RWT = (const bf16_t*)(p.ws + OFF_RWT); float* RSTD = (float*)(p.ws + OFF_RSTD);
    int* TOPI = (int*)(p.ws + OFF_TOPI); float* GATE = (float*)(p.ws + OFF_GATE); int* CNT = (int*)(p.ws + OFF_CNT);
    const int lane = F.lane, l15 = lane & 15, kg = lane >> 4;
    for (int blk = F.vcu; blk < T / 128; blk += F.G) {
        if (F.tid < NEXP) hist[F.tid] = 0;
        __syncthreads();
        const int tok = blk * 128 + F.wave * 16 + l15;
        const bf16_t* xr = X1 + (size_t)tok * D_MODEL + 8 * kg; unsigned char* hr = H2 + (size_t)tok * D_MODEL + 8 * kg;
        f32x4 acc0 = {0.f, 0.f, 0.f, 0.f}, acc1 = {0.f, 0.f, 0.f, 0.f}; float ss = 0.f;
#pragma unroll 4
        for (int ks = 0; ks < 64; ++ks) {
            const u32x4 xw = *(const u32x4*)(xr + 32 * ks);
            const f32x4 xa = {__uint_as_float(xw.x << 16), __uint_as_float(xw.x & 0xffff0000u), __uint_as_float(xw.y << 16), __uint_as_float(xw.y & 0xffff0000u)}, xb = {__uint_as_float(xw.z << 16), __uint_as_float(xw.z & 0xffff0000u), __uint_as_float(xw.w << 16), __uint_as_float(xw.w & 0xffff0000u)};
            const f32x4 ga = *(const f32x4*)(p.norm2 + 32 * ks + 8 * kg), gb = *(const f32x4*)(p.norm2 + 32 * ks + 8 * kg + 4);
            const bf16x8 bh0 = *(const bf16x8*)(RWT + (size_t)l15 * D_MODEL + 32 * ks + 8 * kg), bh1 = *(const bf16x8*)(RWT + (size_t)(16 + l15) * D_MODEL + 32 * ks + 8 * kg);
            const bf16x8 bl0 = *(const bf16x8*)(RWT + (size_t)(NEXP + l15) * D_MODEL + 32 * ks + 8 * kg), bl1 = *(const bf16x8*)(RWT + (size_t)(NEXP + 16 + l15) * D_MODEL + 32 * ks + 8 * kg);
            ss += xa[0] * xa[0] + xa[1] * xa[1] + xa[2] * xa[2] + xa[3] * xa[3] + xb[0] * xb[0] + xb[1] * xb[1] + xb[2] * xb[2] + xb[3] * xb[3];
            u32x2 h8; h8.x = pk4_fp8(xa[0] * ga[0], xa[1] * ga[1], xa[2] * ga[2], xa[3] * ga[3]); h8.y = pk4_fp8(xb[0] * gb[0], xb[1] * gb[1], xb[2] * gb[2], xb[3] * gb[3]);
            *(u32x2*)(hr + 32 * ks) = h8;
            const bf16x8 ah = __builtin_bit_cast(bf16x8, xw);
            acc0 = __builtin_amdgcn_mfma_f32_16x16x32_bf16(ah, bh0, acc0, 0, 0, 0); acc1 = __builtin_amdgcn_mfma_f32_16x16x32_bf16(ah, bh1, acc1, 0, 0, 0);
            acc0 = __builtin_amdgcn_mfma_f32_16x16x32_bf16(ah, bl0, acc0, 0, 0, 0); acc1 = __builtin_amdgcn_mfma_f32_16x16x32_bf16(ah, bl1, acc1, 0, 0, 0);
        }
        ss += __shfl_xor(ss, 16); ss += __shfl_xor(ss, 32);
        const float rstd = rsqrtf(ss * (1.f / D_MODEL) + EPS);
        if (kg == 0) RSTD[tok] = rstd;
        const float rb0 = p.router_b[l15], rb1 = p.router_b[16 + l15];
        float v0[4], v1[4];
#pragma unroll
        for (int r = 0; r < 4; ++r) { const float rs = __shfl(rstd, 4 * kg + r); v0[r] = acc0[r] * rs + rb0; v1[r] = acc1[r] * rs + rb1; }
        float tv[4][4]; int ti[4][4];
#pragma unroll
        for (int k = 0; k < 4; ++k)
#pragma unroll
            for (int r = 0; r < 4; ++r) {
                float bv = v0[r]; int bi = l15; if (v1[r] > bv) { bv = v1[r]; bi = 16 + l15; }
#pragma unroll
                for (int msk = 1; msk < 16; msk <<= 1) { const float ov = __shfl_xor(bv, msk); const int oi = __shfl_xor(bi, msk); if (ov > bv || (ov == bv && oi < bi)) { bv = ov; bi = oi; } }
                tv[k][r] = bv; ti[k][r] = bi; if (bi == l15) v0[r] = -INFINITY; if (bi == 16 + l15) v1[r] = -INFINITY;
            }
        if (l15 == 0) {
#pragma unroll
            for (int r = 0; r < 4; ++r) { const int t = blk * 128 + F.wave * 16 + 4 * kg + r;
                const float e1 = __expf(tv[1][r] - tv[0][r]), e2 = __expf(tv[2][r] - tv[0][r]), e3 = __expf(tv[3][r] - tv[0][r]), inv = 1.f / (1.f + e1 + e2 + e3);
                *(int4*)(TOPI + (size_t)t * 4) = make_int4(ti[0][r], ti[1][r], ti[2][r], ti[3][r]); *(float4*)(GATE + (size_t)t * 4) = make_float4(inv, e1 * inv, e2 * inv, e3 * inv);
                atomicAdd((int*)&hist[ti[0][r]], 1); atomicAdd((int*)&hist[ti[1][r]], 1); atomicAdd((int*)&hist[ti[2][r]], 1); atomicAdd((int*)&hist[ti[3][r]], 1); }
        }
        __syncthreads();
        if (F.tid < NEXP) CNT[blk * NEXP + F.tid] = hist[F.tid];
        __syncthreads();
    }
}
__device__ __forceinline__ void p8_scatter(const Frame& F0, const P& p) { const Frame F = phase_frame(F0);
    LAS int* base = (LAS int*)(F.lds + 0); LAS int* tot = base + 32; LAS int* segs = base + 64; LAS int* spos = base + 128;
    const int tid = F.tid, lane = F.lane;
    const int* CNT = (const int*)(p.ws + OFF_CNT); const int* TOPI = (const int*)(p.ws + OFF_TOPI); const float* GATE = (const float*)(p.ws + OFF_GATE);
    int* POS = (int*)(p.ws + OFF_POS); float* ROWW = (float*)(p.ws + OFF_ROWW); int* TILEE = (int*)(p.ws + OFF_TILEE);
    int* ROWTOK = (int*)(p.ws + OFF_ROWTOK); float* ROWRS = (float*)(p.ws + OFF_ROWRS); const float* RSTD = (const float*)(p.ws + OFF_RSTD);
    for (int wg = F.vcu; wg < RT_WGS; wg += F.G) {
        { LAS int* redb = base + 1024; LAS int* redt = redb + 512;
          const int e = tid & 31, part = tid >> 5; int before = 0, total = 0;
#pragma unroll
          for (int j = 0; j < 16; ++j) { const int w = part * 16 + j; const int c = CNT[w * NEXP + e]; total += c; before += (w < wg) ? c : 0; }
          redb[tid] = before; redt[tid] = total;
          __syncthreads();
          if (tid < NEXP) { int b2 = 0, t2 = 0;
#pragma unroll
              for (int q = 0; q < 16; ++q) { b2 += redb[q * 32 + tid]; t2 += redt[q * 32 + tid]; }
              base[tid] = b2; tot[tid] = t2; } }
        __syncthreads();
        if (tid == 0) { int s = 0; for (int e = 0; e < NEXP; ++e) { segs[e] = s; s += (tot[e] + 255) & ~255; } segs[NEXP] = s; }
        __syncthreads();
        if (wg == 0) {
            for (int e = 0; e < NEXP; ++e) { const int t0 = segs[e] >> 8, t1 = segs[e + 1] >> 8; for (int tt = t0 + tid; tt < t1; tt += NWAVES * 64) TILEE[tt] = e; }
            if (tid == 0) TILEE[NTILES_MAX] = segs[NEXP] >> 8;
        }
        { LAS int* cw = base + 2048;
          const int f = F.wave * 64 + lane, e = TOPI[(size_t)wg * RT_TOK * 4 + f]; int mycnt = 0, within = 0;
          for (int ex = 0; ex < NEXP; ++ex) { const unsigned long long m = __ballot(e == ex); if (lane == ex) mycnt = __popcll(m); if (e == ex) within = __popcll(m & ((1ull << lane) - 1ull)); }
          if (lane < NEXP) cw[F.wave * NEXP + lane] = mycnt;
          __syncthreads();
          int prev = 0;
          for (int w2 = 0; w2 < F.wave; ++w2) prev += cw[w2 * NEXP + e];
          const int pos = segs[e] + base[e] + prev + within;
          POS[(size_t)wg * RT_TOK * 4 + f] = pos; ROWW[pos] = GATE[(size_t)wg * RT_TOK * 4 + f]; ROWTOK[pos] = wg * RT_TOK + (f >> 2); ROWRS[pos] = RSTD[wg * RT_TOK + (f >> 2)]; }
        __syncthreads();
        if (wg < NEXP) { const int r0 = segs[wg] + tot[wg], r1 = segs[wg + 1]; for (int r = r0 + tid; r < r1; r += NWAVES * 64) { ROWTOK[r] = 0; ROWW[r] = 0.f; ROWRS[r] = 0.f; } }
        __syncthreads();
    }
}
__device__ __forceinline__ void p11_combine(const Frame& F0, const P& p) { const Frame F = phase_frame(F0);
    const bf16_t* X1 = (const bf16_t*)(p.ws + OFF_X1B); const unsigned char* YR = p.ws + OFF_YR; const int* POS = (const int*)(p.ws + OFF_POS);
    const int gw = F.vcu * NWAVES + F.wave, NGW = F.G * NWAVES, lane = F.lane;
    for (int t = gw; t < T; t += NGW) {
        const int4 pos = *(const int4*)(POS + (size_t)t * 4); const int pp[4] = {pos.x, pos.y, pos.z, pos.w};
#pragma unroll
        for (int i = 0; i < 2; ++i) {
            const int c = 16 * (lane + 64 * i);
            const u32x4 xa = *(const u32x4*)(X1 + (size_t)t * D_MODEL + c), xb = *(const u32x4*)(X1 + (size_t)t * D_MODEL + c + 8);
            float s16[16];
#pragma unroll
            for (int j = 0; j < 16; ++j) s16[j] = 0.f;
#pragma unroll
            for (int k = 0; k < 4; ++k) { const u32x4 y = *(const u32x4*)(YR + (size_t)pp[k] * D_MODEL + c); const unsigned yw[4] = {y.x, y.y, y.z, y.w};
#pragma unroll
                for (int d = 0; d < 4; ++d) { const auto lo = __builtin_amdgcn_cvt_pk_f32_fp8((int)yw[d], false), hi = __builtin_amdgcn_cvt_pk_f32_fp8((int)yw[d], true);
                    s16[4 * d + 0] += lo[0]; s16[4 * d + 1] += lo[1]; s16[4 * d + 2] += hi[0]; s16[4 * d + 3] += hi[1]; } }
            const unsigned xw[8] = {xa.x, xa.y, xa.z, xa.w, xb.x, xb.y, xb.z, xb.w};
            constexpr float inv = 1.f / YR_SCALE;
#pragma unroll
            for (int q = 0; q < 4; ++q) { f32x4 o;
                o[0] = __uint_as_float(xw[2 * q] << 16) + s16[4 * q + 0] * inv; o[1] = __uint_as_float(xw[2 * q] & 0xffff0000u) + s16[4 * q + 1] * inv;
                o[2] = __uint_as_float(xw[2 * q + 1] << 16) + s16[4 * q + 2] * inv; o[3] = __uint_as_float(xw[2 * q + 1] & 0xffff0000u) + s16[4 * q + 3] * inv;
                *(f32x4*)(p.out + (size_t)t * D_MODEL + c + 4 * q) = o; }
        }
    }
}

__device__ __forceinline__ void p5_quant(const Frame& F0, const P& p) { const Frame F = phase_frame(F0);
    const int gw = F.vcu * NWAVES + F.wave, NGW = F.G * NWAVES, lane = F.lane;
    for (int e = gw; e < 2 * T; e += NGW) { const int br = e & 1, t = e >> 1;
        const bf16_t* src = (const bf16_t*)(p.ws + (br ? OFF_BOUT : OFF_AOUT)) + (size_t)t * WIDTH + 16 * lane;
        const u32x4 a = *(const u32x4*)src, b = *(const u32x4*)(src + 8); const unsigned w[8] = {a.x, a.y, a.z, a.w, b.x, b.y, b.z, b.w};
        float v[16]; float m = 0.f;
#pragma unroll
        for (int j = 0; j < 8; ++j) { v[2 * j] = __uint_as_float(w[j] << 16); v[2 * j + 1] = __uint_as_float(w[j] & 0xffff0000u); m = fmaxf(m, fmaxf(__builtin_fabsf(v[2 * j]), __builtin_fabsf(v[2 * j + 1]))); }
        const float mx = fmaxf(wave_max(m), 1e-30f), inv = 127.f / mx;
        u32x4 o; o.x = pk4_i8(v[0] * inv, v[1] * inv, v[2] * inv, v[3] * inv); o.y = pk4_i8(v[4] * inv, v[5] * inv, v[6] * inv, v[7] * inv); o.z = pk4_i8(v[8] * inv, v[9] * inv, v[10] * inv, v[11] * inv); o.w = pk4_i8(v[12] * inv, v[13] * inv, v[14] * inv, v[15] * inv);
        *(u32x4*)(p.ws + OFF_H8 + (size_t)br * 32 * MiB + (size_t)t * WIDTH + 16 * lane) = o;
        if (lane == 0) ((float*)(p.ws + (br ? OFF_HSC2 : OFF_HSC)))[t] = mx * (1.f / 127.f);
    }
}
__device__ __forceinline__ void p6_quant(const Frame& F0, const P& p) { const Frame F = phase_frame(F0);
    const bf16_t* MRG = (const bf16_t*)(p.ws + OFF_MRG); unsigned char* Q = p.ws + OFF_H8; float* HSC = (float*)(p.ws + OFF_HSC);
    const int gw = F.vcu * NWAVES + F.wave, NGW = F.G * NWAVES, lane = F.lane;
    for (int t = gw; t < T; t += NGW) {
        const bf16_t* src = MRG + (size_t)t * D_MODEL + 32 * lane; u32x4 in[4]; float m = 0.f;
#pragma unroll
        for (int i = 0; i < 4; ++i) { in[i] = *(const u32x4*)(src + 8 * i); const unsigned w[4] = {in[i].x, in[i].y, in[i].z, in[i].w};
#pragma unroll
            for (int j = 0; j < 4; ++j) m = fmaxf(m, fmaxf(__builtin_fabsf(__uint_as_float(w[j] << 16)), __builtin_fabsf(__uint_as_float(w[j] & 0xffff0000u)))); }
        const float mx = fmaxf(wave_max(m), 1e-30f), inv = 127.f / mx;
        u32x4 o[2];
#pragma unroll
        for (int i = 0; i < 4; ++i) { const unsigned w[4] = {in[i].x, in[i].y, in[i].z, in[i].w};
            const unsigned a = pk4_i8(__uint_as_float(w[0] << 16) * inv, __uint_as_float(w[0] & 0xffff0000u) * inv, __uint_as_float(w[1] << 16) * inv, __uint_as_float(w[1] & 0xffff0000u) * inv);
            const unsigned b = pk4_i8(__uint_as_float(w[2] << 16) * inv, __uint_as_float(w[2] & 0xffff0000u) * inv, __uint_as_float(w[3] << 16) * inv, __uint_as_float(w[3] & 0xffff0000u) * inv);
            if (i & 1) { o[i >> 1].z = a; o[i >> 1].w = b; } else { o[i >> 1].x = a; o[i >> 1].y = b; } }
        *(u32x4*)(Q + (size_t)t * D_MODEL + 32 * lane) = o[0]; *(u32x4*)(Q + (size_t)t * D_MODEL + 32 * lane + 16) = o[1];
        if (lane == 0) HSC[t] = mx * (1.f / 127.f);
    }
}
struct Args { P p; int ph_lo, ph_hi, li, pad; };
__global__ void __launch_bounds__(NWAVES * 64, 2) mk_fwd(Args args) {
    extern __shared__ __attribute__((aligned(16))) unsigned char lds_raw[];
    Frame F; F.lds = (LAS unsigned char*)lds_raw; F.MISC = (volatile LAS unsigned*)(F.lds + MISC_OFF);
    F.tid = threadIdx.x; F.lane = F.tid & 63; F.wave = __builtin_amdgcn_readfirstlane(F.tid >> 6);
    F.G = gridDim.x; { const int bx = blockIdx.x; F.vcu = (F.G % 8 == 0) ? (bx % 8) * (F.G / 8) + bx / 8 : bx; }
    const P& p = args.p;
    for (int u = F.tid; u < (LDS_BYTES - MISC_OFF) / 4; u += NWAVES * 64) ((LAS unsigned*)(F.lds + MISC_OFF))[u] = 0u;
    __syncthreads();
    XcdBarrier bar = xcd_barrier_post((unsigned*)(p.ws + WS_CTL) + CW_BAR + args.li * XCD_BAR_WORDS, F.MISC + 8);
    const int lo = args.ph_lo, hi = args.ph_hi;
#ifndef DUP_MASK
#define DUP_MASK 0
#endif
#define DUP(k) ((DUP_MASK >> (k)) & 1)
#define IN(k) (lo <= (k) && (k) < hi)
#define BOTH(k) (IN(k) && IN((k) + 1))
    if (IN(0)) { for (int rep = 0; rep <= DUP(0); ++rep) { p0_quant_weights(F, p); p0_router_prep(F, p); __syncthreads(); p0_rmsnorm(F, p); __syncthreads(); } if (BOTH(0)) xcd_barrier(bar); }
    if (IN(1)) {
        p1_fix_c(F, p);
        { SchedIn<1> S{T / 256, NF8T, F.G, (int)blockIdx.x, (const char*)(p.ws + OFF_H8), (const char*)(p.ws + OFF_WIN8_T), (size_t)256 * D_MODEL, (const float*)(p.ws + OFF_HSC), (const unsigned*)(p.ws + WS_CTL) + CW_CMAX};
          EpiIn1 E{p.ws, p.lb_logits, (LAS float*)(F.lds + MISC_OFF + 4096), p.fq_norm, p.fk_norm};
          pg8::gemm_phase<EpiIn1, SchedIn<1>, true, false, true>(F.lds, D_MODEL / 2, S, E); }
        if (BOTH(1)) xcd_barrier(bar);
    }
    if (IN(2)) { p2_jlo(F, p); p2_hgrn_local(F, p);     if (BOTH(2)) xcd_barrier(bar); }
    if (IN(3)) { for (int rep = 0; rep <= DUP(3); ++rep) p3_hgrn_scan(F, p); if (BOTH(3)) xcd_barrier(bar); }
    if (IN(4)) { if (((blockIdx.x >> 3) & 3) == 3) convert_queue(F, p); p4_hgrn_out(F, p); __syncthreads(); p4_attention(F, p, 0); __syncthreads(); convert_queue(F, p); if (BOTH(4)) xcd_barrier(bar); }
    if (IN(5)) {
        p5_quant(F, p);
        xcd_barrier(bar);
        int kmerge = WIDTH / 2; asm volatile("" : "+s"(kmerge));
        { SchedI8 S{T / 256, D_MODEL / 256, F.G, (int)blockIdx.x, (const char*)(p.ws + OFF_H8), (const char*)(p.ws + OFF_WUPA_T), (size_t)256 * WIDTH, (const float*)(p.ws + OFF_HSC), (const unsigned*)(p.ws + WS_CTL) + CW_CMAXA};
          EpiMergeT<0> E{p.ws}; pg8::gemm_phase<EpiMergeT<0>, SchedI8, true, false, true>(F.lds, kmerge, S, E); }
        { SchedI8 S{T / 256, D_MODEL / 256, F.G, (int)blockIdx.x, (const char*)(p.ws + OFF_H8 + 32 * MiB), (const char*)(p.ws + OFF_WUPB_T), (size_t)256 * WIDTH, (const float*)(p.ws + OFF_HSC2), (const unsigned*)(p.ws + WS_CTL) + CW_CMAXB};
          EpiMergeT<1> E{p.ws}; pg8::gemm_phase<EpiMergeT<1>, SchedI8, true, false, true>(F.lds, kmerge, S, E); }
        if (BOTH(5)) xcd_barrier(bar);
    }
    if (IN(6)) {
        p6_quant(F, p);
        xcd_barrier(bar);
        SchedI8 S{T / 256, D_MODEL / 256, F.G, (int)blockIdx.x, (const char*)(p.ws + OFF_H8), (const char*)(p.ws + OFF_WOUT8_T), (size_t)256 * D_MODEL, (const float*)(p.ws + OFF_HSC), (const unsigned*)(p.ws + WS_CTL) + CW_CMAX2};
        EpiWout1 E{p.x, (bf16_t*)(p.ws + OFF_X1B)};
        for (int rep = 0; rep <= DUP(6); ++rep) pg8::gemm_phase<EpiWout1, SchedI8, true, false, true>(F.lds, D_MODEL / 2, S, E);
        if (BOTH(6)) xcd_barrier(bar);
    }
    if (IN(7)) { for (int rep = 0; rep <= DUP(7); ++rep) p7_router(F, p); if (BOTH(7)) xcd_barrier(bar); }
    if (IN(8)) { for (int rep = 0; rep <= DUP(8); ++rep) p8_scatter(F, p); if (BOTH(8)) xcd_barrier(bar); }
    if (IN(9)) {
        const int nT = load_tile_table(F, p);
        pg8::SchedMoe S{nT, 4096 / 256, F.G, (int)blockIdx.x, (const char*)(p.ws + OFF_H2), (const char*)(p.ws + OFF_WGU_T), (size_t)256 * D_MODEL, (size_t)4096 * D_MODEL, (const LAS int*)(F.lds + TILEE_LDS_OFF), true};
        EpiGU1 E{p.b_gu, p.ws + OFF_ACT, (const float*)(p.ws + OFF_ROWRS)};
        for (int rep = 0; rep <= DUP(9); ++rep) pg8::gemm_phase<EpiGU1, pg8::SchedMoe, true, true>(F.lds, D_MODEL / 2, S, E, (const int*)(p.ws + OFF_ROWTOK));
        if (BOTH(9)) xcd_barrier(bar);
    }
    if (IN(10)) {
        const int nT = load_tile_table(F, p);
        pg8::SchedMoe S{nT, D_MODEL / 256, F.G, (int)blockIdx.x, (const char*)(p.ws + OFF_ACT), (const char*)(p.ws + OFF_WDN_T), (size_t)256 * D_MODEL, (size_t)D_MODEL * D_MODEL, (const LAS int*)(F.lds + TILEE_LDS_OFF), false};
        EpiDown1 E{p.b_down, (const float*)(p.ws + OFF_ROWW), p.ws + OFF_YR};
        for (int rep = 0; rep <= DUP(10); ++rep) pg8::gemm_phase<EpiDown1, pg8::SchedMoe, true>(F.lds, D_MODEL / 2, S, E);
        if (BOTH(10)) xcd_barrier(bar);
    }
    if (IN(11)) { for (int rep = 0; rep <= DUP(11); ++rep) p11_combine(F, p); }
#undef IN
#undef BOTH
}
extern "C" void kernel_launch(void* const* d_in, const int* in_sizes, int n_in, void* d_out, int out_size, void* d_ws, size_t ws_size, hipStream_t stream) {
    static int grid = 0;
    if (grid == 0) {
        if (n_in != 18 || out_size != T * D_MODEL || ws_size < WS_END3) { fprintf(stderr, "kernel_launch: unexpected shapes (n_in %d out %d ws %zu need %zu)\n", n_in, out_size, ws_size, (size_t)WS_END3); grid = -1; return; }
        int dev = 0, cus = 0, per_cu = 0;
        if (hipGetDevice(&dev) != hipSuccess || hipDeviceGetAttribute(&cus, hipDeviceAttributeMultiprocessorCount, dev) != hipSuccess) { grid = -1; return; }
        if (hipFuncSetAttribute((const void*)mk_fwd, hipFuncAttributeMaxDynamicSharedMemorySize, LDS_BYTES) != hipSuccess) { fprintf(stderr, "kernel_launch: hipFuncSetAttribute failed\n"); grid = -1; return; }
        if (hipOccupancyMaxActiveBlocksPerMultiprocessor(&per_cu, (const void*)mk_fwd, NWAVES * 64, LDS_BYTES) != hipSuccess || per_cu < 1) fprintf(stderr, "kernel_launch: occupancy query says %d\n", per_cu);
        (void)hipGetLastError();
        grid = cus;
    }
    if (grid < 0) return;
    P p{};
    p.x = (const float*)d_in[0]; p.lb_logits = (const float*)d_in[1]; p.norm1 = (const float*)d_in[2]; p.w_in = (const float*)d_in[3]; p.hg_norm = (const float*)d_in[4];
    p.fq_norm = (const float*)d_in[5]; p.fk_norm = (const float*)d_in[6]; p.f_bias = (const float*)d_in[7]; p.w_up_hg = (const float*)d_in[8]; p.w_up_fox = (const float*)d_in[9];
    p.w_out = (const float*)d_in[10]; p.norm2 = (const float*)d_in[11]; p.router_w = (const float*)d_in[12]; p.router_b = (const float*)d_in[13]; p.w_gu = (const float*)d_in[14];
    p.b_gu = (const float*)d_in[15]; p.w_down = (const float*)d_in[16]; p.b_down = (const float*)d_in[17]; p.out = (float*)d_out; p.ws = (unsigned char*)d_ws;
    unsigned char* ws = p.ws;
    (void)hipMemsetAsync(ws + WS_CTL, 0, CTL_ZERO_BYTES, stream);
    Args a{}; a.p = p; a.ph_lo = 0; a.ph_hi = 12; a.li = 0; a.pad = 0;
    hipLaunchKernelGGL(mk_fwd, dim3(grid), dim3(NWAVES * 64), LDS_BYTES, stream, a);
}
```

```cpp
#define DUP_MASK 0
#include <hip/hip_runtime.h>
#include <cstdio>
#include <cstdint>

constexpr int D_MODEL = 2048, BATCH = 4, SEQ = 8192, T = BATCH * SEQ;
constexpr int HEADS = 8, HD = 128, WIDTH = 1024;
constexpr int IN_COLS = 11272, NEXP = 32, TOPK = 4, TK = T * TOPK;
constexpr int NROWS_MAX = TK + NEXP * 256;
constexpr int NTILES_MAX = NROWS_MAX / 256;
constexpr float EPS = 1e-6f;
constexpr int RT_TOK = 128, RT_WGS = T / RT_TOK;

typedef unsigned short bf16_t;
__device__ __forceinline__ float bf2f(bf16_t b) { return __uint_as_float(((unsigned)b) << 16); }
__device__ __forceinline__ bf16_t f2bf(float f) { unsigned u = __float_as_uint(f); u += 0x7fffu + ((u >> 16) & 1u); return (bf16_t)(u >> 16); }
__device__ __forceinline__ float wave_sum(float v) {
#pragma unroll
    for (int o = 1; o < 64; o <<= 1) v += __shfl_xor(v, o);
    return v;
}
__device__ __forceinline__ float wave_max(float v) {
#pragma unroll
    for (int o = 1; o < 64; o <<= 1) v = fmaxf(v, __shfl_xor(v, o));
    return v;
}
__device__ __forceinline__ float sigmoidf_(float x) { return 1.f / (1.f + __expf(-x)); }
__device__ __forceinline__ float siluf_(float x) { return x * sigmoidf_(x); }
__device__ __forceinline__ float log_sigmoidf_(float z) { return fminf(z, 0.f) - log1pf(__expf(-fabsf(z))); }

constexpr size_t MiB = 1u << 20;
constexpr size_t WS_CTL = 0;
constexpr size_t WS_SMALL = 1 * MiB;
constexpr size_t OFF_C = WS_SMALL;
constexpr size_t OFF_FL = OFF_C + 1 * MiB;
constexpr size_t OFF_TOPI = OFF_FL + 1 * MiB;
constexpr size_t OFF_GATE = OFF_TOPI + MiB / 2;
constexpr size_t OFF_POS = OFF_GATE + MiB / 2;
constexpr size_t OFF_ROWW = OFF_POS + MiB / 2;
constexpr size_t OFF_CNT = OFF_ROWW + 1 * MiB;
constexpr size_t OFF_TILEE = OFF_CNT + 64 * 1024;
constexpr size_t WS_BIG = 8 * MiB;
constexpr size_t OFF_X1 = WS_BIG;
constexpr size_t OFF_H2 = OFF_X1 + 256 * MiB;
constexpr size_t OFF_YR = OFF_H2 + 128 * MiB;
constexpr size_t OFF_A = OFF_YR + 544 * MiB;
constexpr size_t OFF_H = OFF_A;
constexpr size_t OFF_HQ = OFF_H + 128 * MiB;
constexpr size_t OFF_LOGF = OFF_HQ + 64 * MiB;
constexpr size_t OFF_HV = OFF_LOGF + 64 * MiB;
constexpr size_t OFF_HG = OFF_HV + 64 * MiB;
constexpr size_t OFF_FQ = OFF_HG + 64 * MiB;
constexpr size_t OFF_FK = OFF_FQ + 64 * MiB;
constexpr size_t OFF_FV = OFF_FK + 64 * MiB;
constexpr size_t OFF_GA = OFF_FV + 64 * MiB;
constexpr size_t OFF_GB = OFF_GA + 128 * MiB;
constexpr size_t OFF_AOUT = OFF_GB + 128 * MiB;
constexpr size_t OFF_BOUT = OFF_AOUT + 64 * MiB;
constexpr size_t OFF_MRG = OFF_BOUT + 64 * MiB;
constexpr size_t OFF_A_END = OFF_MRG + 128 * MiB;
constexpr size_t OFF_XS = OFF_A;
constexpr size_t OFF_ACT = OFF_XS + 544 * MiB;
constexpr size_t WS_END = (OFF_A_END > OFF_ACT + 544 * MiB) ? OFF_A_END : OFF_ACT + 544 * MiB;

struct P {
    const float *x, *lb_logits, *norm1, *w_in, *hg_norm, *fq_norm, *fk_norm, *f_bias, *w_up_hg, *w_up_fox, *w_out, *norm2, *router_w, *router_b, *w_gu, *b_gu, *w_down, *b_down;
    float* out; unsigned char* ws;
};

#define LAS __attribute__((address_space(3)))
#define GAS __attribute__((address_space(1)))
typedef short bf16x8 __attribute__((ext_vector_type(8)));
typedef float f32x4 __attribute__((ext_vector_type(4)));
typedef float f32x2 __attribute__((ext_vector_type(2)));
typedef unsigned u32x4 __attribute__((ext_vector_type(4)));
typedef unsigned u32x2 __attribute__((ext_vector_type(2)));
#define LDS_WAIT() asm volatile("s_waitcnt lgkmcnt(0)" ::: "memory")
#define VM_WAIT() asm volatile("s_waitcnt vmcnt(0)" ::: "memory")
__device__ __forceinline__ unsigned cvt_pk_bf16(float lo, float hi) { unsigned r; asm volatile("v_cvt_pk_bf16_f32 %0, %1, %2" : "=v"(r) : "v"(lo), "v"(hi)); return r; }
__device__ __forceinline__ float fast_sigmoid(float x) { return __builtin_amdgcn_rcpf(1.f + __builtin_amdgcn_exp2f(-1.4426950408889634f * x)); }

constexpr size_t OFF_WIN_T = OFF_A_END;
constexpr size_t OFF_WUPA_T = OFF_WIN_T + 44 * MiB;
constexpr size_t OFF_WUPB_T = OFF_WUPA_T + 4 * MiB;
constexpr size_t OFF_WOUT_T = OFF_WUPB_T + 4 * MiB;
constexpr size_t OFF_WGU_T = OFF_WOUT_T + 8 * MiB;
constexpr size_t OFF_WDN_T = OFF_WGU_T + 512 * MiB;
constexpr size_t WS_END2 = OFF_WDN_T + 256 * MiB;
constexpr size_t OFF_SLOC = WS_END2;
constexpr size_t OFF_STATE = OFF_SLOC + 128 * MiB;
constexpr size_t OFF_DEC = OFF_STATE + 128 * MiB;
constexpr size_t OFF_H8 = OFF_DEC + 2 * MiB;
constexpr size_t OFF_WIN8_T = OFF_H8 + 64 * MiB;
constexpr size_t OFF_WOUT8_T = OFF_WIN8_T + 24 * MiB;
constexpr size_t WS_END3 = OFF_WIN8_T + 28 * MiB;
constexpr size_t OFF_BT = OFF_TILEE + 4096;
constexpr size_t OFF_JLO = OFF_BT + 8192 + 4096;
constexpr size_t OFF_RWT = 7 * MiB + 128 * 1024;
constexpr size_t OFF_HSC2 = 7 * MiB + 768 * 1024;
constexpr size_t OFF_HSC = 7 * MiB + 640 * 1024;
constexpr int CW_CMAXA = 51200, CW_CMAXB = 53248;
constexpr int CW_CMAX2 = 49152, CW_RMAX = 65536;
constexpr int CW_CMAX = 32768;
constexpr size_t OFF_RSTD = 7 * MiB + 512 * 1024;
constexpr size_t OFF_ROWRS = 6 * MiB + 576 * 1024;
constexpr size_t OFF_ROWTOK = 6 * MiB;
static_assert(OFF_ROWTOK + (size_t)NROWS_MAX * 4 <= OFF_ROWRS && OFF_ROWRS + (size_t)NROWS_MAX * 4 <= OFF_RWT && OFF_RWT + 2 * NEXP * D_MODEL * 2 <= OFF_RSTD && OFF_RSTD + (size_t)T * 4 <= WS_BIG && OFF_JLO + 4096 <= OFF_ROWTOK, "small-table map");
constexpr size_t OFF_X1B = OFF_H;
constexpr int CW_BAR = 4096;
constexpr size_t CTL_ZERO_BYTES = 512 * 1024;

#define XB_TMO      128
#define XB_XCNT(j)  (256  + 64 * (j))
#define XB_XSUB(j)  (1280 + 64 * (j))
#define XB_XGEN(j)  (2304 + 64 * (j))
#define XB_TOP      3328
#define XB_TOPGEN   3392
#define XCD_BAR_WORDS 3456
#define XB_SPIN_CAP (1u << 18)
__device__ __forceinline__ unsigned xb_ld(unsigned* p)              { return __hip_atomic_load(p, __ATOMIC_RELAXED, __HIP_MEMORY_SCOPE_AGENT); }
__device__ __forceinline__ unsigned xb_add(unsigned* p, unsigned v) { return __hip_atomic_fetch_add(p, v, __ATOMIC_RELAXED, __HIP_MEMORY_SCOPE_AGENT); }
__device__ __forceinline__ unsigned xb_xcc_id() { return (unsigned)__builtin_amdgcn_s_getreg((3 << 11) | 20) & 0xFu; }
#define XB_SPIN(cond, bar) do { unsigned _sp = 0; while (cond) { __builtin_amdgcn_s_sleep(1); \
    if ((++_sp & 255u) == 0u) { if (xb_ld(&(bar)[XB_TMO])) break; if (_sp > XB_SPIN_CAP) { atomicAdd(&(bar)[XB_TMO], 1u); break; } } } } while (0)
struct XcdBarrier { unsigned* bar; unsigned x; volatile LAS unsigned* st; };
__device__ __forceinline__ XcdBarrier xcd_barrier_post(unsigned* bar, volatile LAS unsigned* st) {
    XcdBarrier b; b.bar = bar; b.x = xb_xcc_id(); b.st = st;
    if (threadIdx.x == 0) (void)xb_add(&bar[XB_XCNT(b.x)], 1u);
    return b;
}
__device__ __forceinline__ void xcd_barrier_complete(unsigned* bar, unsigned x, unsigned& nloc, unsigned& nx) {
    const unsigned G = gridDim.x * gridDim.y * gridDim.z;
    unsigned sum, cnt, mine, sp = 0u;
    for (;;) {
        sum = 0u; cnt = 0u; mine = 0u;
#pragma unroll
        for (unsigned j = 0; j < 16; ++j) { const unsigned c = xb_ld(&bar[XB_XCNT(j)]); sum += c; cnt += (c > 0u) ? 1u : 0u; mine = (j == x) ? c : mine; }
        if (sum == G) break;
        __builtin_amdgcn_s_sleep(1);
        if ((++sp & 255u) == 0u) { if (xb_ld(&bar[XB_TMO])) break; if (sp > XB_SPIN_CAP) { atomicAdd(&bar[XB_TMO], 1u); break; } }
    }
    nloc = mine > 0u ? mine : 1u; nx = cnt > 0u ? cnt : 1u;
}
__device__ __forceinline__ void xcd_barrier(const XcdBarrier& b) {
    asm volatile("s_waitcnt vmcnt(0)" ::: "memory");
    __syncthreads();
    if (threadIdx.x == 0) {
        unsigned* bar = b.bar;
        __builtin_amdgcn_s_waitcnt(0);
        unsigned nloc = b.st[0], nx = b.st[1];
        if (nloc == 0u) { xcd_barrier_complete(bar, b.x, nloc, nx); b.st[0] = nloc; b.st[1] = nx; }
        const unsigned old = xb_add(&bar[XB_XSUB(b.x)], 1u);
        const unsigned gen = old / nloc;
        if (old + 1u == (gen + 1u) * nloc) {
            __builtin_amdgcn_fence(__ATOMIC_RELEASE, "agent");
            asm volatile("s_waitcnt vmcnt(0)" ::: "memory");
            const unsigned og = xb_add(&bar[XB_TOP], 1u);
            const unsigned tg = og / nx;
            if (og + 1u == (tg + 1u) * nx) xb_add(&bar[XB_TOPGEN], 1u);
            else XB_SPIN(xb_ld(&bar[XB_TOPGEN]) == tg, bar);
            __builtin_amdgcn_fence(__ATOMIC_ACQUIRE, "agent");
            xb_add(&bar[XB_XGEN(b.x)], 1u);
            asm volatile("s_waitcnt vmcnt(0)" ::: "memory");
        } else {
            XB_SPIN(xb_ld(&bar[XB_XGEN(b.x)]) == gen, bar);
            __builtin_amdgcn_fence(__ATOMIC_ACQUIRE, "agent");
            asm volatile("s_waitcnt vmcnt(0)" ::: "memory");
        }
    }
    __syncthreads();
}

namespace pg8 {
constexpr int BM = 256, BK = 64, HALF = 128, HTB = HALF * BK * 2, STAGE_BYTES = 8 * HTB, NXCD = 8, WGM = 8;
__host__ __device__ __forceinline__ int lds_byte(int r, int c) { const int st = (r >> 4) * 2 + (c >> 5), rr = r & 15, cc = c & 31, ob = rr * 64 + cc * 2; return st * 1024 + (ob ^ (((ob >> 9) & 1) << 5)); }
__host__ __device__ __forceinline__ void stage_rc(int b, int& R, int& C) { const int st = b / 1024, sb = b % 1024, swz = sb ^ (((sb >> 9) & 1) << 5); R = (st >> 1) * 16 + swz / 64; C = (st & 1) * 32 + (swz % 64) / 2; }
__host__ __device__ __forceinline__ int perm32(int rho) { const int n = rho >> 4, i = rho & 15; return 8 * (i >> 2) + 4 * n + (i & 3); }
struct Unit { int pm, pn, e, h; };
__device__ __forceinline__ void tile_map(int wgid, int nM, int nN, int& pm, int& pn) {
    const int nwg = nM * nN; { const int q = nwg / NXCD, r = nwg % NXCD, xcd = wgid % NXCD, off = wgid / NXCD; wgid = (xcd < r ? xcd * (q + 1) : r * (q + 1) + (xcd - r) * q) + off; }
    const int nig = WGM * nN, gid = wgid / nig, fm = gid * WGM, gsz = (nM - fm) < WGM ? (nM - fm) : WGM;
    pm = fm + ((wgid % nig) % gsz); pn = (wgid % nig) / gsz;
}
typedef int i32x8 __attribute__((ext_vector_type(8)));
typedef int i32x4 __attribute__((ext_vector_type(4)));
template <class Epi, class Sched, bool FP8 = false, bool GATHER = false, bool I8 = false>
__device__ __forceinline__ void gemm_phase(LAS unsigned char* lds, const int K, const Sched& S, const Epi& E, const int* rowtok = nullptr) {
    int tid = threadIdx.x; asm volatile("" : "+v"(tid));
    const int wid = __builtin_amdgcn_readfirstlane(tid >> 6), lane = tid & 63, wr = wid >> 2, wc = wid & 3, fr = lane & 15, fq = lane >> 4;
    const int nt = K / BK;
    unsigned voffA[2], voffB[2];
#pragma unroll
    for (int i = 0; i < 2; ++i) { int R, C; stage_rc(tid * 16 + i * 8192, R, C); const int Rb = Epi::PERM ? ((R & ~31) + perm32(R & 31)) : R;
        voffA[i] = (unsigned)(R * K + C) * 2u; voffB[i] = (unsigned)(Rb * K + C) * 2u; }
    const size_t kstep = (size_t)(BK * 2);
    const size_t hstep = (size_t)HALF * K * 2;
    const unsigned ldsw = (unsigned)wid * 1024u;
    const int aoff = lds_byte(wr * 64 + fr, fq * 8), boff = lds_byte(wc * 32 + fr, fq * 8);
#define PG8_SA(b, h) (((b) * 2 + (h)) * HTB)
#define PG8_SB(b, h) ((4 + (b) * 2 + (h)) * HTB)
#define PG8_STAGE(bufoff, gbase, voff) do { _Pragma("unroll") for (int _i = 0; _i < 2; ++_i) \
        __builtin_amdgcn_global_load_lds((const unsigned*)((const char*)(gbase) + (voff)[_i]), (LAS unsigned*)(lds + (bufoff) + ldsw + _i * 8192), 16, 0, 0); } while (0)
#define PG8_LDA(dst, b, h) do { _Pragma("unroll") for (int m = 0; m < 4; ++m) { const i32x4 _x = *(const LAS i32x4*)(lds + PG8_SA(b, h) + aoff + m * 2048), _y = *(const LAS i32x4*)(lds + PG8_SA(b, h) + aoff + m * 2048 + 1024); \
        dst[m] = __builtin_shufflevector(_x, _y, 0, 1, 2, 3, 4, 5, 6, 7); } } while (0)
#define PG8_LDB(dst, b, h) do { _Pragma("unroll") for (int n = 0; n < 2; ++n) { const i32x4 _x = *(const LAS i32x4*)(lds + PG8_SB(b, h) + boff + n * 2048), _y = *(const LAS i32x4*)(lds + PG8_SB(b, h) + boff + n * 2048 + 1024); \
        dst[n] = __builtin_shufflevector(_x, _y, 0, 1, 2, 3, 4, 5, 6, 7); } } while (0)
#define PG8_LO(v) __builtin_bit_cast(bf16x8, __builtin_shufflevector(v, v, 0, 1, 2, 3))
#define PG8_HI(v) __builtin_bit_cast(bf16x8, __builtin_shufflevector(v, v, 4, 5, 6, 7))
#define PG8_MMA(ai, bj, At, Bt) do { __builtin_amdgcn_s_setprio(1); if constexpr (I8) { _Pragma("unroll") for (int m = 0; m < 4; ++m) _Pragma("unroll") for (int n = 0; n < 2; ++n) { \
        i32x4 _c = __builtin_bit_cast(i32x4, acc[ai][bj][m][n]); \
        _c = __builtin_amdgcn_mfma_i32_16x16x64_i8(__builtin_shufflevector(Bt[n], Bt[n], 0, 1, 2, 3), __builtin_shufflevector(At[m], At[m], 0, 1, 2, 3), _c, 0, 0, 0); \
        _c = __builtin_amdgcn_mfma_i32_16x16x64_i8(__builtin_shufflevector(Bt[n], Bt[n], 4, 5, 6, 7), __builtin_shufflevector(At[m], At[m], 4, 5, 6, 7), _c, 0, 0, 0); \
        acc[ai][bj][m][n] = __builtin_bit_cast(f32x4, _c); } } else if constexpr (FP8) { _Pragma("unroll") for (int m = 0; m < 4; ++m) _Pragma("unroll") for (int n = 0; n < 2; ++n) \
        asm volatile("v_mfma_scale_f32_16x16x128_f8f6f4 %0, %1, %2, %0, %3, %4 op_sel_hi:[0,0,0]" : "+v"(acc[ai][bj][m][n]) : "v"(Bt[n]), "v"(At[m]), "v"(sc_w), "v"(sc_a)); } else { \
        _Pragma("unroll") for (int m = 0; m < 4; ++m) _Pragma("unroll") for (int n = 0; n < 2; ++n) { \
        acc[ai][bj][m][n] = __builtin_amdgcn_mfma_f32_16x16x32_bf16(PG8_LO(Bt[n]), PG8_LO(At[m]), acc[ai][bj][m][n], 0, 0, 0); \
        acc[ai][bj][m][n] = __builtin_amdgcn_mfma_f32_16x16x32_bf16(PG8_HI(Bt[n]), PG8_HI(At[m]), acc[ai][bj][m][n], 0, 0, 0); } } __builtin_amdgcn_s_setprio(0); } while (0)
#define PG8_WAIT_V(n) asm volatile("s_waitcnt vmcnt(" #n ")" ::: "memory")
#define PG8_WAIT_L(n) asm volatile("s_waitcnt lgkmcnt(" #n ")" ::: "memory")
#define PG8_BAR __builtin_amdgcn_s_barrier()
#define PG8_SCHED __builtin_amdgcn_sched_barrier(0)
    Unit cur, nxt; int ui = 0;
    if (!S.next(0, cur)) return;
    unsigned gA[2][2], gN[2][2], arow[2];
    if constexpr (GATHER) {
#pragma unroll
        for (int i = 0; i < 2; ++i) { int R, C; stage_rc(tid * 16 + i * 8192, R, C); arow[i] = (unsigned)R; voffA[i] = (unsigned)C * 2u; }
#pragma unroll
        for (int h = 0; h < 2; ++h)
#pragma unroll
            for (int i = 0; i < 2; ++i) gA[h][i] = (unsigned)rowtok[cur.pm * 256 + h * 128 + (int)arow[i]] * (unsigned)(K * 2) + voffA[i];
    }
#define PG8_STAGE_A(bufoff, gbase, h, last_) do { if constexpr (GATHER) { if (last_) { _Pragma("unroll") for (int _i = 0; _i < 2; ++_i) \
        __builtin_amdgcn_global_load_lds((const unsigned*)((const char*)(gbase) + gN[h][_i]), (LAS unsigned*)(lds + (bufoff) + ldsw + _i * 8192), 16, 0, 0); } else { _Pragma("unroll") for (int _i = 0; _i < 2; ++_i) \
        __builtin_amdgcn_global_load_lds((const unsigned*)((const char*)(gbase) + gA[h][_i]), (LAS unsigned*)(lds + (bufoff) + ldsw + _i * 8192), 16, 0, 0); } } \
        else { PG8_STAGE(bufoff, (const char*)(gbase) + (h) * hstep, voffA); } } while (0)
    f32x4 acc[2][2][4][2];
#pragma unroll
    for (int a = 0; a < 2; ++a)
#pragma unroll
        for (int b = 0; b < 2; ++b)
#pragma unroll
            for (int m = 0; m < 4; ++m)
#pragma unroll
                for (int n = 0; n < 2; ++n) acc[a][b][m][n] = (f32x4){0.f, 0.f, 0.f, 0.f};
    i32x8 At[4], B0[2], B1[2];
    int sc_w = 121, sc_a = 127; asm volatile("" : "+v"(sc_w), "+v"(sc_a));
    const char* cA = S.aptr(cur); const char* cB = S.bptr(cur);
    PG8_STAGE(PG8_SB(0, 0), cB, voffB); PG8_STAGE(PG8_SB(0, 1), cB + hstep, voffB); PG8_STAGE_A(PG8_SA(0, 0), cA, 0, false); PG8_STAGE_A(PG8_SA(0, 1), cA, 1, false);
    if (wr == 1) PG8_BAR;
    PG8_WAIT_V(2); PG8_BAR;
    PG8_STAGE(PG8_SB(1, 0), cB + kstep, voffB); PG8_STAGE_A(PG8_SA(1, 0), cA + kstep, 0, false); PG8_STAGE(PG8_SB(1, 1), cB + hstep + kstep, voffB);
    PG8_WAIT_V(6); PG8_BAR;
    for (;;) {
        const bool has_next = S.next(ui + 1, nxt);
        const char* nA = has_next ? S.aptr(nxt) : cA; const char* nB = has_next ? S.bptr(nxt) : cB;
        if constexpr (GATHER) { const int pmn = has_next ? nxt.pm : cur.pm;
#pragma unroll
            for (int h = 0; h < 2; ++h)
#pragma unroll
                for (int i = 0; i < 2; ++i) gN[h][i] = (unsigned)rowtok[pmn * 256 + h * 128 + (int)arow[i]] * (unsigned)(K * 2) + voffA[i]; }
        for (int t = 0; t < nt; t += 2) {
            const bool last = (t == nt - 2);
            const char* a1 = cA + (size_t)(t + 1) * kstep;
            const char* a2 = last ? nA : cA + (size_t)(t + 2) * kstep; const char* b2 = last ? nB : cB + (size_t)(t + 2) * kstep;
            const char* a3 = a2 + kstep; const char* b3 = b2 + kstep;
            PG8_LDB(B0, 0, 0); PG8_LDB(B1, 0, 1); PG8_SCHED; PG8_LDA(At, 0, 0); PG8_STAGE_A(PG8_SA(1, 1), a1, 1, false);
            PG8_WAIT_V(8); PG8_WAIT_L(0); PG8_BAR; PG8_MMA(0, 0, At, B0); PG8_MMA(0, 1, At, B1); PG8_BAR; PG8_SCHED;
            PG8_LDA(At, 0, 1); PG8_STAGE(PG8_SB(0, 0), b2, voffB); PG8_STAGE(PG8_SB(0, 1), b2 + hstep, voffB); PG8_STAGE_A(PG8_SA(0, 0), a2, 0, last);
            PG8_WAIT_V(8); PG8_WAIT_L(0); PG8_BAR; PG8_MMA(1, 0, At, B0); PG8_MMA(1, 1, At, B1); PG8_BAR; PG8_SCHED;
            PG8_LDB(B0, 1, 0); PG8_LDB(B1, 1, 1); PG8_SCHED; PG8_LDA(At, 1, 0); PG8_STAGE_A(PG8_SA(0, 1), a2, 1, last);
            PG8_WAIT_V(8); PG8_WAIT_L(0); PG8_BAR; PG8_MMA(0, 0, At, B0); PG8_MMA(0, 1, At, B1); PG8_BAR; PG8_SCHED;
            PG8_LDA(At, 1, 1); PG8_STAGE(PG8_SB(1, 0), b3, voffB); PG8_STAGE(PG8_SB(1, 1), b3 + hstep, voffB); PG8_STAGE_A(PG8_SA(1, 0), a3, 0, last);
            PG8_WAIT_V(8); PG8_WAIT_L(0); PG8_BAR; PG8_MMA(1, 0, At, B0); PG8_MMA(1, 1, At, B1); PG8_BAR; PG8_SCHED;
        }
        if (wr == 0) PG8_BAR;
        if constexpr (FP8 && !I8) asm volatile("s_nop 15\n\ts_nop 15" ::: "memory");
        if constexpr (I8) {
            const float* rsp = S.rowscale(cur) + cur.pm * 256 + wr * 64 + fr; const unsigned* csb = S.colmax(cur); const int colb = cur.e * 256 + wc * 32 + 8 * fq;
            f32x4 cs[2][2];
#pragma unroll
            for (int bj = 0; bj < 2; ++bj)
#pragma unroll
                for (int n = 0; n < 2; ++n) { const int c0 = S.ccol(colb + bj * 128 + 4 * n); const u32x4 cb = *(const u32x4*)(csb + c0);
                    cs[bj][n] = (f32x4){__uint_as_float(cb.x), __uint_as_float(cb.y), __uint_as_float(cb.z), __uint_as_float(cb.w)} * (1.f / 127.f); }
#pragma unroll
            for (int ai = 0; ai < 2; ++ai)
#pragma unroll
                for (int m = 0; m < 4; ++m) { const float r = rsp[ai * 128 + m * 16];
#pragma unroll
                    for (int bj = 0; bj < 2; ++bj)
#pragma unroll
                        for (int n = 0; n < 2; ++n) { const i32x4 ci = __builtin_bit_cast(i32x4, acc[ai][bj][m][n]);
                            acc[ai][bj][m][n] = (f32x4){(float)ci[0], (float)ci[1], (float)ci[2], (float)ci[3]} * (cs[bj][n] * r); } }
        }
        E(acc, cur, wr, wc, fr, fq);
#ifdef EPI_DUP
        E(acc, cur, wr, wc, fr, fq);
#endif
        if (!has_next) break;
#pragma unroll
        for (int a = 0; a < 2; ++a)
#pragma unroll
            for (int b = 0; b < 2; ++b)
#pragma unroll
                for (int m = 0; m < 4; ++m)
#pragma unroll
                    for (int n = 0; n < 2; ++n) acc[a][b][m][n] = (f32x4){0.f, 0.f, 0.f, 0.f};
        cur = nxt; cA = nA; cB = nB; ++ui;
        if constexpr (GATHER) { gA[0][0] = gN[0][0]; gA[0][1] = gN[0][1]; gA[1][0] = gN[1][0]; gA[1][1] = gN[1][1]; }
        if (wr == 1) PG8_BAR;
    }
    PG8_WAIT_V(0);
    PG8_BAR;
#undef PG8_SA
#undef PG8_SB
#undef PG8_STAGE
#undef PG8_STAGE_A
#undef PG8_LDA
#undef PG8_LDB
#undef PG8_LO
#undef PG8_HI
#undef PG8_MMA
#undef PG8_WAIT_V
#undef PG8_WAIT_L
#undef PG8_BAR
#undef PG8_SCHED
}
struct SchedDense {
    int nM, nN, G, c; const char* A; const char* Bt; size_t tstep;
    __device__ __forceinline__ bool next(int i, Unit& u) const { const long L = (long)i * G + c; if (L >= (long)nM * nN) return false; tile_map((int)L, nM, nN, u.pm, u.pn); u.e = 0; u.h = 0; return true; }
    __device__ __forceinline__ const char* aptr(const Unit& u) const { return A + (size_t)u.pm * tstep; }
    __device__ __forceinline__ const char* bptr(const Unit& u) const { return Bt + (size_t)u.pn * tstep; }
};
struct SchedMerge {
    int nM, nN, G, c; const char *A0, *A1, *B0, *B1; size_t tstep;
    __device__ __forceinline__ bool next(int i, Unit& u) const { const long L = (long)(i >> 1) * G + c; if (L >= (long)nM * nN) return false; tile_map((int)L, nM, nN, u.pm, u.pn); u.e = 0; u.h = i & 1; return true; }
    __device__ __forceinline__ const char* aptr(const Unit& u) const { return (u.h ? A1 : A0) + (size_t)u.pm * tstep; }
    __device__ __forceinline__ const char* bptr(const Unit& u) const { return (u.h ? B1 : B0) + (size_t)u.pn * tstep; }
};
struct SchedMoe {
    int nM, nN, G, c; const char* A; const char* Bt; size_t tstep, estride; const LAS int* tilee; bool gather;
    __device__ __forceinline__ bool next(int i, Unit& u) const { const long L = (long)i * G + c; if (L >= (long)nM * nN) return false; tile_map((int)L, nM, nN, u.pm, u.pn); u.e = __builtin_amdgcn_readfirstlane(tilee[u.pm]); u.h = 0; return true; }
    __device__ __forceinline__ const char* aptr(const Unit& u) const { return gather ? A : A + (size_t)u.pm * tstep; }
    __device__ __forceinline__ const char* bptr(const Unit& u) const { return Bt + (size_t)u.e * estride + (size_t)u.pn * tstep; }
};
}

constexpr int NWAVES = 8;
constexpr int RING_BYTES = 131072, MISC_OFF = RING_BYTES, LDS_BYTES = 147456;
struct Frame { LAS unsigned char* lds; volatile LAS unsigned* MISC; int tid, lane, wave, vcu, G; };
__device__ __forceinline__ Frame phase_frame(const Frame& F0) { Frame F = F0; int t = threadIdx.x; asm volatile("" : "+v"(t)); F.tid = t; F.lane = t & 63; F.wave = __builtin_amdgcn_readfirstlane(t >> 6); return F; }

struct MapId { __device__ __forceinline__ int operator()(int c) const { return c; } };
struct MapWin { __device__ __forceinline__ int operator()(int c) const { return c < 7168 ? c : (c < 7176 ? -1 : c - 8); } };
#ifndef FP8_GROUPS
#define FP8_GROUPS 0x7fu
#endif
__host__ __device__ constexpr int fp8_rank(int g) { int r = 0; for (int i = 0; i < g; ++i) r += (FP8_GROUPS >> i) & 1; return r; }
constexpr int N8G = fp8_rank(7), NB16T = 4 * (7 - N8G), NF8T = 4 * N8G + 16;
template <int SEL> __device__ __forceinline__ int in_tile_of(int l) { int cnt = 0, out = SEL ? 28 + (l - 4 * N8G) : 0;
#pragma unroll
    for (int g = 0; g < 7; ++g) if ((int)((FP8_GROUPS >> g) & 1u) == SEL) { if (l >= 4 * cnt && l < 4 * cnt + 4) out = 4 * g + (l - 4 * cnt); ++cnt; }
    return out; }
struct SchedI8 {
    int nM, nN, G, c; const char* A; const char* Bt; size_t tstep; const float* rs; const unsigned* cs;
    __device__ __forceinline__ bool next(int i, pg8::Unit& u) const { const long L = (long)i * G + c; if (L >= (long)nM * nN) return false; pg8::tile_map((int)L, nM, nN, u.pm, u.pn); u.e = u.pn; u.h = 0; return true; }
    __device__ __forceinline__ const char* aptr(const pg8::Unit& u) const { return A + (size_t)u.pm * tstep; }
    __device__ __forceinline__ const char* bptr(const pg8::Unit& u) const { return Bt + (size_t)u.pn * tstep; }
    __device__ __forceinline__ int ccol(int c0) const { return c0; }
    __device__ __forceinline__ const float* rowscale(const pg8::Unit&) const { return rs; }
    __device__ __forceinline__ const unsigned* colmax(const pg8::Unit&) const { return cs; }
};
template <int SEL> struct SchedIn {
    int nM, nN, G, c; const char* A; const char* Bt; size_t tstep; const float* rs; const unsigned* cs;
    __device__ __forceinline__ bool next(int i, pg8::Unit& u) const { const long L = (long)i * G + c; if (L >= (long)nM * nN) return false; pg8::tile_map((int)L, nM, nN, u.pm, u.pn); u.e = in_tile_of<SEL>(u.pn); u.h = 0; return true; }
    __device__ __forceinline__ const char* aptr(const pg8::Unit& u) const { return A + (size_t)u.pm * tstep; }
    __device__ __forceinline__ const char* bptr(const pg8::Unit& u) const { return Bt + (size_t)(SEL ? u.pn : u.e) * tstep; }
    __device__ __forceinline__ int ccol(int c0) const { return c0 < 7168 ? c0 : c0 + 8; }
    __device__ __forceinline__ const float* rowscale(const pg8::Unit&) const { return rs; }
    __device__ __forceinline__ const unsigned* colmax(const pg8::Unit&) const { return cs; }
};
struct MapWinG { __device__ __forceinline__ int operator()(int c) const { if (c >= 7176) return c - 7176 + 1024 * N8G; if (c >= 7168) return -1; const int g = c >> 10; int r = 0;
#pragma unroll
        for (int i = 0; i < 7; ++i) r += (i < g) ? (int)((FP8_GROUPS >> i) & 1u) : 0;
        return ((FP8_GROUPS >> g) & 1u) ? r * 1024 + (c & 1023) : -1; } };
struct MapGu { __device__ __forceinline__ int operator()(int c) const { const int bj = c >> 11, j = c & 2047; return ((j >> 7) << 8) + (bj << 7) + (j & 127); } };
__device__ __forceinline__ unsigned pk4_fp8(float a, float b, float c, float d) { int r = __builtin_amdgcn_cvt_pk_fp8_f32(a, b, 0, false); r = __builtin_amdgcn_cvt_pk_fp8_f32(c, d, r, true); return (unsigned)r; }
constexpr float W8_SCALE = 64.f;
__device__ __forceinline__ unsigned pk4_i8(float a, float b, float c, float d) { const int q0 = (int)__builtin_rintf(__builtin_amdgcn_fmed3f(a, -127.f, 127.f)), q1 = (int)__builtin_rintf(__builtin_amdgcn_fmed3f(b, -127.f, 127.f)), q2 = (int)__builtin_rintf(__builtin_amdgcn_fmed3f(c, -127.f, 127.f)), q3 = (int)__builtin_rintf(__builtin_amdgcn_fmed3f(d, -127.f, 127.f)); return (unsigned)(q0 & 255) | ((unsigned)(q1 & 255) << 8) | ((unsigned)(q2 & 255) << 16) | ((unsigned)q3 << 24); }
template <class Map, bool Q8 = false, bool I8 = false>
__device__ __forceinline__ void p0_transpose_item(const float* W, int K, int N, void* WTv, LAS float* scr, int item, int lane, Map map, const unsigned* cmax = nullptr) {
    const int nblk = (N + 31) / 32, kb = item / nblk, nb = item % nblk, k0 = 64 * kb, n0 = 32 * nb;
    const int col = n0 + (lane & 31); const bool okc = col < N;
    float v[32];
#pragma unroll
    for (int i = 0; i < 32; ++i) { const int kk = 2 * i + (lane >> 5); v[i] = okc ? W[(size_t)(k0 + kk) * N + col] : 0.f; }
#pragma unroll
    for (int i = 0; i < 32; ++i) { const int kk = 2 * i + (lane >> 5); scr[kk * 33 + (lane & 31)] = v[i]; }
    LDS_WAIT(); asm volatile("" ::: "memory");
    const int c = lane & 7;
#pragma unroll
    for (int j = 0; j < 4; ++j) { const int n = (lane >> 3) + 8 * j; const LAS float* s = scr + (8 * c) * 33 + n;
        const int dr = (n0 + n < N) ? map(n0 + n) : -1;
        if constexpr (Q8) { u32x2 o;
            if constexpr (I8) { const float inv = 127.f / fmaxf(__uint_as_float(cmax[(n0 + n < N) ? n0 + n : 0]), 1e-30f);
                o.x = pk4_i8(s[0 * 33] * inv, s[1 * 33] * inv, s[2 * 33] * inv, s[3 * 33] * inv); o.y = pk4_i8(s[4 * 33] * inv, s[5 * 33] * inv, s[6 * 33] * inv, s[7 * 33] * inv); }
            else { o.x = pk4_fp8(s[0 * 33] * W8_SCALE, s[1 * 33] * W8_SCALE, s[2 * 33] * W8_SCALE, s[3 * 33] * W8_SCALE); o.y = pk4_fp8(s[4 * 33] * W8_SCALE, s[5 * 33] * W8_SCALE, s[6 * 33] * W8_SCALE, s[7 * 33] * W8_SCALE); }
            if (dr >= 0) *(u32x2*)((unsigned char*)WTv + (size_t)dr * K + k0 + 8 * c) = o; }
        else { u32x4 o; o.x = cvt_pk_bf16(s[0 * 33], s[1 * 33]); o.y = cvt_pk_bf16(s[2 * 33], s[3 * 33]); o.z = cvt_pk_bf16(s[4 * 33], s[5 * 33]); o.w = cvt_pk_bf16(s[6 * 33], s[7 * 33]);
            if (dr >= 0) *(u32x4*)((bf16_t*)WTv + (size_t)dr * K + k0 + 8 * c) = o; } }
    LDS_WAIT(); asm volatile("" ::: "memory");
}
template <class Map>
__device__ __forceinline__ void p0_fp8_load(float (&v)[64], const float* W, int N, int item, int lane) {
    const int nblk = N / 32, kb = item / nblk, nb = item % nblk, k0 = 128 * kb + 64 * (lane >> 5), col = 32 * nb + (lane & 31);
    const float* src = W + (size_t)k0 * N + col;
#pragma unroll
    for (int i = 0; i < 64; ++i) v[i] = __builtin_nontemporal_load(src + (size_t)i * N);
}
template <class Map>
__device__ __forceinline__ void p0_fp8_finish(const float (&v)[64], int K, int N, unsigned char* WT, int item, int lane, Map map) {
    const int nblk = N / 32, kb = item / nblk, nb = item % nblk, k0 = 128 * kb + 64 * (lane >> 5), col = 32 * nb + (lane & 31);
    u32x4 o[4];
#pragma unroll
    for (int q = 0; q < 4; ++q) {
        o[q].x = pk4_fp8(v[16 * q + 0] * W8_SCALE, v[16 * q + 1] * W8_SCALE, v[16 * q + 2] * W8_SCALE, v[16 * q + 3] * W8_SCALE);
        o[q].y = pk4_fp8(v[16 * q + 4] * W8_SCALE, v[16 * q + 5] * W8_SCALE, v[16 * q + 6] * W8_SCALE, v[16 * q + 7] * W8_SCALE);
        o[q].z = pk4_fp8(v[16 * q + 8] * W8_SCALE, v[16 * q + 9] * W8_SCALE, v[16 * q + 10] * W8_SCALE, v[16 * q + 11] * W8_SCALE);
        o[q].w = pk4_fp8(v[16 * q + 12] * W8_SCALE, v[16 * q + 13] * W8_SCALE, v[16 * q + 14] * W8_SCALE, v[16 * q + 15] * W8_SCALE); }
#define XCHG(pa, pb, bit, msk) do { const bool b_ = (lane & (bit)) != 0; u32x4 s_ = b_ ? o[pa] : o[pb]; \
        s_.x = (unsigned)__shfl_xor((int)s_.x, msk); s_.y = (unsigned)__shfl_xor((int)s_.y, msk); s_.z = (unsigned)__shfl_xor((int)s_.z, msk); s_.w = (unsigned)__shfl_xor((int)s_.w, msk); \
        if (b_) o[pa] = s_; else o[pb] = s_; } while (0)
    XCHG(0, 1, 1, 1); XCHG(2, 3, 1, 1); XCHG(0, 2, 2, 2); XCHG(1, 3, 2, 2);
#undef XCHG
    const int j = lane & 3, colb = col - j;
#pragma unroll
    for (int q = 0; q < 4; ++q) *(u32x4*)(WT + (size_t)map(colb + q) * K + k0 + 16 * j) = o[q];
}
constexpr int CW_QH = 128, CW_QC = 192;
__device__ __forceinline__ void p0_weights(const Frame& F0, const P& p) { const Frame F = phase_frame(F0);
    LAS float* scr = (LAS float*)(F.lds + F.wave * 8448);
    const int gw = F.vcu * NWAVES + F.wave, NGW = F.G * NWAVES;
    constexpr int I_IN = (2048 / 64) * ((IN_COLS + 31) / 32), I_UP = (1024 / 64) * (2048 / 32), NB16 = I_IN + 2 * I_UP;
    unsigned char* ws = p.ws;
    (void)scr; (void)gw; (void)NGW; (void)ws; (void)NB16;
}
template <int NCOLS, int KROWS = 2048> __device__ __forceinline__ void p0_colmax_t(const Frame& F0, const float* W, unsigned* CMAX) { const Frame F = phase_frame(F0);
    const int gw = F.vcu * NWAVES + F.wave, NGW = F.G * NWAVES, lane = F.lane;
    constexpr int NBLK = (NCOLS + 31) / 32, I_IN = (KROWS / 64) * NBLK;
    for (int it = gw; it < I_IN; it += NGW) { const int kb = it / NBLK, nb = it % NBLK, k0 = 64 * kb, col = 32 * nb + (lane & 31); const bool okc = col < NCOLS;
        float m = 0.f;
#pragma unroll
        for (int i = 0; i < 32; ++i) { const int kk = 2 * i + (lane >> 5); m = fmaxf(m, __builtin_fabsf(okc ? W[(size_t)(k0 + kk) * NCOLS + col] : 0.f)); }
        m = fmaxf(m, __shfl_xor(m, 32));
        if (lane < 32 && okc) atomicMax(CMAX + col, __float_as_uint(m)); }
}
__device__ __forceinline__ void p0_colmax(const Frame& F0, const P& p) { p0_colmax_t<IN_COLS>(F0, p.w_in, (unsigned*)(p.ws + WS_CTL) + CW_CMAX); p0_colmax_t<2048>(F0, p.w_out, (unsigned*)(p.ws + WS_CTL) + CW_CMAX2);
    p0_colmax_t<2048, 1024>(F0, p.w_up_hg, (unsigned*)(p.ws + WS_CTL) + CW_CMAXA); p0_colmax_t<2048, 1024>(F0, p.w_up_fox, (unsigned*)(p.ws + WS_CTL) + CW_CMAXB); }
__device__ __forceinline__ void p0_win_i8(const Frame& F0, const P& p) { const Frame F = phase_frame(F0);
    LAS float* scr = (LAS float*)(F.lds + F.wave * 8448);
    const unsigned* CMAX = (const unsigned*)(p.ws + WS_CTL) + CW_CMAX;
    const int gw = F.vcu * NWAVES + F.wave, NGW = F.G * NWAVES;
    constexpr int I_IN = (2048 / 64) * ((IN_COLS + 31) / 32);
    for (int it = gw; it < I_IN; it += NGW) p0_transpose_item<MapWinG, true, true>(p.w_in, 2048, IN_COLS, p.ws + OFF_WIN8_T, scr, it, F.lane, MapWinG{}, CMAX);
    constexpr int I_OUT = (2048 / 64) * (2048 / 32);
    for (int it = gw; it < I_OUT; it += NGW) p0_transpose_item<MapId, true, true>(p.w_out, 2048, 2048, p.ws + OFF_WOUT8_T, scr, it, F.lane, MapId{}, (const unsigned*)(p.ws + WS_CTL) + CW_CMAX2);
    constexpr int I_UP = (1024 / 64) * (2048 / 32);
    for (int it = gw; it < I_UP; it += NGW) { p0_transpose_item<MapId, true, true>(p.w_up_hg, 1024, 2048, p.ws + OFF_WUPA_T, scr, it, F.lane, MapId{}, (const unsigned*)(p.ws + WS_CTL) + CW_CMAXA);
        p0_transpose_item<MapId, true, true>(p.w_up_fox, 1024, 2048, p.ws + OFF_WUPB_T, scr, it, F.lane, MapId{}, (const unsigned*)(p.ws + WS_CTL) + CW_CMAXB); }
}
template <class Map>
__device__ __forceinline__ void p0_quant_strip(const Frame& F, const float* W, const int K, const int N, const int strip, unsigned char* WT, unsigned* CMAX, Map map) {
    LAS bf16_t* img = (LAS bf16_t*)F.lds; LAS float* red = (LAS float*)(F.lds + MISC_OFF + 4096); LAS float* invs = red + 512;
    const int tid = F.tid, lane = F.lane, n0 = 32 * strip;
    { const int c = tid & 31, r = tid >> 5, col = n0 + c; const bool okc = col < N; float m = 0.f;
      for (int kb = 0; kb < K; kb += 512) { float v[32];
#pragma unroll
          for (int j = 0; j < 32; ++j) v[j] = okc ? W[(size_t)(kb + 16 * j + r) * N + col] : 0.f;
#pragma unroll
          for (int j = 0; j < 32; ++j) { m = fmaxf(m, __builtin_fabsf(v[j])); img[(kb + 16 * j + r) * 32 + c] = f2bf(v[j]); } }
      red[r * 32 + c] = m; }
    __syncthreads();
    if (tid < 32) { float mm = 0.f;
#pragma unroll
        for (int q = 0; q < 16; ++q) mm = fmaxf(mm, red[q * 32 + tid]);
        invs[tid] = 127.f / fmaxf(mm, 1e-30f); if (n0 + tid < N) CMAX[n0 + tid] = __float_as_uint(mm); }
    __syncthreads();
    { const int kq = lane & 7, cs = lane >> 3, c = F.wave * 4 + (cs & 3), hf = cs >> 2, col = n0 + c; const int dr = (col < N) ? map(col) : -1; const float inv = invs[c];
      for (int ch = hf; ch < K / 128; ch += 2) { const int k0 = ch * 128 + 16 * kq; float f[16];
#pragma unroll
          for (int e = 0; e < 16; ++e) f[e] = bf2f(img[(k0 + e) * 32 + c]) * inv;
          u32x4 o; o.x = pk4_i8(f[0], f[1], f[2], f[3]); o.y = pk4_i8(f[4], f[5], f[6], f[7]); o.z = pk4_i8(f[8], f[9], f[10], f[11]); o.w = pk4_i8(f[12], f[13], f[14], f[15]);
          if (dr >= 0) *(u32x4*)(WT + (size_t)dr * K + k0) = o; } }
    __syncthreads();
}
__device__ __forceinline__ void p0_quant_weights(const Frame& F0, const P& p) { const Frame F = phase_frame(F0);
    unsigned* ctl = (unsigned*)(p.ws + WS_CTL);
    constexpr int S_IN = (IN_COLS + 31) / 32, S_SQ = 2048 / 32, S_ALL = S_IN + 3 * S_SQ;
    for (int s0 = F.vcu; s0 < S_ALL; s0 += F.G) { int st = s0;
        if (st < S_IN) { p0_quant_strip(F, p.w_in, 2048, IN_COLS, st, p.ws + OFF_WIN8_T, ctl + CW_CMAX, MapWinG{}); continue; } st -= S_IN;
        if (st < S_SQ) { p0_quant_strip(F, p.w_out, 2048, 2048, st, p.ws + OFF_WOUT8_T, ctl + CW_CMAX2, MapId{}); continue; } st -= S_SQ;
        if (st < S_SQ) { p0_quant_strip(F, p.w_up_hg, 1024, 2048, st, p.ws + OFF_WUPA_T, ctl + CW_CMAXA, MapId{}); continue; } st -= S_SQ;
        p0_quant_strip(F, p.w_up_fox, 1024, 2048, st, p.ws + OFF_WUPB_T, ctl + CW_CMAXB, MapId{}); }
}
struct MapGuOrId { int gu; __device__ __forceinline__ int operator()(int c) const { const int bj = c >> 11, j = c & 2047; return gu ? ((j >> 7) << 8) + (bj << 7) + (j & 127) : c; } };
__device__ __forceinline__ void cq_issue(float (&v)[64], const P& p, int c, int wave, int lane) {
    constexpr int I_GU = (2048 / 128) * (4096 / 32), I_DN = (2048 / 128) * (2048 / 32);
    const int r = __builtin_amdgcn_readfirstlane(c * 8 + wave); const bool gu = r < NEXP * I_GU; const int q = gu ? r : r - NEXP * I_GU, per = gu ? I_GU : I_DN, e = q / per, N = gu ? 4096 : 2048;
    const float* W = gu ? p.w_gu + (size_t)e * 2048 * 4096 : p.w_down + (size_t)e * 2048 * 2048;
    p0_fp8_load<MapId>(v, W, N, q - e * per, lane);
}
__device__ __forceinline__ void cq_finish(const float (&v)[64], const P& p, int c, int wave, int lane) {
    constexpr int I_GU = (2048 / 128) * (4096 / 32), I_DN = (2048 / 128) * (2048 / 32);
    const int r = __builtin_amdgcn_readfirstlane(c * 8 + wave); const bool gu = r < NEXP * I_GU; const int q = gu ? r : r - NEXP * I_GU, per = gu ? I_GU : I_DN, e = q / per, N = gu ? 4096 : 2048;
    unsigned char* WT = gu ? p.ws + OFF_WGU_T + (size_t)e * 4096 * 2048 : p.ws + OFF_WDN_T + (size_t)e * 2048 * 2048;
    p0_fp8_finish(v, 2048, N, WT, q - e * per, lane, MapGuOrId{gu ? 1 : 0});
}
__device__ __forceinline__ void convert_queue(const Frame& F0, const P& p) { const Frame F = phase_frame(F0);
    constexpr int I_GU = (2048 / 128) * (4096 / 32), I_DN = (2048 / 128) * (2048 / 32), NCONV = NEXP * (I_GU + I_DN), NCH = NCONV / 8;
    unsigned* qhead = (unsigned*)(p.ws + WS_CTL) + CW_QC; LAS int* slot = (LAS int*)(F.lds + MISC_OFF + 768);
    if (F.tid == 0) { slot[0] = (int)__hip_atomic_fetch_add(qhead, 1u, __ATOMIC_RELAXED, __HIP_MEMORY_SCOPE_AGENT); slot[1] = (int)__hip_atomic_fetch_add(qhead, 1u, __ATOMIC_RELAXED, __HIP_MEMORY_SCOPE_AGENT); }
    __syncthreads();
    int ca = __builtin_amdgcn_readfirstlane(slot[0]), cb = __builtin_amdgcn_readfirstlane(slot[1]);
    float va[64], vb[64];
    if (ca < NCH) {
        cq_issue(va, p, ca, F.wave, F.lane);
        for (;;) {
            if (F.tid == 0) slot[2] = (int)__hip_atomic_fetch_add(qhead, 1u, __ATOMIC_RELAXED, __HIP_MEMORY_SCOPE_AGENT);
            cq_issue(vb, p, cb < NCH ? cb : NCH - 1, F.wave, F.lane);
            cq_finish(va, p, ca, F.wave, F.lane);
            __syncthreads();
            const int cn = __builtin_amdgcn_readfirstlane(slot[2]);
            if (cb >= NCH) break;
            if (F.tid == 0) slot[3] = (int)__hip_atomic_fetch_add(qhead, 1u, __ATOMIC_RELAXED, __HIP_MEMORY_SCOPE_AGENT);
            cq_issue(va, p, cn < NCH ? cn : NCH - 1, F.wave, F.lane);
            cq_finish(vb, p, cb, F.wave, F.lane);
            __syncthreads();
            const int cm = __builtin_amdgcn_readfirstlane(slot[3]);
            if (cn >= NCH) break;
            ca = cn; cb = cm;
        }
    }
    __syncthreads();
}
__device__ __forceinline__ void p0_router_prep(const Frame& F0, const P& p) { const Frame F = phase_frame(F0);
    bf16_t* RWT = (bf16_t*)(p.ws + OFF_RWT);
    for (int i = F.vcu * NWAVES * 64 + F.tid; i < NEXP * D_MODEL; i += F.G * NWAVES * 64) { const int e = i >> 11, k = i & 2047;
        const float w = p.norm2[k] * p.router_w[(size_t)k * NEXP + e]; const bf16_t hi = f2bf(w); RWT[i] = hi; RWT[NEXP * D_MODEL + i] = f2bf(w - bf2f(hi)); }
}
__device__ __forceinline__ void p0_rmsnorm(const Frame& F0, const P& p) { const Frame F = phase_frame(F0);
    LAS float* WF = (LAS float*)F.lds;
    LAS float* FLs = (LAS float*)(F.lds + 65536);
    unsigned char* H8 = p.ws + OFF_H8; float* HSC = (float*)(p.ws + OFF_HSC); float* C = (float*)(p.ws + OFF_C); float* BT = (float*)(p.ws + OFF_BT);
    for (int k = F.tid; k < D_MODEL; k += NWAVES * 64) { const float4* wr = (const float4*)(p.w_in + (size_t)k * IN_COLS + 7168); const float4 w0 = wr[0], w1 = wr[1];
        WF[0 * 2048 + k] = w0.x; WF[1 * 2048 + k] = w0.y; WF[2 * 2048 + k] = w0.z; WF[3 * 2048 + k] = w0.w; WF[4 * 2048 + k] = w1.x; WF[5 * 2048 + k] = w1.y; WF[6 * 2048 + k] = w1.z; WF[7 * 2048 + k] = w1.w; }
    __syncthreads();
    const int lane = F.lane;
    for (int blk = F.vcu; blk < T / 128; blk += F.G) {
        for (int pr = 0; pr < 8; ++pr) {
            const int lt = F.wave * 16 + 2 * pr, ta = blk * 128 + lt;
            const float4* xa = (const float4*)(p.x + (size_t)ta * D_MODEL); const float4* xb = xa + D_MODEL / 4;
            float4 va[8], vb[8]; float sa = 0.f, sb = 0.f;
#pragma unroll
            for (int i = 0; i < 8; ++i) { va[i] = xa[lane + 64 * i]; vb[i] = xb[lane + 64 * i];
                sa += va[i].x * va[i].x + va[i].y * va[i].y + va[i].z * va[i].z + va[i].w * va[i].w; sb += vb[i].x * vb[i].x + vb[i].y * vb[i].y + vb[i].z * vb[i].z + vb[i].w * vb[i].w; }
            const float ra = rsqrtf(wave_sum(sa) * (1.f / D_MODEL) + EPS), rb = rsqrtf(wave_sum(sb) * (1.f / D_MODEL) + EPS);
            float qa_ = 0.f, qb_ = 0.f;
#pragma unroll
            for (int i = 0; i < 8; ++i) { const float4 g = ((const float4*)p.norm1)[lane + 64 * i];
                qa_ = fmaxf(fmaxf(qa_, fmaxf(__builtin_fabsf(va[i].x * g.x), __builtin_fabsf(va[i].y * g.y))), fmaxf(__builtin_fabsf(va[i].z * g.z), __builtin_fabsf(va[i].w * g.w)));
                qb_ = fmaxf(fmaxf(qb_, fmaxf(__builtin_fabsf(vb[i].x * g.x), __builtin_fabsf(vb[i].y * g.y))), fmaxf(__builtin_fabsf(vb[i].z * g.z), __builtin_fabsf(vb[i].w * g.w))); }
            const float ma_ = fmaxf(wave_max(qa_) * ra, 1e-30f), mb_ = fmaxf(wave_max(qb_) * rb, 1e-30f), inva = 127.f / ma_, invb = 127.f / mb_;
            if (lane == 0) { HSC[ta] = ma_ * (1.f / 127.f); HSC[ta + 1] = mb_ * (1.f / 127.f); }
            float aa[8], ab[8];
#pragma unroll
            for (int j = 0; j < 8; ++j) { aa[j] = 0.f; ab[j] = 0.f; }
#pragma unroll
            for (int i = 0; i < 8; ++i) {
                const float4 g = ((const float4*)p.norm1)[lane + 64 * i]; const int k0 = 4 * (lane + 64 * i);
                const float4 ha = make_float4(va[i].x * ra * g.x, va[i].y * ra * g.y, va[i].z * ra * g.z, va[i].w * ra * g.w);
                const float4 hb = make_float4(vb[i].x * rb * g.x, vb[i].y * rb * g.y, vb[i].z * rb * g.z, vb[i].w * rb * g.w);
                *(unsigned*)(H8 + (size_t)ta * D_MODEL + k0) = pk4_i8(ha.x * inva, ha.y * inva, ha.z * inva, ha.w * inva); *(unsigned*)(H8 + (size_t)(ta + 1) * D_MODEL + k0) = pk4_i8(hb.x * invb, hb.y * invb, hb.z * invb, hb.w * invb);
#pragma unroll
                for (int j = 0; j < 8; ++j) { const f32x4 w = *(const LAS f32x4*)(WF + j * 2048 + k0);
                    aa[j] += ha.x * w[0] + ha.y * w[1] + ha.z * w[2] + ha.w * w[3]; ab[j] += hb.x * w[0] + hb.y * w[1] + hb.z * w[2] + hb.w * w[3]; }
            }
#pragma unroll
            for (int j = 0; j < 8; ++j) { aa[j] = wave_sum(aa[j]); ab[j] = wave_sum(ab[j]); }
            float ma = aa[0], mb = ab[0];
#pragma unroll
            for (int j = 1; j < 8; ++j) { ma = (lane == j) ? aa[j] : ma; mb = (lane == j) ? ab[j] : mb; }
            if (lane < 8) { const float fb = p.f_bias[lane]; FLs[lt * 8 + lane] = log_sigmoidf_(ma + fb); FLs[(lt + 1) * 8 + lane] = log_sigmoidf_(mb + fb); }
        }
        __syncthreads();
        if (F.tid < 8) { float c = 0.f; for (int tt = 0; tt < 128; ++tt) { c += FLs[tt * 8 + F.tid]; FLs[tt * 8 + F.tid] = c; } BT[blk * 8 + F.tid] = c; }
        __syncthreads();
        for (int e = F.tid; e < 1024; e += NWAVES * 64) C[(size_t)blk * 1024 + e] = FLs[e];
        __syncthreads();
    }
}
__device__ __forceinline__ void p1_fix_c(const Frame& F0, const P& p) { const Frame F = phase_frame(F0);
    float* C = (float*)(p.ws + OFF_C); const float* BT = (const float*)(p.ws + OFF_BT);
    for (int blk = F.vcu; blk < T / 128; blk += F.G) {
        const int j = F.tid & 7, b0 = (blk / 64) * 64; float off = 0.f;
        for (int w = b0; w < blk; ++w) off += BT[w * 8 + j];
        for (int e = F.tid; e < 1024; e += NWAVES * 64) C[(size_t)blk * 1024 + e] += off;
    }
}
struct EpiIn1 {
    static constexpr bool PERM = true;
    unsigned char* ws; const float* lb_logits; LAS float* NS; const float* fq_norm; const float* fk_norm;
    __device__ __forceinline__ void operator()(const f32x4 (&acc)[2][2][4][2], const pg8::Unit& u, int wr, int wc, int fr, int fq) const {
        const int pn = u.e; int seg, colt;
        if (pn < 28) { seg = pn >> 2; colt = (pn & 3) * 256; } else if (pn < 36) { seg = 7; colt = (pn - 28) * 256; } else { seg = 8; colt = (pn - 36) * 256; }
        const int ldc = seg < 7 ? 1024 : 2048;
        bf16_t* base = (bf16_t*)(ws + (seg < 7 ? OFF_HQ + (size_t)seg * 64 * MiB : OFF_GA + (size_t)(seg - 7) * 128 * MiB));
        const int row0 = u.pm * 256 + wr * 64 + fr, col0 = colt + wc * 32 + 8 * fq;
        const int mode = (seg == 0) ? 0 : (seg == 1) ? 1 : (seg == 3) ? 3 : (seg >= 7) ? 4 : 2;
        if (seg == 4 || seg == 5) {
            const float* gn = (seg == 4) ? fq_norm : fk_norm; const float gs = (seg == 4) ? 0.08838834764831845f : 1.f;
#pragma unroll
            for (int ai = 0; ai < 2; ++ai)
#pragma unroll
                for (int m = 0; m < 4; ++m)
#pragma unroll
                    for (int bj = 0; bj < 2; ++bj) { const f32x4 a = acc[ai][bj][m][0], b = acc[ai][bj][m][1];
                        float q = a[0] * a[0] + a[1] * a[1] + a[2] * a[2] + a[3] * a[3] + b[0] * b[0] + b[1] * b[1] + b[2] * b[2] + b[3] * b[3];
                        q += __shfl_xor(q, 16); q += __shfl_xor(q, 32);
                        if (fq == 0) NS[(ai * 128 + wr * 64 + m * 16 + fr) * 8 + bj * 4 + wc] = q; }
            asm volatile("s_waitcnt lgkmcnt(0)" ::: "memory");
            __builtin_amdgcn_s_barrier();
            const f32x4 g0 = *(const f32x4*)(gn + 32 * wc + 8 * fq) * gs, g1 = *(const f32x4*)(gn + 32 * wc + 8 * fq + 4) * gs;
#pragma unroll
            for (int ai = 0; ai < 2; ++ai)
#pragma unroll
                for (int m = 0; m < 4; ++m) { bf16_t* rowp = base + (size_t)(row0 + ai * 128 + m * 16) * ldc + col0;
#pragma unroll
                    for (int bj = 0; bj < 2; ++bj) { const f32x4 t = *(const LAS f32x4*)(NS + (ai * 128 + wr * 64 + m * 16 + fr) * 8 + bj * 4);
                        const float rs = rsqrtf((t[0] + t[1] + t[2] + t[3]) * (1.f / 128.f) + EPS);
                        const f32x4 v0 = acc[ai][bj][m][0] * rs * g0, v1 = acc[ai][bj][m][1] * rs * g1;
                        u32x4 w; w.x = cvt_pk_bf16(v0[0], v0[1]); w.y = cvt_pk_bf16(v0[2], v0[3]); w.z = cvt_pk_bf16(v1[0], v1[1]); w.w = cvt_pk_bf16(v1[2], v1[3]);
                        *(u32x4*)(rowp + bj * 128) = w; } }
            return;
        }
        f32x4 lbv[2][2];
        if (mode == 1) {
#pragma unroll
            for (int bj = 0; bj < 2; ++bj)
#pragma unroll
                for (int n = 0; n < 2; ++n) { const int cc = col0 + bj * 128 + 4 * n; const f32x4 l0 = *(const f32x4*)(lb_logits + cc), l1 = *(const f32x4*)(lb_logits + 1024 + cc);
#pragma unroll
                    for (int j = 0; j < 4; ++j) lbv[bj][n][j] = __builtin_amdgcn_rcpf(1.f + __expf(l1[j] - l0[j])); }
        }
#pragma unroll
        for (int ai = 0; ai < 2; ++ai)
#pragma unroll
            for (int m = 0; m < 4; ++m) { bf16_t* rowp = base + (size_t)(row0 + ai * 128 + m * 16) * ldc + col0;
#pragma unroll
                for (int bj = 0; bj < 2; ++bj) { f32x4 v[2] = {acc[ai][bj][m][0], acc[ai][bj][m][1]};
#pragma unroll
                    for (int n = 0; n < 2; ++n)
#pragma unroll
                        for (int j = 0; j < 4; ++j) { float x = v[n][j];
                            if (mode == 0) x = x * fast_sigmoid(x) * 0.08838834764831845f;
                            else if (mode == 1) { const float lb = lbv[bj][n][j]; x = __logf(lb + (1.f - lb) * fast_sigmoid(x)); }
                            else if (mode == 3) x = x * fast_sigmoid(x);
                            else if (mode == 4) x = fast_sigmoid(x);
                            v[n][j] = x; }
                    u32x4 w; w.x = cvt_pk_bf16(v[0][0], v[0][1]); w.y = cvt_pk_bf16(v[0][2], v[0][3]); w.z = cvt_pk_bf16(v[1][0], v[1][1]); w.w = cvt_pk_bf16(v[1][2], v[1][3]);
                    *(u32x4*)(rowp + bj * 128) = w; } }
    }
};

template <int HH> struct EpiMergeT {
    static constexpr bool PERM = true;
    unsigned char* ws;
    __device__ __forceinline__ void operator()(const f32x4 (&acc)[2][2][4][2], const pg8::Unit& u, int wr, int wc, int fr, int fq) const {
        const int row0 = u.pm * 256 + wr * 64 + fr, col0 = u.pn * 256 + wc * 32 + 8 * fq;
        const bf16_t* G = (const bf16_t*)(ws + (HH ? OFF_GB : OFF_GA)); bf16_t* TMP = (bf16_t*)(ws + OFF_X1); bf16_t* MRG = (bf16_t*)(ws + OFF_MRG);
#pragma unroll
        for (int ai = 0; ai < 2; ++ai)
#pragma unroll
            for (int m = 0; m < 4; ++m) { const size_t ro = (size_t)(row0 + ai * 128 + m * 16) * D_MODEL + col0;
#pragma unroll
                for (int bj = 0; bj < 2; ++bj) { const u32x4 g = *(const u32x4*)(G + ro + bj * 128);
                    f32x4 v0 = acc[ai][bj][m][0], v1 = acc[ai][bj][m][1];
                    v0[0] *= __uint_as_float(g.x << 16); v0[1] *= __uint_as_float(g.x & 0xffff0000u); v0[2] *= __uint_as_float(g.y << 16); v0[3] *= __uint_as_float(g.y & 0xffff0000u);
                    v1[0] *= __uint_as_float(g.z << 16); v1[1] *= __uint_as_float(g.z & 0xffff0000u); v1[2] *= __uint_as_float(g.w << 16); v1[3] *= __uint_as_float(g.w & 0xffff0000u);
                    if constexpr (HH != 0) { const u32x4 t = *(const u32x4*)(TMP + ro + bj * 128);
                        v0[0] += __uint_as_float(t.x << 16); v0[1] += __uint_as_float(t.x & 0xffff0000u); v0[2] += __uint_as_float(t.y << 16); v0[3] += __uint_as_float(t.y & 0xffff0000u);
                        v1[0] += __uint_as_float(t.z << 16); v1[1] += __uint_as_float(t.z & 0xffff0000u); v1[2] += __uint_as_float(t.w << 16); v1[3] += __uint_as_float(t.w & 0xffff0000u); }
                    u32x4 w; w.x = cvt_pk_bf16(v0[0], v0[1]); w.y = cvt_pk_bf16(v0[2], v0[3]); w.z = cvt_pk_bf16(v1[0], v1[1]); w.w = cvt_pk_bf16(v1[2], v1[3]);
                    *(u32x4*)((HH ? MRG : TMP) + ro + bj * 128) = w;
                    }
                }
    }
};
struct EpiWout1 {
    static constexpr bool PERM = true;
    const float* x; bf16_t* X1;
    __device__ __forceinline__ void operator()(const f32x4 (&acc)[2][2][4][2], const pg8::Unit& u, int wr, int wc, int fr, int fq) const {
        const int row0 = u.pm * 256 + wr * 64 + fr, col0 = u.pn * 256 + wc * 32 + 8 * fq;
#pragma unroll
        for (int ai = 0; ai < 2; ++ai)
#pragma unroll
            for (int m = 0; m < 4; ++m) { const size_t ro = (size_t)(row0 + ai * 128 + m * 16) * D_MODEL + col0;
#pragma unroll
                for (int bj = 0; bj < 2; ++bj) { const f32x4 v0 = *(const f32x4*)(x + ro + bj * 128) + acc[ai][bj][m][0], v1 = *(const f32x4*)(x + ro + bj * 128 + 4) + acc[ai][bj][m][1];
                    u32x4 w; w.x = cvt_pk_bf16(v0[0], v0[1]); w.y = cvt_pk_bf16(v0[2], v0[3]); w.z = cvt_pk_bf16(v1[0], v1[1]); w.w = cvt_pk_bf16(v1[2], v1[3]);
                    *(u32x4*)(X1 + ro + bj * 128) = w; } }
    }
};
struct EpiGU1 {
    static constexpr bool PERM = true;
    const float* b_gu; unsigned char* ACT; const float* ROWRS;
    __device__ __forceinline__ void operator()(const f32x4 (&acc)[2][2][4][2], const pg8::Unit& u, int wr, int wc, int fr, int fq) const {
        const int row0 = u.pm * 256 + wr * 64 + fr, ca = u.pn * 128 + wc * 32 + 8 * fq;
        const float* bg = b_gu + (size_t)u.e * 4096 + ca;
        const f32x4 bg0 = *(const f32x4*)bg, bg1 = *(const f32x4*)(bg + 4), bu0 = *(const f32x4*)(bg + 2048), bu1 = *(const f32x4*)(bg + 2052);
#pragma unroll
        for (int ai = 0; ai < 2; ++ai)
#pragma unroll
            for (int m = 0; m < 4; ++m) {
                const float rs = ROWRS[row0 + ai * 128 + m * 16];
                f32x4 g[2] = {acc[ai][0][m][0] * rs + bg0, acc[ai][0][m][1] * rs + bg1}, up[2] = {acc[ai][1][m][0] * rs + bu0, acc[ai][1][m][1] * rs + bu1}; float o[8];
#pragma unroll
                for (int n = 0; n < 2; ++n)
#pragma unroll
                    for (int j = 0; j < 4; ++j) { const float gg = fminf(g[n][j], 7.f), uu = fminf(fmaxf(up[n][j], -7.f), 7.f); o[n * 4 + j] = (uu + 1.f) * gg * fast_sigmoid(1.702f * gg); }
                u32x2 w; w.x = pk4_fp8(o[0], o[1], o[2], o[3]); w.y = pk4_fp8(o[4], o[5], o[6], o[7]);
                *(u32x2*)(ACT + (size_t)(row0 + ai * 128 + m * 16) * D_MODEL + ca) = w; }
    }
};
constexpr float YR_SCALE = 32.f;
struct EpiDown1 {
    static constexpr bool PERM = true;
    const float* b_down; const float* ROWW; unsigned char* YR;
    __device__ __forceinline__ void operator()(const f32x4 (&acc)[2][2][4][2], const pg8::Unit& u, int wr, int wc, int fr, int fq) const {
        const int row0 = u.pm * 256 + wr * 64 + fr, col0 = u.pn * 256 + wc * 32 + 8 * fq;
        const float* bb = b_down + (size_t)u.e * 2048 + col0;
        f32x4 bv[2][2];
#pragma unroll
        for (int bj = 0; bj < 2; ++bj) { bv[bj][0] = *(const f32x4*)(bb + bj * 128); bv[bj][1] = *(const f32x4*)(bb + bj * 128 + 4); }
#pragma unroll
        for (int ai = 0; ai < 2; ++ai)
#pragma unroll
            for (int m = 0; m < 4; ++m) { const int r = row0 + ai * 128 + m * 16; const float rw = ROWW[r];
#pragma unroll
                for (int bj = 0; bj < 2; ++bj) { f32x4 v0 = (acc[ai][bj][m][0] + bv[bj][0]) * (rw * YR_SCALE), v1 = (acc[ai][bj][m][1] + bv[bj][1]) * (rw * YR_SCALE);
#pragma unroll
                    for (int j = 0; j < 4; ++j) { v0[j] = __builtin_amdgcn_fmed3f(v0[j], -448.f, 448.f); v1[j] = __builtin_amdgcn_fmed3f(v1[j], -448.f, 448.f); }
                    u32x2 w; w.x = pk4_fp8(v0[0], v0[1], v0[2], v0[3]); w.y = pk4_fp8(v1[0], v1[1], v1[2], v1[3]);
                    *(u32x2*)(YR + (size_t)r * D_MODEL + col0 + bj * 128) = w; } }
    }
};
constexpr int TILEE_LDS_OFF = MISC_OFF + 1024;
__device__ __forceinline__ int load_tile_table(const Frame& F0, const P& p) { const Frame F = phase_frame(F0);
    const int* TILEE = (const int*)(p.ws + OFF_TILEE); LAS int* tl = (LAS int*)(F.lds + TILEE_LDS_OFF);
    for (int i = F.tid; i <= NTILES_MAX; i += NWAVES * 64) tl[i] = TILEE[i];
    __syncthreads();
    return tl[NTILES_MAX];
}


typedef short s16x4 __attribute__((ext_vector_type(4)));
__device__ __forceinline__ int img_off(int row, int ch) { return 256 * row + 16 * (ch ^ (((row & 3) << 2) | ((row >> 2) & 3))); }
__device__ __forceinline__ void tr_frag_issue(s16x4& lo, s16x4& hi, LAS unsigned char* img, int r0, int ctile, int lane) {
    const int q = (lane & 15) >> 2, pp = lane & 3;
    lo = __builtin_amdgcn_ds_read_tr16_b64_v4i16((LAS s16x4*)(img + img_off(r0 + q, 2 * ctile + (pp >> 1)) + 8 * (pp & 1)));
    hi = __builtin_amdgcn_ds_read_tr16_b64_v4i16((LAS s16x4*)(img + img_off(r0 + 4 + q, 2 * ctile + (pp >> 1)) + 8 * (pp & 1)));
}
__device__ __forceinline__ bf16x8 frag8(const s16x4& lo, const s16x4& hi) { return (bf16x8){lo[0], lo[1], lo[2], lo[3], hi[0], hi[1], hi[2], hi[3]}; }
__device__ __forceinline__ float clamp80(float x) { return fminf(fmaxf(x, -80.f), 80.f); }
constexpr int HG_V = 0, HG_K = 16384, HG_Q = 32768, HG_QH = 49152, HG_P = 65536, HG_SEG = 73728, HG_RED = 77824;

__device__ __forceinline__ void hgrn_cumsum(const Frame& F, const unsigned (&lf)[8], float (&b0)[8], float (&b1)[8], float& B0, float& B1) {
    LAS float* SEG = (LAS float*)(F.lds + HG_SEG);
    float c0 = 0.f, c1 = 0.f;
#pragma unroll
    for (int r = 0; r < 8; ++r) { c0 += __uint_as_float(lf[r] << 16); c1 += __uint_as_float(lf[r] & 0xffff0000u); b0[r] = c0; b1[r] = c1; }
    *(LAS f32x2*)(SEG + F.wave * 128 + 2 * F.lane) = (f32x2){c0, c1};
    __syncthreads();
    float p0 = 0.f, p1 = 0.f; B0 = 0.f; B1 = 0.f;
#pragma unroll
    for (int j = 0; j < 8; ++j) { const f32x2 s = *(const LAS f32x2*)(SEG + j * 128 + 2 * F.lane); if (j < F.wave) { p0 += s[0]; p1 += s[1]; } B0 += s[0]; B1 += s[1]; }
#pragma unroll
    for (int r = 0; r < 8; ++r) { b0[r] += p0; b1[r] += p1; }
}
__device__ __forceinline__ void hgrn_v_to_lds(const Frame& F, const bf16_t* HV, size_t tok0, int h) {
#pragma unroll
    for (int i = 0; i < 2; ++i) { const int qd = F.tid + 512 * i, row = qd >> 4, ch = qd & 15;
        const u32x4 v = *(const u32x4*)(HV + (tok0 + row) * 1024 + h * 128 + ch * 8);
        *(LAS u32x4*)(F.lds + HG_V + img_off(row, ch)) = v; }
}
__device__ __forceinline__ void p2_hgrn_local(const Frame& F0, const P& p) { const Frame F = phase_frame(F0);
    const bf16_t* LOGF = (const bf16_t*)(p.ws + OFF_LOGF); const bf16_t* HV = (const bf16_t*)(p.ws + OFF_HV);
    bf16_t* SLOC = (bf16_t*)(p.ws + OFF_SLOC); float* DEC = (float*)(p.ws + OFF_DEC);
    const int w = F.wave, lane = F.lane, g = lane >> 4;
    for (int it = F.vcu; it < 4096; it += F.G) {
        const int bh = it >> 7, n = it & 127, b = bh >> 3, h = bh & 7; const size_t tok0 = (size_t)b * SEQ + n * 64;
        const size_t gbase = (tok0 + 8 * w) * 1024 + h * 128 + 2 * lane;
        unsigned lf[8];
#pragma unroll
        for (int r = 0; r < 8; ++r) lf[r] = *(const unsigned*)(LOGF + gbase + (size_t)r * 1024);
        hgrn_v_to_lds(F, HV, tok0, h);
        float b0[8], b1[8], B0, B1;
        hgrn_cumsum(F, lf, b0, b1, B0, B1);
#pragma unroll
        for (int r = 0; r < 8; ++r) { const float l0 = __uint_as_float(lf[r] << 16), l1 = __uint_as_float(lf[r] & 0xffff0000u);
            const float k0 = (1.f - __expf(l0)) * __expf(B0 - b0[r]), k1 = (1.f - __expf(l1)) * __expf(B1 - b1[r]);
            *(LAS unsigned*)(F.lds + HG_K + img_off(8 * w + r, lane >> 2) + (lane & 3) * 4) = cvt_pk_bf16(k0, k1); }
        if (w == 0) *(f32x2*)(DEC + (size_t)it * 128 + 2 * lane) = (f32x2){__expf(B0), __expf(B1)};
        __syncthreads();
        s16x4 al[2], ah[2];
#pragma unroll
        for (int ks = 0; ks < 2; ++ks) tr_frag_issue(al[ks], ah[ks], F.lds + HG_K, 32 * ks + 8 * g, w, lane);
        f32x4 acc[8];
#pragma unroll
        for (int vt = 0; vt < 8; ++vt) {
            s16x4 bl[2], bh2[2];
#pragma unroll
            for (int ks = 0; ks < 2; ++ks) tr_frag_issue(bl[ks], bh2[ks], F.lds + HG_V, 32 * ks + 8 * g, vt, lane);
            acc[vt] = (f32x4){0.f, 0.f, 0.f, 0.f};
#pragma unroll
            for (int ks = 0; ks < 2; ++ks) acc[vt] = __builtin_amdgcn_mfma_f32_16x16x32_bf16(frag8(al[ks], ah[ks]), frag8(bl[ks], bh2[ks]), acc[vt], 0, 0, 0);
        }
#pragma unroll
        for (int vt = 0; vt < 8; ++vt) { u32x2 o; o.x = cvt_pk_bf16(acc[vt][0], acc[vt][1]); o.y = cvt_pk_bf16(acc[vt][2], acc[vt][3]);
            *(u32x2*)(SLOC + (size_t)it * 16384 + (size_t)(16 * vt + (lane & 15)) * 128 + 16 * w + 4 * g) = o; }
        __syncthreads();
    }
}
__device__ __forceinline__ void p3_hgrn_scan(const Frame& F0, const P& p) { const Frame F = phase_frame(F0);
    const bf16_t* SLOC = (const bf16_t*)(p.ws + OFF_SLOC); const float* DEC = (const float*)(p.ws + OFF_DEC); bf16_t* STATE = (bf16_t*)(p.ws + OFF_STATE);
    for (int gid = F.vcu * 512 + F.tid; gid < 32 * 4096; gid += F.G * 512) {
        const int bh = gid >> 12, e = (gid & 4095) * 4, c = e & 127;
        f32x4 st = {0.f, 0.f, 0.f, 0.f};
        for (int n0 = 0; n0 < 128; n0 += 8) {
            u32x2 sl[8]; f32x4 dc[8];
#pragma unroll
            for (int j = 0; j < 8; ++j) { const size_t it = (size_t)bh * 128 + n0 + j; sl[j] = *(const u32x2*)(SLOC + it * 16384 + e); dc[j] = *(const f32x4*)(DEC + it * 128 + c); }
#pragma unroll
            for (int j = 0; j < 8; ++j) { const size_t it = (size_t)bh * 128 + n0 + j;
                u32x2 o; o.x = cvt_pk_bf16(st[0], st[1]); o.y = cvt_pk_bf16(st[2], st[3]); *(u32x2*)(STATE + it * 16384 + e) = o;
                st[0] = dc[j][0] * st[0] + __uint_as_float(sl[j].x << 16); st[1] = dc[j][1] * st[1] + __uint_as_float(sl[j].x & 0xffff0000u);
                st[2] = dc[j][2] * st[2] + __uint_as_float(sl[j].y << 16); st[3] = dc[j][3] * st[3] + __uint_as_float(sl[j].y & 0xffff0000u); }
        }
    }
}
__device__ __forceinline__ void p4_hgrn_out(const Frame& F0, const P& p) { const Frame F = phase_frame(F0);
    const bf16_t* HQ = (const bf16_t*)(p.ws + OFF_HQ); const bf16_t* LOGF = (const bf16_t*)(p.ws + OFF_LOGF); const bf16_t* HV = (const bf16_t*)(p.ws + OFF_HV); const bf16_t* HG = (const bf16_t*)(p.ws + OFF_HG);
    const bf16_t* STATE = (const bf16_t*)(p.ws + OFF_STATE); bf16_t* AOUT = (bf16_t*)(p.ws + OFF_AOUT);
    const int w = F.wave, lane = F.lane, g = lane >> 4, l15 = lane & 15, tt = w & 3, vh = w >> 2;
    LAS float* RED = (LAS float*)(F.lds + HG_RED);
    unsigned* qhead = (unsigned*)(p.ws + WS_CTL) + CW_QH; LAS int* slot = (LAS int*)(F.lds + MISC_OFF + 768);
    if (F.tid == 0) { slot[1] = (int)__hip_atomic_fetch_add(qhead, 1u, __ATOMIC_RELAXED, __HIP_MEMORY_SCOPE_AGENT); slot[2] = (int)__hip_atomic_fetch_add(qhead, 1u, __ATOMIC_RELAXED, __HIP_MEMORY_SCOPE_AGENT); }
    __syncthreads();
    int it = __builtin_amdgcn_readfirstlane(slot[1]), itn = __builtin_amdgcn_readfirstlane(slot[2]), par = 0;
    unsigned lfN[8], qqN[8]; u32x2 hgN[4]; u32x4 vN[2];
#define HGO_PRE(item) do { const int bh_ = (item) >> 7, n_ = (item) & 127, b_ = bh_ >> 3, h_ = bh_ & 7; const size_t tok_ = (size_t)b_ * SEQ + n_ * 64, gb_ = (tok_ + 8 * w) * 1024 + h_ * 128 + 2 * lane; \
        _Pragma("unroll") for (int r = 0; r < 8; ++r) { lfN[r] = *(const unsigned*)(LOGF + gb_ + (size_t)r * 1024); qqN[r] = *(const unsigned*)(HQ + gb_ + (size_t)r * 1024); } \
        _Pragma("unroll") for (int vt = 0; vt < 4; ++vt) hgN[vt] = *(const u32x2*)(HG + (tok_ + 16 * tt + l15) * 1024 + h_ * 128 + 64 * vh + 16 * vt + 4 * g); \
        _Pragma("unroll") for (int i = 0; i < 2; ++i) { const int qd = F.tid + 512 * i, row = qd >> 4, ch = qd & 15; vN[i] = *(const u32x4*)(HV + (tok_ + row) * 1024 + h_ * 128 + ch * 8); } } while (0)
    if (it < 4096) HGO_PRE(it);
    while (it < 4096) {
        if (F.tid == 0) slot[3 + par] = (int)__hip_atomic_fetch_add(qhead, 1u, __ATOMIC_RELAXED, __HIP_MEMORY_SCOPE_AGENT);
        const int bh = it >> 7, n = it & 127, b = bh >> 3, h = bh & 7; const size_t tok0 = (size_t)b * SEQ + n * 64;
        bf16x8 sfr[4][4];
#pragma unroll
        for (int vt = 0; vt < 4; ++vt)
#pragma unroll
            for (int ks = 0; ks < 4; ++ks) sfr[vt][ks] = *(const bf16x8*)(STATE + (size_t)it * 16384 + (size_t)(64 * vh + 16 * vt + l15) * 128 + 32 * ks + 8 * g);
        u32x2 hgv[4]; unsigned lf[8], qq[8];
#pragma unroll
        for (int vt = 0; vt < 4; ++vt) hgv[vt] = hgN[vt];
#pragma unroll
        for (int r = 0; r < 8; ++r) { lf[r] = lfN[r]; qq[r] = qqN[r]; }
#pragma unroll
        for (int i = 0; i < 2; ++i) { const int qd = F.tid + 512 * i, row = qd >> 4, ch = qd & 15; *(LAS u32x4*)(F.lds + HG_V + img_off(row, ch)) = vN[i]; }
        { const int nx = itn < 4096 ? itn : 4095; HGO_PRE(nx); }
        float b0[8], b1[8], B0, B1;
        hgrn_cumsum(F, lf, b0, b1, B0, B1);
        const float r0 = 0.5f * B0, r1 = 0.5f * B1;
#pragma unroll
        for (int r = 0; r < 8; ++r) { const float l0 = __uint_as_float(lf[r] << 16), l1 = __uint_as_float(lf[r] & 0xffff0000u), q0 = __uint_as_float(qq[r] << 16), q1 = __uint_as_float(qq[r] & 0xffff0000u);
            const int off = img_off(8 * w + r, lane >> 2) + (lane & 3) * 4;
            *(LAS unsigned*)(F.lds + HG_Q + off) = cvt_pk_bf16(q0 * __expf(clamp80(b0[r] - r0)), q1 * __expf(clamp80(b1[r] - r1)));
            *(LAS unsigned*)(F.lds + HG_K + off) = cvt_pk_bf16((1.f - __expf(l0)) * __expf(clamp80(r0 - b0[r])), (1.f - __expf(l1)) * __expf(clamp80(r1 - b1[r])));
            *(LAS unsigned*)(F.lds + HG_QH + off) = cvt_pk_bf16(q0 * __expf(b0[r]), q1 * __expf(b1[r])); }
        __syncthreads();
#pragma unroll
        for (int si = 0; si < 2; ++si) { const int st = 2 * vh + si; f32x4 sc = {0.f, 0.f, 0.f, 0.f};
#pragma unroll
            for (int ks = 0; ks < 4; ++ks) { const bf16x8 a = *(const LAS bf16x8*)(F.lds + HG_K + img_off(16 * st + l15, 4 * ks + g)), bq = *(const LAS bf16x8*)(F.lds + HG_Q + img_off(16 * tt + l15, 4 * ks + g));
                sc = __builtin_amdgcn_mfma_f32_16x16x32_bf16(a, bq, sc, 0, 0, 0); }
#pragma unroll
            for (int rg = 0; rg < 4; ++rg) sc[rg] = (16 * st + 4 * g + rg > 16 * tt + l15) ? 0.f : sc[rg];
            const int t = 16 * tt + l15, chunk = 2 * st + (g >> 1);
            u32x2 o; o.x = cvt_pk_bf16(sc[0], sc[1]); o.y = cvt_pk_bf16(sc[2], sc[3]);
            *(LAS u32x2*)(F.lds + HG_P + t * 128 + ((chunk ^ (t & 7)) * 16) + 8 * (g & 1)) = o; }
        __syncthreads();
        bf16x8 pb[2], qb[4];
        { const int t = 16 * tt + l15;
#pragma unroll
          for (int ks = 0; ks < 2; ++ks) pb[ks] = *(const LAS bf16x8*)(F.lds + HG_P + t * 128 + (((4 * ks + g) ^ (t & 7)) * 16));
#pragma unroll
          for (int ks = 0; ks < 4; ++ks) qb[ks] = *(const LAS bf16x8*)(F.lds + HG_QH + img_off(t, 4 * ks + g)); }
        f32x4 oacc[4]; float ssq = 0.f;
#pragma unroll
        for (int vt = 0; vt < 4; ++vt) {
            s16x4 vl[2], vhh[2];
#pragma unroll
            for (int ks = 0; ks < 2; ++ks) tr_frag_issue(vl[ks], vhh[ks], F.lds + HG_V, 32 * ks + 8 * g, 4 * vh + vt, lane);
            f32x4 a = {0.f, 0.f, 0.f, 0.f};
#pragma unroll
            for (int ks = 0; ks < 2; ++ks) a = __builtin_amdgcn_mfma_f32_16x16x32_bf16(frag8(vl[ks], vhh[ks]), pb[ks], a, 0, 0, 0);
#pragma unroll
            for (int ks = 0; ks < 4; ++ks) a = __builtin_amdgcn_mfma_f32_16x16x32_bf16(sfr[vt][ks], qb[ks], a, 0, 0, 0);
            oacc[vt] = a; ssq += a[0] * a[0] + a[1] * a[1] + a[2] * a[2] + a[3] * a[3];
        }
        ssq += __shfl_xor(ssq, 16); ssq += __shfl_xor(ssq, 32);
        if (g == 0) RED[(16 * tt + l15) * 2 + vh] = ssq;
        __syncthreads();
        { const int t = 16 * tt + l15; const float tot = RED[t * 2] + RED[t * 2 + 1], rs = rsqrtf(tot * (1.f / 128.f) + EPS);
#pragma unroll
          for (int vt = 0; vt < 4; ++vt) { const int v0 = 64 * vh + 16 * vt + 4 * g; const f32x4 gn = *(const f32x4*)(p.hg_norm + v0);
              const float y0 = oacc[vt][0] * rs * gn[0] * __uint_as_float(hgv[vt].x << 16), y1 = oacc[vt][1] * rs * gn[1] * __uint_as_float(hgv[vt].x & 0xffff0000u);
              const float y2 = oacc[vt][2] * rs * gn[2] * __uint_as_float(hgv[vt].y << 16), y3 = oacc[vt][3] * rs * gn[3] * __uint_as_float(hgv[vt].y & 0xffff0000u);
              u32x2 o; o.x = cvt_pk_bf16(y0, y1); o.y = cvt_pk_bf16(y2, y3);
              *(u32x2*)(AOUT + (tok0 + t) * 1024 + h * 128 + v0) = o; } }
        __syncthreads();
        it = itn; itn = __builtin_amdgcn_readfirstlane(slot[3 + par]); par ^= 1;
    }
#undef HGO_PRE
}

namespace fox {
constexpr int NW = 8, QBLK = 32, KVBLK = 64, QB = NW * QBLK, D = 128, RS = 1024;
constexpr int SHM_V = KVBLK * D * 2, SHM_K = KVBLK * D * 2;
constexpr int OFF_VL = 0, OFF_KL = 2 * SHM_V, OFF_WS = 2 * SHM_V + 2 * SHM_K, OFF_BIAS = OFF_WS + NW * 64 * 4, OFF_ITEM = OFF_BIAS + 2 * 64 * 4;
constexpr float THR = 8.f;
typedef float f32x16 __attribute__((ext_vector_type(16)));
#define KSWZ(row, colB) ((row) * 256 + ((colB) ^ (((row) & 7) << 4)))
#define SBAR() __builtin_amdgcn_sched_barrier(0)
__device__ __forceinline__ int v_st(int k, int c) { const int kk = (k & ~0xC) | ((k & 4) << 1) | ((k & 8) >> 1); return ((kk >> 3) * 4 + (c >> 5)) * 512 + ((kk & 7) * 32 + (c & 31)) * 2; }
__device__ __forceinline__ int v_rd_base(int lane) { return ((lane & 3) << 3) | (((lane >> 2) & 3) << 6) | (((lane >> 4) & 1) << 5) | (((lane >> 5) & 1) << 8); }
constexpr int v_rd_off(int d0, int ks, int half) { return d0 * 512 + ks * 4096 + half * 2048; }
__device__ __forceinline__ int crow(int r, int hi) { return (r & 3) + 8 * (r >> 2) + 4 * hi; }
__device__ __forceinline__ void mask_tile(f32x16& p0, f32x16& p1, int dq) {
    const float NEG = -__builtin_inff();
#pragma unroll
    for (int r = 0; r < 16; ++r) { const int c = (r & 3) + 8 * (r >> 2); if (dq - c < 0) p0[r] = NEG; if (dq - c - 32 < 0) p1[r] = NEG; }
}
__device__ __forceinline__ void partialSM(f32x16& p0, f32x16& p1, float& m_reg, float& mn, float& alpha) {
    float pmax = p0[0];
#pragma unroll
    for (int r = 1; r < 16; ++r) pmax = fmaxf(pmax, p0[r]);
#pragma unroll
    for (int r = 0; r < 16; ++r) pmax = fmaxf(pmax, p1[r]);
    { auto rr = __builtin_amdgcn_permlane32_swap(__float_as_uint(pmax), __float_as_uint(pmax), false, false); pmax = fmaxf(__uint_as_float(rr[0]), __uint_as_float(rr[1])); }
    constexpr float C2 = 1.4426950408889634f;
    if (__builtin_expect(__all((pmax - m_reg) <= THR), 1)) { mn = m_reg; alpha = 1.f; }
    else { mn = fmaxf(m_reg, pmax); alpha = __builtin_amdgcn_exp2f((m_reg - mn) * C2); m_reg = mn; }
    const float mnL = -mn * C2;
#pragma unroll
    for (int r = 0; r < 16; ++r) p0[r] = fmaf(p0[r], C2, mnL);
#pragma unroll
    for (int r = 0; r < 16; ++r) p1[r] = fmaf(p1[r], C2, mnL);
#pragma unroll
    for (int r = 0; r < 16; ++r) p0[r] = __builtin_amdgcn_exp2f(p0[r]);
}
__device__ __forceinline__ void finishSM(f32x16& p0, f32x16& p1, float alpha, float& l_reg, bf16x8& pa0, bf16x8& pa1, bf16x8& pa2, bf16x8& pa3) {
#pragma unroll
    for (int r = 0; r < 16; ++r) p1[r] = __builtin_amdgcn_exp2f(p1[r]);
    float ps = 0;
#pragma unroll
    for (int r = 0; r < 16; ++r) ps += p0[r];
#pragma unroll
    for (int r = 0; r < 16; ++r) ps += p1[r];
    { auto rr = __builtin_amdgcn_permlane32_swap(__float_as_uint(ps), __float_as_uint(ps), false, false); ps = __uint_as_float(rr[0]) + __uint_as_float(rr[1]); }
    l_reg = l_reg * alpha + ps;
#define PK4(P, B_, OUT) do { unsigned a0 = cvt_pk_bf16(P[B_+0], P[B_+1]), a1 = cvt_pk_bf16(P[B_+2], P[B_+3]); unsigned b0 = cvt_pk_bf16(P[B_+4], P[B_+5]), b1 = cvt_pk_bf16(P[B_+6], P[B_+7]); \
        auto r0 = __builtin_amdgcn_permlane32_swap(a0, b0, false, false); auto r1 = __builtin_amdgcn_permlane32_swap(a1, b1, false, false); \
        u32x4 w = {r0[0], r1[0], r0[1], r1[1]}; OUT = *reinterpret_cast<bf16x8*>(&w); } while (0)
    PK4(p0, 0, pa0); PK4(p0, 8, pa1); PK4(p1, 0, pa2); PK4(p1, 8, pa3);
#undef PK4
}
template <int KB>
__device__ __forceinline__ void qkt(f32x16& p0, f32x16& p1, const LAS char* lds, int r32, int hi, const bf16x8* qr) {
    const LAS float* bb = (const LAS float*)(lds + OFF_BIAS) + KB * 64 + 4 * hi;
#pragma unroll
    for (int j = 0; j < 4; ++j) { const f32x4 a = *(const LAS f32x4*)(bb + 8 * j), b = *(const LAS f32x4*)(bb + 32 + 8 * j);
        p0[4 * j] = a[0]; p0[4 * j + 1] = a[1]; p0[4 * j + 2] = a[2]; p0[4 * j + 3] = a[3]; p1[4 * j] = b[0]; p1[4 * j + 1] = b[1]; p1[4 * j + 2] = b[2]; p1[4 * j + 3] = b[3]; }
    const LAS char* kb[4];
#pragma unroll
    for (int dd = 0; dd < 4; ++dd) kb[dd] = lds + OFF_KL + KB * SHM_K + KSWZ(r32, (dd * 16 + hi * 8) * 2);
#pragma unroll
    for (int d0 = 0; d0 < 8; ++d0) { const LAS char* a = kb[d0 & 3] + (d0 >> 2) * 128;
        const bf16x8 b0 = *reinterpret_cast<const LAS bf16x8*>(a), b1 = *reinterpret_cast<const LAS bf16x8*>(a + 32 * 256);
        p0 = __builtin_amdgcn_mfma_f32_32x32x16_bf16(b0, qr[d0], p0, 0, 0, 0);
        p1 = __builtin_amdgcn_mfma_f32_32x32x16_bf16(b1, qr[d0], p1, 0, 0, 0); }
}
template <int VB>
__device__ __forceinline__ void pv_tile(f32x16* o, const LAS char* vb0, bf16x8 pa0, bf16x8 pa1, bf16x8 pa2, bf16x8 pa3) {
#define TRR(off) __builtin_amdgcn_ds_read_tr16_b64_v4i16((LAS s16x4*)(vb0 + (off)))
#define PV_D0(d0) do { constexpr int b_ = VB * SHM_V + v_rd_off(d0, 0, 0); \
        const s16x4 l0 = TRR(b_), h0 = TRR(b_ + 2048), l1 = TRR(b_ + 4096), h1 = TRR(b_ + 6144), l2 = TRR(b_ + 8192), h2 = TRR(b_ + 10240), l3 = TRR(b_ + 12288), h3 = TRR(b_ + 14336); \
        o[d0] = __builtin_amdgcn_mfma_f32_32x32x16_bf16(pa0, (bf16x8){l0[0], l0[1], l0[2], l0[3], h0[0], h0[1], h0[2], h0[3]}, o[d0], 0, 0, 0); \
        o[d0] = __builtin_amdgcn_mfma_f32_32x32x16_bf16(pa1, (bf16x8){l1[0], l1[1], l1[2], l1[3], h1[0], h1[1], h1[2], h1[3]}, o[d0], 0, 0, 0); \
        o[d0] = __builtin_amdgcn_mfma_f32_32x32x16_bf16(pa2, (bf16x8){l2[0], l2[1], l2[2], l2[3], h2[0], h2[1], h2[2], h2[3]}, o[d0], 0, 0, 0); \
        o[d0] = __builtin_amdgcn_mfma_f32_32x32x16_bf16(pa3, (bf16x8){l3[0], l3[1], l3[2], l3[3], h3[0], h3[1], h3[2], h3[3]}, o[d0], 0, 0, 0); } while (0)
    PV_D0(0); PV_D0(1); PV_D0(2); PV_D0(3);
#undef PV_D0
#undef TRR
}
struct BlockRef { const bf16_t* Q; const bf16_t* K; const bf16_t* V; bf16_t* O; const float* Cp; int P0, jlo; float cref; };
struct Seam { bf16x8 qr[8]; bf16x8 st_v0, st_v1, st_k0, st_k1; float sb0, sb1; };
#define ROW(p, k0, rr) ((p) + (size_t)((k0) + (rr)) * RS + sc)
#define VMW() asm volatile("s_waitcnt vmcnt(0)" ::: "memory")
#define VMWN(n) asm volatile("s_waitcnt vmcnt(%0)" :: "i"(n) : "memory")
#define SLOAD_H(R, k0) do { S.st_v0 = *(const bf16x8*)ROW((R).V, k0, sr); S.st_v1 = *(const bf16x8*)ROW((R).V, k0, 32 + sr); S.st_k0 = *(const bf16x8*)ROW((R).K, k0, sr); S.st_k1 = *(const bf16x8*)ROW((R).K, k0, 32 + sr); \
        S.sb0 = (R).Cp[(size_t)((k0) + sr) * 8]; S.sb1 = (R).Cp[(size_t)((k0) + 32 + sr) * 8]; } while (0)
#define SWRITE_HK(bf, cr) do { *(LAS bf16x8*)(K_lds + (bf) * SHM_K + kws) = S.st_k0; *(LAS bf16x8*)(K_lds + (bf) * SHM_K + kws + 32 * 256) = S.st_k1; \
        if (sc == 0) { BIASL[(bf) * 64 + sr] = (cr) - S.sb0; BIASL[(bf) * 64 + 32 + sr] = (cr) - S.sb1; } } while (0)
#define SWRITE_HV(bf) do { *(LAS bf16x8*)(V_lds + (bf) * SHM_V + vst0) = S.st_v0; *(LAS bf16x8*)(V_lds + (bf) * SHM_V + vst1) = S.st_v1; } while (0)
#define SWRITE_H(bf, cr) do { SWRITE_HV(bf); SWRITE_HK(bf, cr); } while (0)
__device__ __forceinline__ void prime(const BlockRef& cur, LAS char* lds, Seam& S) {
    int tid = threadIdx.x; asm volatile("" : "+v"(tid)); const int wid = __builtin_amdgcn_readfirstlane(tid >> 6), lane = tid & 63, r32 = lane & 31, hi = lane >> 5;
    const int sr = tid >> 4, sc = (tid & 15) * 8, kws = KSWZ(sr, sc * 2); LAS char* K_lds = lds + OFF_KL; LAS float* BIASL = (LAS float*)(lds + OFF_BIAS);
    const int kb0 = cur.jlo * KVBLK;
#pragma unroll
    for (int d0 = 0; d0 < 8; ++d0) S.qr[d0] = *(const bf16x8*)(cur.Q + (size_t)(wid * QBLK + r32) * RS + d0 * 16 + hi * 8);
    SLOAD_H(cur, kb0); VMW(); SWRITE_HK(0, cur.cref);
    __syncthreads();
}
__device__ __forceinline__ void block(const BlockRef& cur, const BlockRef& nxt, LAS char* lds, Seam& S) {
    const int tid = threadIdx.x, wid = __builtin_amdgcn_readfirstlane(tid >> 6), lane = tid & 63, r32 = lane & 31, hi = lane >> 5;
    const int j_lo = cur.jlo, j_hi = (cur.P0 + QB - 1) / KVBLK + 1, NT = j_hi - j_lo;
    const int kbn = nxt.jlo * KVBLK;
    const int qlo = cur.P0 + wid * QBLK, qm = qlo + r32 - 4 * hi;
    LAS char* V_lds = lds + OFF_VL; LAS char* K_lds = lds + OFF_KL; LAS float* BIASL = (LAS float*)(lds + OFF_BIAS);
    LAS float* ws = (LAS float*)(lds + OFF_WS) + wid * 64; LAS float* li_l = ws; LAS float* al_l = ws + 32;
    float m_reg = -1e30f, l_reg = 0; f32x16 o[4] = {};
    const int sr = tid >> 4, sc = (tid & 15) * 8, vst0 = v_st(sr, sc), vst1 = v_st(32 + sr, sc), kws = KSWZ(sr, sc * 2);
    const LAS char* vb0 = V_lds + v_rd_base(lane);
#define RESC(a) do { if (__any((a) < 1.f)) { if (hi == 0) al_l[r32] = (a); asm volatile("s_waitcnt lgkmcnt(0)" ::: "memory"); \
                     for (int d_ = 0; d_ < 4; ++d_) for (int r = 0; r < 16; ++r) o[d_][r] *= al_l[crow(r, hi)]; } } while (0)
#define KBASE(t) ((j_lo + (t)) * KVBLK)
#define MASKT(P0_, P1_, t) do { const int kb_ = KBASE(t); if (kb_ + KVBLK - 1 > qlo) mask_tile(P0_, P1_, qm - kb_); } while (0)
#define SEAM_K0() do { VMWN(8); SWRITE_HK(0, nxt.cref); SBAR(); } while (0)
    f32x16 pA0, pA1, pB0, pB1; float mnA, mnB, alA, alB; bf16x8 pa0, pa1, pa2, pa3;
    SWRITE_HV(0); SBAR();
    if (NT > 1) SLOAD_H(cur, KBASE(1));
    SBAR(); qkt<0>(pA0, pA1, lds, r32, hi, S.qr);
    mask_tile(pA0, pA1, qm - KBASE(0)); partialSM(pA0, pA1, m_reg, mnA, alA);
    if (NT > 1) { VMW(); SWRITE_H(1, cur.cref); }
    __syncthreads();
#define HALF_STEP(PX0, PX1, mnX, alX, PY0, PY1, alY, t, KB, VB, SB) do { \
        SBAR(); qkt<KB>(PX0, PX1, lds, r32, hi, S.qr); \
        finishSM(PY0, PY1, alY, l_reg, pa0, pa1, pa2, pa3); SBAR(); \
        if ((t) + 1 < NT) { SLOAD_H(cur, KBASE((t) + 1)); SBAR(); } \
        pv_tile<VB>(o, vb0, pa0, pa1, pa2, pa3); MASKT(PX0, PX1, (t)); partialSM(PX0, PX1, m_reg, mnX, alX); \
        __syncthreads(); \
        if ((t) + 1 < NT) { VMW(); SWRITE_H(SB, cur.cref); } \
        RESC(alX); __syncthreads(); } while (0)
    for (int t = 1; t + 1 < NT; t += 2) {
        HALF_STEP(pB0, pB1, mnB, alB, pA0, pA1, alA, t, 1, 0, 0);
        HALF_STEP(pA0, pA1, mnA, alA, pB0, pB1, alB, t + 1, 0, 1, 1);
    }
    const bool even = (NT & 1) == 0;
    if (even) { SBAR(); qkt<1>(pB0, pB1, lds, r32, hi, S.qr); SBAR(); }
    SLOAD_H(nxt, kbn); SBAR();
#pragma unroll
    for (int d0 = 0; d0 < 8; ++d0) S.qr[d0] = *(const bf16x8*)(nxt.Q + (size_t)(wid * QBLK + r32) * RS + d0 * 16 + hi * 8);
    SBAR();
    finishSM(pA0, pA1, alA, l_reg, pa0, pa1, pa2, pa3); SBAR();
    pv_tile<0>(o, vb0, pa0, pa1, pa2, pa3);
    if (even) { MASKT(pB0, pB1, NT - 1); partialSM(pB0, pB1, m_reg, mnB, alB); __syncthreads(); RESC(alB);
        finishSM(pB0, pB1, alB, l_reg, pa0, pa1, pa2, pa3); SBAR(); pv_tile<1>(o, vb0, pa0, pa1, pa2, pa3); }
    SBAR(); SEAM_K0();
    if (hi == 0) li_l[r32] = l_reg; asm volatile("s_waitcnt lgkmcnt(0)" ::: "memory");
    const __amdgpu_buffer_rsrc_t orsrc = __builtin_amdgcn_make_buffer_rsrc((void*)(cur.O + (size_t)(wid * QBLK) * RS), 0, QBLK * RS * 2, 0x00020000);
    const int ovoff = (hi * 4 * RS + r32) * 2;
#pragma unroll
    for (int r = 0; r < 16; ++r) { const int orow0 = (r & 3) + 8 * (r >> 2); const float rl = __builtin_amdgcn_rcpf(li_l[orow0 + 4 * hi]);
#pragma unroll
        for (int d0 = 0; d0 < 4; ++d0) { const float v = o[d0][r] * rl; const float vn = __shfl_xor(v, 1);
            if ((r32 & 1) == 0) __builtin_amdgcn_raw_buffer_store_b32(cvt_pk_bf16(v, vn), orsrc, ovoff, orow0 * RS * 2 + d0 * 64, 0); } }
    __syncthreads();
#undef RESC
#undef KBASE
#undef MASKT
#undef SEAM_K0
#undef HALF_STEP
}
#undef ROW
#undef VMW
#undef VMWN
#undef SLOAD_H
#undef SWRITE_HK
#undef SWRITE_HV
#undef SWRITE_H
#undef KSWZ
#undef SBAR
}
constexpr int CW_ATTQ = 64;
__device__ __forceinline__ void p2_jlo(const Frame& F0, const P& p) { const Frame F = phase_frame(F0);
    const float* C = (const float*)(p.ws + OFF_C); int* JLO = (int*)(p.ws + OFF_JLO);
    const int gw = F.vcu * NWAVES + F.wave, NGW = F.G * NWAVES, lane = F.lane;
    const float gq = wave_max(fmaxf(fabsf(p.fq_norm[2 * lane]), fabsf(p.fq_norm[2 * lane + 1]))), gk = wave_max(fmaxf(fabsf(p.fk_norm[2 * lane]), fabsf(p.fk_norm[2 * lane + 1])));
    const float th = -(2.f * 1.02f * gq * gk * 11.3137085f + 104.f);
    for (int e = gw; e < BATCH * HEADS * 32; e += NGW) {
        const int b = e >> 8, h = (e >> 5) & 7, qb = e & 31, P0 = qb * 256;
        const float* Cp = C + (size_t)b * SEQ * 8 + h; const float c0 = Cp[(size_t)P0 * 8];
        int cnt = 0;
#pragma unroll
        for (int i = 0; i < 2; ++i) { const int j = lane + 64 * i, kl = 64 * j + 63; const bool neg = (kl < P0) && (c0 - Cp[(size_t)(kl < SEQ ? kl : 0) * 8] < th); cnt += __popcll(__ballot(neg)); }
        if (lane == 0) JLO[e] = cnt;
    }
}
__device__ __forceinline__ void p4_attention(const Frame& F0, const P& p, int rep) { const Frame F = phase_frame(F0);
    LAS char* lds = (LAS char*)F.lds; LAS int* ITEM = (LAS int*)(lds + fox::OFF_ITEM);
    const bf16_t* FQ = (const bf16_t*)(p.ws + OFF_FQ); const bf16_t* FK = (const bf16_t*)(p.ws + OFF_FK); const bf16_t* FV = (const bf16_t*)(p.ws + OFF_FV); bf16_t* BOUT = (bf16_t*)(p.ws + OFF_BOUT);
    const float* C = (const float*)(p.ws + OFF_C); const int* JLO = (const int*)(p.ws + OFF_JLO);
    unsigned* qhead = (unsigned*)(p.ws + WS_CTL) + CW_ATTQ + 64 * rep;
    constexpr int TOTAL = BATCH * HEADS * 32;
    if (F.tid == 0) { float fb[8]; for (int i = 0; i < 8; ++i) fb[i] = p.f_bias[i];
        for (int r = 0; r < 8; ++r) { int best = 0; for (int i = 1; i < 8; ++i) if (fb[i] > fb[best]) best = i; ITEM[r] = best; fb[best] = -INFINITY; }
        ITEM[8] = (int)__hip_atomic_fetch_add(qhead, 1u, __ATOMIC_RELAXED, __HIP_MEMORY_SCOPE_AGENT); }
    __syncthreads();
    auto mkref = [&](int L) { fox::BlockRef r; const int hr = L >> 7, rr = L & 127, qb = 31 - (rr >> 2), b = rr & 3, h = __builtin_amdgcn_readfirstlane(ITEM[hr]); const size_t t0 = (size_t)b * SEQ;
        r.Q = FQ + (t0 + qb * 256) * 1024 + h * 128; r.K = FK + t0 * 1024 + h * 128; r.V = FV + t0 * 1024 + h * 128; r.O = BOUT + (t0 + qb * 256) * 1024 + h * 128;
        r.Cp = C + t0 * 8 + h; r.P0 = qb * 256; r.jlo = __builtin_amdgcn_readfirstlane(JLO[(b * 8 + h) * 32 + qb]);
        r.cref = __uint_as_float(__builtin_amdgcn_readfirstlane(__float_as_uint(r.Cp[(size_t)(qb * 256 + 255) * 8]))); return r; };
    int L = __builtin_amdgcn_readfirstlane(ITEM[8]);
    if (L >= TOTAL) return;
    if (F.tid == 0) ITEM[9] = (int)__hip_atomic_fetch_add(qhead, 1u, __ATOMIC_RELAXED, __HIP_MEMORY_SCOPE_AGENT);
    __syncthreads();
    int Ln = __builtin_amdgcn_readfirstlane(ITEM[9]);
    fox::BlockRef cur = mkref(L);
    fox::Seam S;
    fox::prime(cur, lds, S);
    for (int it = 0;; ++it) {
        const bool last = Ln >= TOTAL;
        if (!last && F.tid == 0) ITEM[8 + (it & 1)] = (int)__hip_atomic_fetch_add(qhead, 1u, __ATOMIC_RELAXED, __HIP_MEMORY_SCOPE_AGENT);
        const fox::BlockRef nxt = last ? cur : mkref(Ln);
        fox::block(cur, nxt, lds, S);
        if (last) break;
        cur = nxt; L = Ln; Ln = __builtin_amdgcn_readfirstlane(ITEM[8 + (it & 1)]);
    }
}
__device__ __forceinline__ void p2_qknorm(const Frame& F0, const P& p) { const Frame F = phase_frame(F0);
    bf16_t* FQ = (bf16_t*)(p.ws + OFF_FQ); bf16_t* FK = (bf16_t*)(p.ws + OFF_FK);
    const int gw = F.vcu * NWAVES + F.wave, NGW = F.G * NWAVES, lane = F.lane, d0 = (lane & 7) * 16;
    float gq[16], gk[16];
#pragma unroll
    for (int j = 0; j < 16; ++j) { gq[j] = p.fq_norm[d0 + j] * 0.08838834764831845f; gk[j] = p.fk_norm[d0 + j]; }
    for (int t = gw; t < T; t += NGW) {
#pragma unroll
        for (int which = 0; which < 2; ++which) {
            bf16_t* ptr = (which ? FK : FQ) + (size_t)t * 1024 + lane * 16;
            const u32x4 a = *(const u32x4*)ptr, b = *(const u32x4*)(ptr + 8); const unsigned w[8] = {a.x, a.y, a.z, a.w, b.x, b.y, b.z, b.w};
            float v[16]; float ss = 0.f;
#pragma unroll
            for (int j = 0; j < 8; ++j) { v[2 * j] = __uint_as_float(w[j] << 16); v[2 * j + 1] = __uint_as_float(w[j] & 0xffff0000u); ss += v[2 * j] * v[2 * j] + v[2 * j + 1] * v[2 * j + 1]; }
            ss += __shfl_xor(ss, 1); ss += __shfl_xor(ss, 2); ss += __shfl_xor(ss, 4);
            const float rs = rsqrtf(ss * (1.f / 128.f) + EPS);
            unsigned o[8];
#pragma unroll
            for (int j = 0; j < 8; ++j) o[j] = which ? cvt_pk_bf16(v[2 * j] * rs * gk[2 * j], v[2 * j + 1] * rs * gk[2 * j + 1]) : cvt_pk_bf16(v[2 * j] * rs * gq[2 * j], v[2 * j + 1] * rs * gq[2 * j + 1]);
            *(u32x4*)ptr = (u32x4){o[0], o[1], o[2], o[3]}; *(u32x4*)(ptr + 8) = (u32x4){o[4], o[5], o[6], o[7]};
        }
    }
}
__device__ __forceinline__ void p7_router(const Frame& F0, const P& p) { const Frame F = phase_frame(F0);
    LAS int* hist = (LAS int*)(F.lds + MISC_OFF + 512);
    const bf16_t* X1 = (const bf16_t*)(p.ws + OFF_X1B); unsigned char* H2 = p.ws + OFF_H2; const bf16_t* RWT = (const bf16_t*)(p.ws + OFF_RWT); float* RSTD = (float*)(p.ws + OFF_RSTD);
    int* TOPI = (int*)(p.ws + OFF_TOPI); float* GATE = (float*)(p.ws + OFF_GATE); int* CNT = (int*)(p.ws + OFF_CNT);
    const int lane = F.lane, l15 = lane & 15, kg = lane >> 4;
    for (int blk = F.vcu; blk < T / 128; blk += F.G) {
        if (F.tid < NEXP) hist[F.tid] = 0;
        __syncthreads();
        const int tok = blk * 128 + F.wave * 16 + l15;
        const bf16_t* xr = X1 + (size_t)tok * D_MODEL + 8 * kg; unsigned char* hr = H2 + (size_t)tok * D_MODEL + 8 * kg;
        f32x4 acc0 = {0.f, 0.f, 0.f, 0.f}, acc1 = {0.f, 0.f, 0.f, 0.f}; float ss = 0.f;
#pragma unroll 4
        for (int ks = 0; ks < 64; ++ks) {
            const u32x4 xw = *(const u32x4*)(xr + 32 * ks);
            const f32x4 xa = {__uint_as_float(xw.x << 16), __uint_as_float(xw.x & 0xffff0000u), __uint_as_float(xw.y << 16), __uint_as_float(xw.y & 0xffff0000u)}, xb = {__uint_as_float(xw.z << 16), __uint_as_float(xw.z & 0xffff0000u), __uint_as_float(xw.w << 16), __uint_as_float(xw.w & 0xffff0000u)};
            const f32x4 ga = *(const f32x4*)(p.norm2 + 32 * ks + 8 * kg), gb = *(const f32x4*)(p.norm2 + 32 * ks + 8 * kg + 4);
            const bf16x8 bh0 = *(const bf16x8*)(RWT + (size_t)l15 * D_MODEL + 32 * ks + 8 * kg), bh1 = *(const bf16x8*)(RWT + (size_t)(16 + l15) * D_MODEL + 32 * ks + 8 * kg);
            const bf16x8 bl0 = *(const bf16x8*)(RWT + (size_t)(NEXP + l15) * D_MODEL + 32 * ks + 8 * kg), bl1 = *(const bf16x8*)(RWT + (size_t)(NEXP + 16 + l15) * D_MODEL + 32 * ks + 8 * kg);
            ss += xa[0] * xa[0] + xa[1] * xa[1] + xa[2] * xa[2] + xa[3] * xa[3] + xb[0] * xb[0] + xb[1] * xb[1] + xb[2] * xb[2] + xb[3] * xb[3];
            u32x2 h8; h8.x = pk4_fp8(xa[0] * ga[0], xa[1] * ga[1], xa[2] * ga[2], xa[3] * ga[3]); h8.y = pk4_fp8(xb[0] * gb[0], xb[1] * gb[1], xb[2] * gb[2], xb[3] * gb[3]);
            *(u32x2*)(hr + 32 * ks) = h8;
            const bf16x8 ah = __builtin_bit_cast(bf16x8, xw);
            acc0 = __builtin_amdgcn_mfma_f32_16x16x32_bf16(ah, bh0, acc0, 0, 0, 0); acc1 = __builtin_amdgcn_mfma_f32_16x16x32_bf16(ah, bh1, acc1, 0, 0, 0);
            acc0 = __builtin_amdgcn_mfma_f32_16x16x32_bf16(ah, bl0, acc0, 0, 0, 0); acc1 = __builtin_amdgcn_mfma_f32_16x16x32_bf16(ah, bl1, acc1, 0, 0, 0);
        }
        ss += __shfl_xor(ss, 16); ss += __shfl_xor(ss, 32);
        const float rstd = rsqrtf(ss * (1.f / D_MODEL) + EPS);
        if (kg == 0) RSTD[tok] = rstd;
        const float rb0 = p.router_b[l15], rb1 = p.router_b[16 + l15];
        float v0[4], v1[4];
#pragma unroll
        for (int r = 0; r < 4; ++r) { const float rs = __shfl(rstd, 4 * kg + r); v0[r] = acc0[r] * rs + rb0; v1[r] = acc1[r] * rs + rb1; }
        float tv[4][4]; int ti[4][4];
#pragma unroll
        for (int k = 0; k < 4; ++k)
#pragma unroll
            for (int r = 0; r < 4; ++r) {
                float bv = v0[r]; int bi = l15; if (v1[r] > bv) { bv = v1[r]; bi = 16 + l15; }
#pragma unroll
                for (int msk = 1; msk < 16; msk <<= 1) { const float ov = __shfl_xor(bv, msk); const int oi = __shfl_xor(bi, msk); if (ov > bv || (ov == bv && oi < bi)) { bv = ov; bi = oi; } }
                tv[k][r] = bv; ti[k][r] = bi; if (bi == l15) v0[r] = -INFINITY; if (bi == 16 + l15) v1[r] = -INFINITY;
            }
        if (l15 == 0) {
#pragma unroll
            for (int r = 0; r < 4; ++r) { const int t = blk * 128 + F.wave * 16 + 4 * kg + r;
                const float e1 = __expf(tv[1][r] - tv[0][r]), e2 = __expf(tv[2][r] - tv[0][r]), e3 = __expf(tv[3][r] - tv[0][r]), inv = 1.f / (1.f + e1 + e2 + e3);
                *(int4*)(TOPI + (size_t)t * 4) = make_int4(ti[0][r], ti[1][r], ti[2][r], ti[3][r]); *(float4*)(GATE + (size_t)t * 4) = make_float4(inv, e1 * inv, e2 * inv, e3 * inv);
                atomicAdd((int*)&hist[ti[0][r]], 1); atomicAdd((int*)&hist[ti[1][r]], 1); atomicAdd((int*)&hist[ti[2][r]], 1); atomicAdd((int*)&hist[ti[3][r]], 1); }
        }
        __syncthreads();
        if (F.tid < NEXP) CNT[blk * NEXP + F.tid] = hist[F.tid];
        __syncthreads();
    }
}
__device__ __forceinline__ void p8_scatter(const Frame& F0, const P& p) { const Frame F = phase_frame(F0);
    LAS int* base = (LAS int*)(F.lds + 0); LAS int* tot = base + 32; LAS int* segs = base + 64; LAS int* spos = base + 128;
    const int tid = F.tid, lane = F.lane;
    const int* CNT = (const int*)(p.ws + OFF_CNT); const int* TOPI = (const int*)(p.ws + OFF_TOPI); const float* GATE = (const float*)(p.ws + OFF_GATE);
    int* POS = (int*)(p.ws + OFF_POS); float* ROWW = (float*)(p.ws + OFF_ROWW); int* TILEE = (int*)(p.ws + OFF_TILEE);
    int* ROWTOK = (int*)(p.ws + OFF_ROWTOK); float* ROWRS = (float*)(p.ws + OFF_ROWRS); const float* RSTD = (const float*)(p.ws + OFF_RSTD);
    for (int wg = F.vcu; wg < RT_WGS; wg += F.G) {
        { LAS int* redb = base + 1024; LAS int* redt = redb + 512;
          const int e = tid & 31, part = tid >> 5; int before = 0, total = 0;
#pragma unroll
          for (int j = 0; j < 16; ++j) { const int w = part * 16 + j; const int c = CNT[w * NEXP + e]; total += c; before += (w < wg) ? c : 0; }
          redb[tid] = before; redt[tid] = total;
          __syncthreads();
          if (tid < NEXP) { int b2 = 0, t2 = 0;
#pragma unroll
              for (int q = 0; q < 16; ++q) { b2 += redb[q * 32 + tid]; t2 += redt[q * 32 + tid]; }
              base[tid] = b2; tot[tid] = t2; } }
        __syncthreads();
        if (tid == 0) { int s = 0; for (int e = 0; e < NEXP; ++e) { segs[e] = s; s += (tot[e] + 255) & ~255; } segs[NEXP] = s; }
        __syncthreads();
        if (wg == 0) {
            for (int e = 0; e < NEXP; ++e) { const int t0 = segs[e] >> 8, t1 = segs[e + 1] >> 8; for (int tt = t0 + tid; tt < t1; tt += NWAVES * 64) TILEE[tt] = e; }
            if (tid == 0) TILEE[NTILES_MAX] = segs[NEXP] >> 8;
        }
        { LAS int* cw = base + 2048;
          const int f = F.wave * 64 + lane, e = TOPI[(size_t)wg * RT_TOK * 4 + f]; int mycnt = 0, within = 0;
          for (int ex = 0; ex < NEXP; ++ex) { const unsigned long long m = __ballot(e == ex); if (lane == ex) mycnt = __popcll(m); if (e == ex) within = __popcll(m & ((1ull << lane) - 1ull)); }
          if (lane < NEXP) cw[F.wave * NEXP + lane] = mycnt;
          __syncthreads();
          int prev = 0;
          for (int w2 = 0; w2 < F.wave; ++w2) prev += cw[w2 * NEXP + e];
          const int pos = segs[e] + base[e] + prev + within;
          POS[(size_t)wg * RT_TOK * 4 + f] = pos; ROWW[pos] = GATE[(size_t)wg * RT_TOK * 4 + f]; ROWTOK[pos] = wg * RT_TOK + (f >> 2); ROWRS[pos] = RSTD[wg * RT_TOK + (f >> 2)]; }
        __syncthreads();
        if (wg < NEXP) { const int r0 = segs[wg] + tot[wg], r1 = segs[wg + 1]; for (int r = r0 + tid; r < r1; r += NWAVES * 64) { ROWTOK[r] = 0; ROWW[r] = 0.f; ROWRS[r] = 0.f; } }
        __syncthreads();
    }
}
__device__ __forceinline__ void p11_combine(const Frame& F0, const P& p) { const Frame F = phase_frame(F0);
    const bf16_t* X1 = (const bf16_t*)(p.ws + OFF_X1B); const unsigned char* YR = p.ws + OFF_YR; const int* POS = (const int*)(p.ws + OFF_POS);
    const int gw = F.vcu * NWAVES + F.wave, NGW = F.G * NWAVES, lane = F.lane;
    for (int t = gw; t < T; t += NGW) {
        const int4 pos = *(const int4*)(POS + (size_t)t * 4); const int pp[4] = {pos.x, pos.y, pos.z, pos.w};
#pragma unroll
        for (int i = 0; i < 2; ++i) {
            const int c = 16 * (lane + 64 * i);
            const u32x4 xa = *(const u32x4*)(X1 + (size_t)t * D_MODEL + c), xb = *(const u32x4*)(X1 + (size_t)t * D_MODEL + c + 8);
            float s16[16];
#pragma unroll
            for (int j = 0; j < 16; ++j) s16[j] = 0.f;
#pragma unroll
            for (int k = 0; k < 4; ++k) { const u32x4 y = *(const u32x4*)(YR + (size_t)pp[k] * D_MODEL + c); const unsigned yw[4] = {y.x, y.y, y.z, y.w};
#pragma unroll
                for (int d = 0; d < 4; ++d) { const auto lo = __builtin_amdgcn_cvt_pk_f32_fp8((int)yw[d], false), hi = __builtin_amdgcn_cvt_pk_f32_fp8((int)yw[d], true);
                    s16[4 * d + 0] += lo[0]; s16[4 * d + 1] += lo[1]; s16[4 * d + 2] += hi[0]; s16[4 * d + 3] += hi[1]; } }
            const unsigned xw[8] = {xa.x, xa.y, xa.z, xa.w, xb.x, xb.y, xb.z, xb.w};
            constexpr float inv = 1.f / YR_SCALE;
#pragma unroll
            for (int q = 0; q < 4; ++q) { f32x4 o;
                o[0] = __uint_as_float(xw[2 * q] << 16) + s16[4 * q + 0] * inv; o[1] = __uint_as_float(xw[2 * q] & 0xffff0000u) + s16[4 * q + 1] * inv;
                o[2] = __uint_as_float(xw[2 * q + 1] << 16) + s16[4 * q + 2] * inv; o[3] = __uint_as_float(xw[2 * q + 1] & 0xffff0000u) + s16[4 * q + 3] * inv;
                *(f32x4*)(p.out + (size_t)t * D_MODEL + c + 4 * q) = o; }
        }
    }
}

__device__ __forceinline__ void p5_quant(const Frame& F0, const P& p) { const Frame F = phase_frame(F0);
    const int gw = F.vcu * NWAVES + F.wave, NGW = F.G * NWAVES, lane = F.lane;
    for (int e = gw; e < 2 * T; e += NGW) { const int br = e & 1, t = e >> 1;
        const bf16_t* src = (const bf16_t*)(p.ws + (br ? OFF_BOUT : OFF_AOUT)) + (size_t)t * WIDTH + 16 * lane;
        const u32x4 a = *(const u32x4*)src, b = *(const u32x4*)(src + 8); const unsigned w[8] = {a.x, a.y, a.z, a.w, b.x, b.y, b.z, b.w};
        float v[16]; float m = 0.f;
#pragma unroll
        for (int j = 0; j < 8; ++j) { v[2 * j] = __uint_as_float(w[j] << 16); v[2 * j + 1] = __uint_as_float(w[j] & 0xffff0000u); m = fmaxf(m, fmaxf(__builtin_fabsf(v[2 * j]), __builtin_fabsf(v[2 * j + 1]))); }
        const float mx = fmaxf(wave_max(m), 1e-30f), inv = 127.f / mx;
        u32x4 o; o.x = pk4_i8(v[0] * inv, v[1] * inv, v[2] * inv, v[3] * inv); o.y = pk4_i8(v[4] * inv, v[5] * inv, v[6] * inv, v[7] * inv); o.z = pk4_i8(v[8] * inv, v[9] * inv, v[10] * inv, v[11] * inv); o.w = pk4_i8(v[12] * inv, v[13] * inv, v[14] * inv, v[15] * inv);
        *(u32x4*)(p.ws + OFF_H8 + (size_t)br * 32 * MiB + (size_t)t * WIDTH + 16 * lane) = o;
        if (lane == 0) ((float*)(p.ws + (br ? OFF_HSC2 : OFF_HSC)))[t] = mx * (1.f / 127.f);
    }
}
__device__ __forceinline__ void p6_quant(const Frame& F0, const P& p) { const Frame F = phase_frame(F0);
    const bf16_t* MRG = (const bf16_t*)(p.ws + OFF_MRG); unsigned char* Q = p.ws + OFF_H8; float* HSC = (float*)(p.ws + OFF_HSC);
    const int gw = F.vcu * NWAVES + F.wave, NGW = F.G * NWAVES, lane = F.lane;
    for (int t = gw; t < T; t += NGW) {
        const bf16_t* src = MRG + (size_t)t * D_MODEL + 32 * lane; u32x4 in[4]; float m = 0.f;
#pragma unroll
        for (int i = 0; i < 4; ++i) { in[i] = *(const u32x4*)(src + 8 * i); const unsigned w[4] = {in[i].x, in[i].y, in[i].z, in[i].w};
#pragma unroll
            for (int j = 0; j < 4; ++j) m = fmaxf(m, fmaxf(__builtin_fabsf(__uint_as_float(w[j] << 16)), __builtin_fabsf(__uint_as_float(w[j] & 0xffff0000u)))); }
        const float mx = fmaxf(wave_max(m), 1e-30f), inv = 127.f / mx;
        u32x4 o[2];
#pragma unroll
        for (int i = 0; i < 4; ++i) { const unsigned w[4] = {in[i].x, in[i].y, in[i].z, in[i].w};
            const unsigned a = pk4_i8(__uint_as_float(w[0] << 16) * inv, __uint_as_float(w[0] & 0xffff0000u) * inv, __uint_as_float(w[1] << 16) * inv, __uint_as_float(w[1] & 0xffff0000u) * inv);
            const unsigned b = pk4_i8(__uint_as_float(w[2] << 16) * inv, __uint_as_float(w[2] & 0xffff0000u) * inv, __uint_as_float(w[3] << 16) * inv, __uint_as_float(w[3] & 0xffff0000u) * inv);
            if (i & 1) { o[i >> 1].z = a; o[i >> 1].w = b; } else { o[i >> 1].x = a; o[i >> 1].y = b; } }
        *(u32x4*)(Q + (size_t)t * D_MODEL + 32 * lane) = o[0]; *(u32x4*)(Q + (size_t)t * D_MODEL + 32 * lane + 16) = o[1];
        if (lane == 0) HSC[t] = mx * (1.f / 127.f);
    }
}
struct Args { P p; int ph_lo, ph_hi, li, pad; };
__global__ void __launch_bounds__(NWAVES * 64, 2) mk_fwd(Args args) {
    extern __shared__ __attribute__((aligned(16))) unsigned char lds_raw[];
    Frame F; F.lds = (LAS unsigned char*)lds_raw; F.MISC = (volatile LAS unsigned*)(F.lds + MISC_OFF);
    F.tid = threadIdx.x; F.lane = F.tid & 63; F.wave = __builtin_amdgcn_readfirstlane(F.tid >> 6);
    F.G = gridDim.x; { const int bx = blockIdx.x; F.vcu = (F.G % 8 == 0) ? (bx % 8) * (F.G / 8) + bx / 8 : bx; }
    const P& p = args.p;
    for (int u = F.tid; u < (LDS_BYTES - MISC_OFF) / 4; u += NWAVES * 64) ((LAS unsigned*)(F.lds + MISC_OFF))[u] = 0u;
    __syncthreads();
    XcdBarrier bar = xcd_barrier_post((unsigned*)(p.ws + WS_CTL) + CW_BAR + args.li * XCD_BAR_WORDS, F.MISC + 8);
    const int lo = args.ph_lo, hi = args.ph_hi;
#ifndef DUP_MASK
#define DUP_MASK 0
#endif
#define DUP(k) ((DUP_MASK >> (k)) & 1)
#define IN(k) (lo <= (k) && (k) < hi)
#define BOTH(k) (IN(k) && IN((k) + 1))
    if (IN(0)) { for (int rep = 0; rep <= DUP(0); ++rep) { p0_quant_weights(F, p); p0_router_prep(F, p); __syncthreads(); p0_rmsnorm(F, p); __syncthreads(); } if (BOTH(0)) xcd_barrier(bar); }
    if (IN(1)) {
        p1_fix_c(F, p);
        { SchedIn<1> S{T / 256, NF8T, F.G, (int)blockIdx.x, (const char*)(p.ws + OFF_H8), (const char*)(p.ws + OFF_WIN8_T), (size_t)256 * D_MODEL, (const float*)(p.ws + OFF_HSC), (const unsigned*)(p.ws + WS_CTL) + CW_CMAX};
          EpiIn1 E{p.ws, p.lb_logits, (LAS float*)(F.lds + MISC_OFF + 4096), p.fq_norm, p.fk_norm};
          pg8::gemm_phase<EpiIn1, SchedIn<1>, true, false, true>(F.lds, D_MODEL / 2, S, E); }
        if (BOTH(1)) xcd_barrier(bar);
    }
    if (IN(2)) { p2_jlo(F, p); p2_hgrn_local(F, p);     if (BOTH(2)) xcd_barrier(bar); }
    if (IN(3)) { for (int rep = 0; rep <= DUP(3); ++rep) p3_hgrn_scan(F, p); if (BOTH(3)) xcd_barrier(bar); }
    if (IN(4)) { if (((blockIdx.x >> 3) & 3) == 3) convert_queue(F, p); p4_hgrn_out(F, p); __syncthreads(); p4_attention(F, p, 0); __syncthreads(); convert_queue(F, p); if (BOTH(4)) xcd_barrier(bar); }
    if (IN(5)) {
        p5_quant(F, p);
        xcd_barrier(bar);
        int kmerge = WIDTH / 2; asm volatile("" : "+s"(kmerge));
        { SchedI8 S{T / 256, D_MODEL / 256, F.G, (int)blockIdx.x, (const char*)(p.ws + OFF_H8), (const char*)(p.ws + OFF_WUPA_T), (size_t)256 * WIDTH, (const float*)(p.ws + OFF_HSC), (const unsigned*)(p.ws + WS_CTL) + CW_CMAXA};
          EpiMergeT<0> E{p.ws}; pg8::gemm_phase<EpiMergeT<0>, SchedI8, true, false, true>(F.lds, kmerge, S, E); }
        { SchedI8 S{T / 256, D_MODEL / 256, F.G, (int)blockIdx.x, (const char*)(p.ws + OFF_H8 + 32 * MiB), (const char*)(p.ws + OFF_WUPB_T), (size_t)256 * WIDTH, (const float*)(p.ws + OFF_HSC2), (const unsigned*)(p.ws + WS_CTL) + CW_CMAXB};
          EpiMergeT<1> E{p.ws}; pg8::gemm_phase<EpiMergeT<1>, SchedI8, true, false, true>(F.lds, kmerge, S, E); }
        if (BOTH(5)) xcd_barrier(bar);
    }
    if (IN(6)) {
        p6_quant(F, p);
        xcd_barrier(bar);
        SchedI8 S{T / 256, D_MODEL / 256, F.G, (int)blockIdx.x, (const char*)(p.ws + OFF_H8), (const char*)(p.ws + OFF_WOUT8_T), (size_t)256 * D_MODEL, (const float*)(p.ws + OFF_HSC), (const unsigned*)(p.ws + WS_CTL) + CW_CMAX2};
        EpiWout1 E{p.x, (bf16_t*)(p.ws + OFF_X1B)};
        for (int rep = 0; rep <= DUP(6); ++rep) pg8::gemm_phase<EpiWout1, SchedI8, true, false, true>(F.lds, D_MODEL / 2, S, E);
        if (BOTH(6)) xcd_barrier(bar);
    }
    if (IN(7)) { for (int rep = 0; rep <= DUP(7); ++rep) p7_router(F, p); if (BOTH(7)) xcd_barrier(bar); }
    if (IN(8)) { for (int rep = 0; rep <= DUP(8); ++rep) p8_scatter(F, p); if (BOTH(8)) xcd_barrier(bar); }
    if (IN(9)) {
        const int nT = load_tile_table(F, p);
        pg8::SchedMoe S{nT, 4096 / 256, F.G, (int)blockIdx.x, (const char*)(p.ws + OFF_H2), (const char*)(p.ws + OFF_WGU_T), (size_t)256 * D_MODEL, (size_t)4096 * D_MODEL, (const LAS int*)(F.lds + TILEE_LDS_OFF), true};
        EpiGU1 E{p.b_gu, p.ws + OFF_ACT, (const float*)(p.ws + OFF_ROWRS)};
        for (int rep = 0; rep <= DUP(9); ++rep) pg8::gemm_phase<EpiGU1, pg8::SchedMoe, true, true>(F.lds, D_MODEL / 2, S, E, (const int*)(p.ws + OFF_ROWTOK));
        if (BOTH(9)) xcd_barrier(bar);
    }
    if (IN(10)) {
        const int nT = load_tile_table(F, p);
        pg8::SchedMoe S{nT, D_MODEL / 256, F.G, (int)blockIdx.x, (const char*)(p.ws + OFF_ACT), (const char*)(p.ws + OFF_WDN_T), (size_t)256 * D_MODEL, (size_t)D_MODEL * D_MODEL, (const LAS int*)(F.lds + TILEE_LDS_OFF), false};
        EpiDown1 E{p.b_down, (const float*)(p.ws + OFF_ROWW), p.ws + OFF_YR};
        for (int rep = 0; rep <= DUP(10); ++rep) pg8::gemm_phase<EpiDown1, pg8::SchedMoe, true>(F.lds, D_MODEL / 2, S, E);
        if (BOTH(10)) xcd_barrier(bar);
    }
    if (IN(11)) { for (int rep = 0; rep <= DUP(11); ++rep) p11_combine(F, p); }
#undef IN
#undef BOTH
}
extern "C" void kernel_launch(void* const* d_in, const int* in_sizes, int n_in, void* d_out, int out_size, void* d_ws, size_t ws_size, hipStream_t stream) {
    static int grid = 0;
    if (grid == 0) {
        if (n_in != 18 || out_size != T * D_MODEL || ws_size < WS_END3) { fprintf(stderr, "kernel_launch: unexpected shapes (n_in %d out %d ws %zu need %zu)\n", n_in, out_size, ws_size, (size_t)WS_END3); grid = -1; return; }
        int dev = 0, cus = 0, per_cu = 0;
        if (hipGetDevice(&dev) != hipSuccess || hipDeviceGetAttribute(&cus, hipDeviceAttributeMultiprocessorCount, dev) != hipSuccess) { grid = -1; return; }
        if (hipFuncSetAttribute((const void*)mk_fwd, hipFuncAttributeMaxDynamicSharedMemorySize, LDS_BYTES) != hipSuccess) { fprintf(stderr, "kernel_launch: hipFuncSetAttribute failed\n"); grid = -1; return; }
        if (hipOccupancyMaxActiveBlocksPerMultiprocessor(&per_cu, (const void*)mk_fwd, NWAVES * 64, LDS_BYTES) != hipSuccess || per_cu < 1) fprintf(stderr, "kernel_launch: occupancy query says %d\n", per_cu);
        (void)hipGetLastError();
        grid = cus;
    }
    if (grid < 0) return;
    P p{};
    p.x = (const float*)d_in[0]; p.lb_logits = (const float*)d_in[1]; p.norm1 = (const float*)d_in[2]; p.w_in = (const float*)d_in[3]; p.hg_norm = (const float*)d_in[4];
    p.fq_norm = (const float*)d_in[5]; p.fk_norm = (const float*)d_in[6]; p.f_bias = (const float*)d_in[7]; p.w_up_hg = (const float*)d_in[8]; p.w_up_fox = (const float*)d_in[9];
    p.w_out = (const float*)d_in[10]; p.norm2 = (const float*)d_in[11]; p.router_w = (const float*)d_in[12]; p.router_b = (const float*)d_in[13]; p.w_gu = (const float*)d_in[14];
    p.b_gu = (const float*)d_in[15]; p.w_down = (const float*)d_in[16]; p.b_down = (const float*)d_in[17]; p.out = (float*)d_out; p.ws = (unsigned char*)d_ws;
    unsigned char* ws = p.ws;
    (void)hipMemsetAsync(ws + WS_CTL, 0, CTL_ZERO_BYTES, stream);
    Args a{}; a.p = p; a.ph_lo = 0; a.ph_hi = 12; a.li = 0; a.pad = 0;
    hipLaunchKernelGGL(mk_fwd, dim3(grid), dim3(NWAVES * 64), LDS_BYTES, stream, a);
}
```

```cpp
#define DUP_MASK 0
#include <hip/hip_runtime.h>
#include <cstdio>
#include <cstdint>

constexpr int D_MODEL = 2048, BATCH = 4, SEQ = 8192, T = BATCH * SEQ;
constexpr int HEADS = 8, HD = 128, WIDTH = 1024;
constexpr int IN_COLS = 11272, NEXP = 32, TOPK = 4, TK = T * TOPK;
constexpr int NROWS_MAX = TK + NEXP * 256;
constexpr int NTILES_MAX = NROWS_MAX / 256;
constexpr float EPS = 1e-6f;
constexpr int RT_TOK = 128, RT_WGS = T / RT_TOK;

typedef unsigned short bf16_t;
__device__ __forceinline__ float bf2f(bf16_t b) { return __uint_as_float(((unsigned)b) << 16); }
__device__ __forceinline__ bf16_t f2bf(float f) { unsigned u = __float_as_uint(f); u += 0x7fffu + ((u >> 16) & 1u); return (bf16_t)(u >> 16); }
__device__ __forceinline__ float wave_sum(float v) {
#pragma unroll
    for (int o = 1; o < 64; o <<= 1) v += __shfl_xor(v, o);
    return v;
}
__device__ __forceinline__ float wave_max(float v) {
#pragma unroll
    for (int o = 1; o < 64; o <<= 1) v = fmaxf(v, __shfl_xor(v, o));
    return v;
}
__device__ __forceinline__ float sigmoidf_(float x) { return 1.f / (1.f + __expf(-x)); }
__device__ __forceinline__ float siluf_(float x) { return x * sigmoidf_(x); }
__device__ __forceinline__ float log_sigmoidf_(float z) { return fminf(z, 0.f) - log1pf(__expf(-fabsf(z))); }

constexpr size_t MiB = 1u << 20;
constexpr size_t WS_CTL = 0;
constexpr size_t WS_SMALL = 1 * MiB;
constexpr size_t OFF_C = WS_SMALL;
constexpr size_t OFF_FL = OFF_C + 1 * MiB;
constexpr size_t OFF_TOPI = OFF_FL + 1 * MiB;
constexpr size_t OFF_GATE = OFF_TOPI + MiB / 2;
constexpr size_t OFF_POS = OFF_GATE + MiB / 2;
constexpr size_t OFF_ROWW = OFF_POS + MiB / 2;
constexpr size_t OFF_CNT = OFF_ROWW + 1 * MiB;
constexpr size_t OFF_TILEE = OFF_CNT + 64 * 1024;
constexpr size_t WS_BIG = 8 * MiB;
constexpr size_t OFF_X1 = WS_BIG;
constexpr size_t OFF_H2 = OFF_X1 + 256 * MiB;
constexpr size_t OFF_YR = OFF_H2 + 128 * MiB;
constexpr size_t OFF_A = OFF_YR + 544 * MiB;
constexpr size_t OFF_H = OFF_A;
constexpr size_t OFF_HQ = OFF_H + 128 * MiB;
constexpr size_t OFF_LOGF = OFF_HQ + 64 * MiB;
constexpr size_t OFF_HV = OFF_LOGF + 64 * MiB;
constexpr size_t OFF_HG = OFF_HV + 64 * MiB;
constexpr size_t OFF_FQ = OFF_HG + 64 * MiB;
constexpr size_t OFF_FK = OFF_FQ + 64 * MiB;
constexpr size_t OFF_FV = OFF_FK + 64 * MiB;
constexpr size_t OFF_GA = OFF_FV + 64 * MiB;
constexpr size_t OFF_GB = OFF_GA + 128 * MiB;
constexpr size_t OFF_AOUT = OFF_GB + 128 * MiB;
constexpr size_t OFF_BOUT = OFF_AOUT + 64 * MiB;
constexpr size_t OFF_MRG = OFF_BOUT + 64 * MiB;
constexpr size_t OFF_A_END = OFF_MRG + 128 * MiB;
constexpr size_t OFF_XS = OFF_A;
constexpr size_t OFF_ACT = OFF_XS + 544 * MiB;
constexpr size_t WS_END = (OFF_A_END > OFF_ACT + 544 * MiB) ? OFF_A_END : OFF_ACT + 544 * MiB;

struct P {
    const float *x, *lb_logits, *norm1, *w_in, *hg_norm, *fq_norm, *fk_norm, *f_bias, *w_up_hg, *w_up_fox, *w_out, *norm2, *router_w, *router_b, *w_gu, *b_gu, *w_down, *b_down;
    float* out; unsigned char* ws;
};

#define LAS __attribute__((address_space(3)))
#define GAS __attribute__((address_space(1)))
typedef short bf16x8 __attribute__((ext_vector_type(8)));
typedef float f32x4 __attribute__((ext_vector_type(4)));
typedef float f32x2 __attribute__((ext_vector_type(2)));
typedef unsigned u32x4 __attribute__((ext_vector_type(4)));
typedef unsigned u32x2 __attribute__((ext_vector_type(2)));
#define LDS_WAIT() asm volatile("s_waitcnt lgkmcnt(0)" ::: "memory")
#define VM_WAIT() asm volatile("s_waitcnt vmcnt(0)" ::: "memory")
__device__ __forceinline__ unsigned cvt_pk_bf16(float lo, float hi) { unsigned r; asm volatile("v_cvt_pk_bf16_f32 %0, %1, %2" : "=v"(r) : "v"(lo), "v"(hi)); return r; }
__device__ __forceinline__ float fast_sigmoid(float x) { return __builtin_amdgcn_rcpf(1.f + __builtin_amdgcn_exp2f(-1.4426950408889634f * x)); }

constexpr size_t OFF_WIN_T = OFF_A_END;
constexpr size_t OFF_WUPA_T = OFF_WIN_T + 44 * MiB;
constexpr size_t OFF_WUPB_T = OFF_WUPA_T + 4 * MiB;
constexpr size_t OFF_WOUT_T = OFF_WUPB_T + 4 * MiB;
constexpr size_t OFF_WGU_T = OFF_WOUT_T + 8 * MiB;
constexpr size_t OFF_WDN_T = OFF_WGU_T + 512 * MiB;
constexpr size_t WS_END2 = OFF_WDN_T + 256 * MiB;
constexpr size_t OFF_SLOC = WS_END2;
constexpr size_t OFF_STATE = OFF_SLOC + 128 * MiB;
constexpr size_t OFF_DEC = OFF_STATE + 128 * MiB;
constexpr size_t OFF_H8 = OFF_DEC + 2 * MiB;
constexpr size_t OFF_WIN8_T = OFF_H8 + 64 * MiB;
constexpr size_t OFF_WOUT8_T = OFF_WIN8_T + 24 * MiB;
constexpr size_t WS_END3 = OFF_WIN8_T + 28 * MiB;
constexpr size_t OFF_BT = OFF_TILEE + 4096;
constexpr size_t OFF_JLO = OFF_BT + 8192 + 4096;
constexpr size_t OFF_RWT = 7 * MiB + 128 * 1024;
constexpr size_t OFF_HSC2 = 7 * MiB + 768 * 1024;
constexpr size_t OFF_HSC = 7 * MiB + 640 * 1024;
constexpr int CW_CMAXA = 51200, CW_CMAXB = 53248;
constexpr int CW_CMAX2 = 49152, CW_RMAX = 65536;
constexpr int CW_CMAX = 32768;
constexpr size_t OFF_RSTD = 7 * MiB + 512 * 1024;
constexpr size_t OFF_ROWRS = 6 * MiB + 576 * 1024;
constexpr size_t OFF_ROWTOK = 6 * MiB;
static_assert(OFF_ROWTOK + (size_t)NROWS_MAX * 4 <= OFF_ROWRS && OFF_ROWRS + (size_t)NROWS_MAX * 4 <= OFF_RWT && OFF_RWT + 2 * NEXP * D_MODEL * 2 <= OFF_RSTD && OFF_RSTD + (size_t)T * 4 <= WS_BIG && OFF_JLO + 4096 <= OFF_ROWTOK, "small-table map");
constexpr size_t OFF_X1B = OFF_H;
constexpr int CW_BAR = 4096;
constexpr size_t CTL_ZERO_BYTES = 512 * 1024;

#define XB_TMO      128
#define XB_XCNT(j)  (256  + 64 * (j))
#define XB_XSUB(j)  (1280 + 64 * (j))
#define XB_XGEN(j)  (2304 + 64 * (j))
#define XB_TOP      3328
#define XB_TOPGEN   3392
#define XCD_BAR_WORDS 3456
#define XB_SPIN_CAP (1u << 18)
__device__ __forceinline__ unsigned xb_ld(unsigned* p)              { return __hip_atomic_load(p, __ATOMIC_RELAXED, __HIP_MEMORY_SCOPE_AGENT); }
__device__ __forceinline__ unsigned xb_add(unsigned* p, unsigned v) { return __hip_atomic_fetch_add(p, v, __ATOMIC_RELAXED, __HIP_MEMORY_SCOPE_AGENT); }
__device__ __forceinline__ unsigned xb_xcc_id() { return (unsigned)__builtin_amdgcn_s_getreg((3 << 11) | 20) & 0xFu; }
#define XB_SPIN(cond, bar) do { unsigned _sp = 0; while (cond) { __builtin_amdgcn_s_sleep(1); \
    if ((++_sp & 255u) == 0u) { if (xb_ld(&(bar)[XB_TMO])) break; if (_sp > XB_SPIN_CAP) { atomicAdd(&(bar)[XB_TMO], 1u); break; } } } } while (0)
struct XcdBarrier { unsigned* bar; unsigned x; volatile LAS unsigned* st; };
__device__ __forceinline__ XcdBarrier xcd_barrier_post(unsigned* bar, volatile LAS unsigned* st) {
    XcdBarrier b; b.bar = bar; b.x = xb_xcc_id(); b.st = st;
    if (threadIdx.x == 0) (void)xb_add(&bar[XB_XCNT(b.x)], 1u);
    return b;
}
__device__ __forceinline__ void xcd_barrier_complete(unsigned* bar, unsigned x, unsigned& nloc, unsigned& nx) {
    const unsigned G = gridDim.x * gridDim.y * gridDim.z;
    unsigned sum, cnt, mine, sp = 0u;
    for (;;) {
        sum = 0u; cnt = 0u; mine = 0u;
#pragma unroll
        for (unsigned j = 0; j < 16; ++j) { const unsigned c = xb_ld(&bar[XB_XCNT(j)]); sum += c; cnt += (c > 0u) ? 1u : 0u; mine = (j == x) ? c : mine; }
        if (sum == G) break;
        __builtin_amdgcn_s_sleep(1);
        if ((++sp & 255u) == 0u) { if (xb_ld(&bar[XB_TMO])) break; if (sp > XB_SPIN_CAP) { atomicAdd(&bar[XB_TMO], 1u); break; } }
    }
    nloc = mine > 0u ? mine : 1u; nx = cnt > 0u ? cnt : 1u;
}
__device__ __forceinline__ void xcd_barrier(const XcdBarrier& b) {
    asm volatile("s_waitcnt vmcnt(0)" ::: "memory");
    __syncthreads();
    if (threadIdx.x == 0) {
        unsigned* bar = b.bar;
        __builtin_amdgcn_s_waitcnt(0);
        unsigned nloc = b.st[0], nx = b.st[1];
        if (nloc == 0u) { xcd_barrier_complete(bar, b.x, nloc, nx); b.st[0] = nloc; b.st[1] = nx; }
        const unsigned old = xb_add(&bar[XB_XSUB(b.x)], 1u);
        const unsigned gen = old / nloc;
        if (old + 1u == (gen + 1u) * nloc) {
            __builtin_amdgcn_fence(__ATOMIC_RELEASE, "agent");
            asm volatile("s_waitcnt vmcnt(0)" ::: "memory");
            const unsigned og = xb_add(&bar[XB_TOP], 1u);
            const unsigned tg = og / nx;
            if (og + 1u == (tg + 1u) * nx) xb_add(&bar[XB_TOPGEN], 1u);
            else XB_SPIN(xb_ld(&bar[XB_TOPGEN]) == tg, bar);
            __builtin_amdgcn_fence(__ATOMIC_ACQUIRE, "agent");
            xb_add(&bar[XB_XGEN(b.x)], 1u);
            asm volatile("s_waitcnt vmcnt(0)" ::: "memory");
        } else {
            XB_SPIN(xb_ld(&bar[XB_XGEN(b.x)]) == gen, bar);
            __builtin_amdgcn_fence(__ATOMIC_ACQUIRE, "agent");
            asm volatile("s_waitcnt vmcnt(0)" ::: "memory");
        }
    }
    __syncthreads();
}

namespace pg8 {
constexpr int BM = 256, BK = 64, HALF = 128, HTB = HALF * BK * 2, STAGE_BYTES = 8 * HTB, NXCD = 8, WGM = 8, SC_OFF = 131072 + 12288;
__host__ __device__ __forceinline__ int lds_byte(int r, int c) { const int st = (r >> 4) * 2 + (c >> 5), rr = r & 15, cc = c & 31, ob = rr * 64 + cc * 2; return st * 1024 + (ob ^ (((ob >> 9) & 1) << 5)); }
__host__ __device__ __forceinline__ void stage_rc(int b, int& R, int& C) { const int st = b / 1024, sb = b % 1024, swz = sb ^ (((sb >> 9) & 1) << 5); R = (st >> 1) * 16 + swz / 64; C = (st & 1) * 32 + (swz % 64) / 2; }
__host__ __device__ __forceinline__ int perm32(int rho) { const int n = rho >> 4, i = rho & 15; return 8 * (i >> 2) + 4 * n + (i & 3); }
struct Unit { int pm, pn, e, h; };
__device__ __forceinline__ void tile_map(int wgid, int nM, int nN, int& pm, int& pn) {
    const int nwg = nM * nN; { const int q = nwg / NXCD, r = nwg % NXCD, xcd = wgid % NXCD, off = wgid / NXCD; wgid = (xcd < r ? xcd * (q + 1) : r * (q + 1) + (xcd - r) * q) + off; }
    const int nig = WGM * nN, gid = wgid / nig, fm = gid * WGM, gsz = (nM - fm) < WGM ? (nM - fm) : WGM;
    pm = fm + ((wgid % nig) % gsz); pn = (wgid % nig) / gsz;
}
typedef int i32x8 __attribute__((ext_vector_type(8)));
typedef int i32x4 __attribute__((ext_vector_type(4)));
template <class Epi, class Sched, bool FP8 = false, bool GATHER = false, bool I8 = false>
__device__ __forceinline__ void gemm_phase(LAS unsigned char* lds, const int K, const Sched& S, const Epi& E, const int* rowtok = nullptr) {
    int tid = threadIdx.x; asm volatile("" : "+v"(tid));
    const int wid = __builtin_amdgcn_readfirstlane(tid >> 6), lane = tid & 63, wr = wid >> 2, wc = wid & 3, fr = lane & 15, fq = lane >> 4;
    const int nt = K / BK;
    unsigned voffA[2], voffB[2];
#pragma unroll
    for (int i = 0; i < 2; ++i) { int R, C; stage_rc(tid * 16 + i * 8192, R, C); const int Rb = Epi::PERM ? ((R & ~31) + perm32(R & 31)) : R;
        voffA[i] = (unsigned)(R * K + C) * 2u; voffB[i] = (unsigned)(Rb * K + C) * 2u; }
    const size_t kstep = (size_t)(BK * 2);
    const size_t hstep = (size_t)HALF * K * 2;
    const unsigned ldsw = (unsigned)wid * 1024u;
    const int aoff = lds_byte(wr * 64 + fr, fq * 8), boff = lds_byte(wc * 32 + fr, fq * 8);
#define PG8_SA(b, h) (((b) * 2 + (h)) * HTB)
#define PG8_SB(b, h) ((4 + (b) * 2 + (h)) * HTB)
#define PG8_STAGE(bufoff, gbase, voff) do { _Pragma("unroll") for (int _i = 0; _i < 2; ++_i) \
        __builtin_amdgcn_global_load_lds((const unsigned*)((const char*)(gbase) + (voff)[_i]), (LAS unsigned*)(lds + (bufoff) + ldsw + _i * 8192), 16, 0, 0); } while (0)
#define PG8_LDA(dst, b, h) do { _Pragma("unroll") for (int m = 0; m < 4; ++m) { const i32x4 _x = *(const LAS i32x4*)(lds + PG8_SA(b, h) + aoff + m * 2048), _y = *(const LAS i32x4*)(lds + PG8_SA(b, h) + aoff + m * 2048 + 1024); \
        dst[m] = __builtin_shufflevector(_x, _y, 0, 1, 2, 3, 4, 5, 6, 7); } } while (0)
#define PG8_LDB(dst, b, h) do { _Pragma("unroll") for (int n = 0; n < 2; ++n) { const i32x4 _x = *(const LAS i32x4*)(lds + PG8_SB(b, h) + boff + n * 2048), _y = *(const LAS i32x4*)(lds + PG8_SB(b, h) + boff + n * 2048 + 1024); \
        dst[n] = __builtin_shufflevector(_x, _y, 0, 1, 2, 3, 4, 5, 6, 7); } } while (0)
#define PG8_LO(v) __builtin_bit_cast(bf16x8, __builtin_shufflevector(v, v, 0, 1, 2, 3))
#define PG8_HI(v) __builtin_bit_cast(bf16x8, __builtin_shufflevector(v, v, 4, 5, 6, 7))
#define PG8_MMA(ai, bj, At, Bt) do { __builtin_amdgcn_s_setprio(1); if constexpr (I8) { _Pragma("unroll") for (int m = 0; m < 4; ++m) _Pragma("unroll") for (int n = 0; n < 2; ++n) { \
        i32x4 _c = __builtin_bit_cast(i32x4, acc[ai][bj][m][n]); \
        _c = __builtin_amdgcn_mfma_i32_16x16x64_i8(__builtin_shufflevector(Bt[n], Bt[n], 0, 1, 2, 3), __builtin_shufflevector(At[m], At[m], 0, 1, 2, 3), _c, 0, 0, 0); \
        _c = __builtin_amdgcn_mfma_i32_16x16x64_i8(__builtin_shufflevector(Bt[n], Bt[n], 4, 5, 6, 7), __builtin_shufflevector(At[m], At[m], 4, 5, 6, 7), _c, 0, 0, 0); \
        acc[ai][bj][m][n] = __builtin_bit_cast(f32x4, _c); } } else if constexpr (FP8) { _Pragma("unroll") for (int m = 0; m < 4; ++m) _Pragma("unroll") for (int n = 0; n < 2; ++n) \
        asm volatile("v_mfma_scale_f32_16x16x128_f8f6f4 %0, %1, %2, %0, %3, %4 op_sel_hi:[0,0,0]" : "+v"(acc[ai][bj][m][n]) : "v"(Bt[n]), "v"(At[m]), "v"(sc_w), "v"(sc_a)); } else { \
        _Pragma("unroll") for (int m = 0; m < 4; ++m) _Pragma("unroll") for (int n = 0; n < 2; ++n) { \
        acc[ai][bj][m][n] = __builtin_amdgcn_mfma_f32_16x16x32_bf16(PG8_LO(Bt[n]), PG8_LO(At[m]), acc[ai][bj][m][n], 0, 0, 0); \
        acc[ai][bj][m][n] = __builtin_amdgcn_mfma_f32_16x16x32_bf16(PG8_HI(Bt[n]), PG8_HI(At[m]), acc[ai][bj][m][n], 0, 0, 0); } } __builtin_amdgcn_s_setprio(0); } while (0)
#define PG8_WAIT_V(n) asm volatile("s_waitcnt vmcnt(" #n ")" ::: "memory")
#define PG8_WAIT_L(n) asm volatile("s_waitcnt lgkmcnt(" #n ")" ::: "memory")
#define PG8_BAR __builtin_amdgcn_s_barrier()
#define PG8_SCHED __builtin_amdgcn_sched_barrier(0)
    Unit cur, nxt; int ui = 0;
    if (!S.next(0, cur)) return;
    unsigned gA[2][2], gN[2][2], arow[2];
    if constexpr (GATHER) {
#pragma unroll
        for (int i = 0; i < 2; ++i) { int R, C; stage_rc(tid * 16 + i * 8192, R, C); arow[i] = (unsigned)R; voffA[i] = (unsigned)C * 2u; }
#pragma unroll
        for (int h = 0; h < 2; ++h)
#pragma unroll
            for (int i = 0; i < 2; ++i) gA[h][i] = (unsigned)rowtok[cur.pm * 256 + h * 128 + (int)arow[i]] * (unsigned)(K * 2) + voffA[i];
    }
#define PG8_STAGE_A(bufoff, gbase, h, last_) do { if constexpr (GATHER) { if (last_) { _Pragma("unroll") for (int _i = 0; _i < 2; ++_i) \
        __builtin_amdgcn_global_load_lds((const unsigned*)((const char*)(gbase) + gN[h][_i]), (LAS unsigned*)(lds + (bufoff) + ldsw + _i * 8192), 16, 0, 0); } else { _Pragma("unroll") for (int _i = 0; _i < 2; ++_i) \
        __builtin_amdgcn_global_load_lds((const unsigned*)((const char*)(gbase) + gA[h][_i]), (LAS unsigned*)(lds + (bufoff) + ldsw + _i * 8192), 16, 0, 0); } } \
        else { PG8_STAGE(bufoff, (const char*)(gbase) + (h) * hstep, voffA); } } while (0)
    f32x4 acc[2][2][4][2];
#pragma unroll
    for (int a = 0; a < 2; ++a)
#pragma unroll
        for (int b = 0; b < 2; ++b)
#pragma unroll
            for (int m = 0; m < 4; ++m)
#pragma unroll
                for (int n = 0; n < 2; ++n) acc[a][b][m][n] = (f32x4){0.f, 0.f, 0.f, 0.f};
    i32x8 At[4], B0[2], B1[2];
    int sc_w = 121, sc_a = 127; asm volatile("" : "+v"(sc_w), "+v"(sc_a));
    const char* cA = S.aptr(cur); const char* cB = S.bptr(cur);
    PG8_STAGE(PG8_SB(0, 0), cB, voffB); PG8_STAGE(PG8_SB(0, 1), cB + hstep, voffB); PG8_STAGE_A(PG8_SA(0, 0), cA, 0, false); PG8_STAGE_A(PG8_SA(0, 1), cA, 1, false);
    if (wr == 1) PG8_BAR;
    PG8_WAIT_V(2); PG8_BAR;
    PG8_STAGE(PG8_SB(1, 0), cB + kstep, voffB); PG8_STAGE_A(PG8_SA(1, 0), cA + kstep, 0, false); PG8_STAGE(PG8_SB(1, 1), cB + hstep + kstep, voffB);
    PG8_WAIT_V(6); PG8_BAR;
    for (;;) {
        const bool has_next = S.next(ui + 1, nxt);
        if constexpr (I8) {
            const int el = wid * 64 + lane; const void* gsrc;
            if (wid < 4) gsrc = (const void*)(S.rowscale(cur) + cur.pm * 256 + el); else gsrc = (const void*)(S.colmax(cur) + S.ccol(cur.e * 256 + el - 256));
            __builtin_amdgcn_global_load_lds((const unsigned*)gsrc, (LAS unsigned*)(lds + SC_OFF + (ui & 1) * 2048 + wid * 256), 4, 0, 0);
        }
        const char* nA = has_next ? S.aptr(nxt) : cA; const char* nB = has_next ? S.bptr(nxt) : cB;
        if constexpr (GATHER) { const int pmn = has_next ? nxt.pm : cur.pm;
#pragma unroll
            for (int h = 0; h < 2; ++h)
#pragma unroll
                for (int i = 0; i < 2; ++i) gN[h][i] = (unsigned)rowtok[pmn * 256 + h * 128 + (int)arow[i]] * (unsigned)(K * 2) + voffA[i]; }
        for (int t = 0; t < nt; t += 2) {
            const bool last = (t == nt - 2);
            const char* a1 = cA + (size_t)(t + 1) * kstep;
            const char* a2 = last ? nA : cA + (size_t)(t + 2) * kstep; const char* b2 = last ? nB : cB + (size_t)(t + 2) * kstep;
            const char* a3 = a2 + kstep; const char* b3 = b2 + kstep;
            PG8_LDB(B0, 0, 0); PG8_LDB(B1, 0, 1); PG8_SCHED; PG8_LDA(At, 0, 0); PG8_STAGE_A(PG8_SA(1, 1), a1, 1, false);
            PG8_WAIT_V(8); PG8_WAIT_L(0); PG8_BAR; PG8_MMA(0, 0, At, B0); PG8_MMA(0, 1, At, B1); PG8_BAR; PG8_SCHED;
            PG8_LDA(At, 0, 1); PG8_STAGE(PG8_SB(0, 0), b2, voffB); PG8_STAGE(PG8_SB(0, 1), b2 + hstep, voffB); PG8_STAGE_A(PG8_SA(0, 0), a2, 0, last);
            PG8_WAIT_V(8); PG8_WAIT_L(0); PG8_BAR; PG8_MMA(1, 0, At, B0); PG8_MMA(1, 1, At, B1); PG8_BAR; PG8_SCHED;
            PG8_LDB(B0, 1, 0); PG8_LDB(B1, 1, 1); PG8_SCHED; PG8_LDA(At, 1, 0); PG8_STAGE_A(PG8_SA(0, 1), a2, 1, last);
            PG8_WAIT_V(8); PG8_WAIT_L(0); PG8_BAR; PG8_MMA(0, 0, At, B0); PG8_MMA(0, 1, At, B1); PG8_BAR; PG8_SCHED;
            PG8_LDA(At, 1, 1); PG8_STAGE(PG8_SB(1, 0), b3, voffB); PG8_STAGE(PG8_SB(1, 1), b3 + hstep, voffB); PG8_STAGE_A(PG8_SA(1, 0), a3, 0, last);
            PG8_WAIT_V(8); PG8_WAIT_L(0); PG8_BAR; PG8_MMA(1, 0, At, B0); PG8_MMA(1, 1, At, B1); PG8_BAR; PG8_SCHED;
        }
        if (wr == 0) PG8_BAR;
        if constexpr (FP8 && !I8) asm volatile("s_nop 15\n\ts_nop 15" ::: "memory");
        if constexpr (I8) {
            const LAS float* rsp = (const LAS float*)(lds + SC_OFF + (ui & 1) * 2048) + wr * 64 + fr; const LAS float* csb = rsp - (wr * 64 + fr) + 256 + wc * 32 + 8 * fq;
            f32x4 cs[2][2];
#pragma unroll
            for (int bj = 0; bj < 2; ++bj)
#pragma unroll
                for (int n = 0; n < 2; ++n) cs[bj][n] = *(const LAS f32x4*)(csb + bj * 128 + 4 * n) * (1.f / 127.f);
#pragma unroll
            for (int ai = 0; ai < 2; ++ai)
#pragma unroll
                for (int m = 0; m < 4; ++m) { const float r = rsp[ai * 128 + m * 16];
#pragma unroll
                    for (int bj = 0; bj < 2; ++bj)
#pragma unroll
                        for (int n = 0; n < 2; ++n) { const i32x4 ci = __builtin_bit_cast(i32x4, acc[ai][bj][m][n]);
                            acc[ai][bj][m][n] = (f32x4){(float)ci[0], (float)ci[1], (float)ci[2], (float)ci[3]} * (cs[bj][n] * r); } }
        }
        E(acc, cur, wr, wc, fr, fq);
#ifdef EPI_DUP
        E(acc, cur, wr, wc, fr, fq);
#endif
        if (!has_next) break;
#pragma unroll
        for (int a = 0; a < 2; ++a)
#pragma unroll
            for (int b = 0; b < 2; ++b)
#pragma unroll
                for (int m = 0; m < 4; ++m)
#pragma unroll
                    for (int n = 0; n < 2; ++n) acc[a][b][m][n] = (f32x4){0.f, 0.f, 0.f, 0.f};
        cur = nxt; cA = nA; cB = nB; ++ui;
        if constexpr (GATHER) { gA[0][0] = gN[0][0]; gA[0][1] = gN[0][1]; gA[1][0] = gN[1][0]; gA[1][1] = gN[1][1]; }
        if (wr == 1) PG8_BAR;
    }
    PG8_WAIT_V(0);
    PG8_BAR;
#undef PG8_SA
#undef PG8_SB
#undef PG8_STAGE
#undef PG8_STAGE_A
#undef PG8_LDA
#undef PG8_LDB
#undef PG8_LO
#undef PG8_HI
#undef PG8_MMA
#undef PG8_WAIT_V
#undef PG8_WAIT_L
#undef PG8_BAR
#undef PG8_SCHED
}
struct SchedDense {
    int nM, nN, G, c; const char* A; const char* Bt; size_t tstep;
    __device__ __forceinline__ bool next(int i, Unit& u) const { const long L = (long)i * G + c; if (L >= (long)nM * nN) return false; tile_map((int)L, nM, nN, u.pm, u.pn); u.e = 0; u.h = 0; return true; }
    __device__ __forceinline__ const char* aptr(const Unit& u) const { return A + (size_t)u.pm * tstep; }
    __device__ __forceinline__ const char* bptr(const Unit& u) const { return Bt + (size_t)u.pn * tstep; }
};
struct SchedMerge {
    int nM, nN, G, c; const char *A0, *A1, *B0, *B1; size_t tstep;
    __device__ __forceinline__ bool next(int i, Unit& u) const { const long L = (long)(i >> 1) * G + c; if (L >= (long)nM * nN) return false; tile_map((int)L, nM, nN, u.pm, u.pn); u.e = 0; u.h = i & 1; return true; }
    __device__ __forceinline__ const char* aptr(const Unit& u) const { return (u.h ? A1 : A0) + (size_t)u.pm * tstep; }
    __device__ __forceinline__ const char* bptr(const Unit& u) const { return (u.h ? B1 : B0) + (size_t)u.pn * tstep; }
};
struct SchedMoe {
    int nM, nN, G, c; const char* A; const char* Bt; size_t tstep, estride; const LAS int* tilee; bool gather;
    __device__ __forceinline__ bool next(int i, Unit& u) const { const long L = (long)i * G + c; if (L >= (long)nM * nN) return false; tile_map((int)L, nM, nN, u.pm, u.pn); u.e = __builtin_amdgcn_readfirstlane(tilee[u.pm]); u.h = 0; return true; }
    __device__ __forceinline__ const char* aptr(const Unit& u) const { return gather ? A : A + (size_t)u.pm * tstep; }
    __device__ __forceinline__ const char* bptr(const Unit& u) const { return Bt + (size_t)u.e * estride + (size_t)u.pn * tstep; }
};
}

constexpr int NWAVES = 8;
constexpr int RING_BYTES = 131072, MISC_OFF = RING_BYTES, LDS_BYTES = 147456;
struct Frame { LAS unsigned char* lds; volatile LAS unsigned* MISC; int tid, lane, wave, vcu, G; };
__device__ __forceinline__ Frame phase_frame(const Frame& F0) { Frame F = F0; int t = threadIdx.x; asm volatile("" : "+v"(t)); F.tid = t; F.lane = t & 63; F.wave = __builtin_amdgcn_readfirstlane(t >> 6); return F; }

struct MapId { __device__ __forceinline__ int operator()(int c) const { return c; } };
struct MapWin { __device__ __forceinline__ int operator()(int c) const { return c < 7168 ? c : (c < 7176 ? -1 : c - 8); } };
#ifndef FP8_GROUPS
#define FP8_GROUPS 0x7fu
#endif
__host__ __device__ constexpr int fp8_rank(int g) { int r = 0; for (int i = 0; i < g; ++i) r += (FP8_GROUPS >> i) & 1; return r; }
constexpr int N8G = fp8_rank(7), NB16T = 4 * (7 - N8G), NF8T = 4 * N8G + 16;
template <int SEL> __device__ __forceinline__ int in_tile_of(int l) { int cnt = 0, out = SEL ? 28 + (l - 4 * N8G) : 0;
#pragma unroll
    for (int g = 0; g < 7; ++g) if ((int)((FP8_GROUPS >> g) & 1u) == SEL) { if (l >= 4 * cnt && l < 4 * cnt + 4) out = 4 * g + (l - 4 * cnt); ++cnt; }
    return out; }
struct SchedI8 {
    int nM, nN, G, c; const char* A; const char* Bt; size_t tstep; const float* rs; const unsigned* cs;
    __device__ __forceinline__ bool next(int i, pg8::Unit& u) const { const long L = (long)i * G + c; if (L >= (long)nM * nN) return false; pg8::tile_map((int)L, nM, nN, u.pm, u.pn); u.e = u.pn; u.h = 0; return true; }
    __device__ __forceinline__ const char* aptr(const pg8::Unit& u) const { return A + (size_t)u.pm * tstep; }
    __device__ __forceinline__ const char* bptr(const pg8::Unit& u) const { return Bt + (size_t)u.pn * tstep; }
    __device__ __forceinline__ int ccol(int c0) const { return c0; }
    __device__ __forceinline__ const float* rowscale(const pg8::Unit&) const { return rs; }
    __device__ __forceinline__ const unsigned* colmax(const pg8::Unit&) const { return cs; }
};
template <int SEL> struct SchedIn {
    int nM, nN, G, c; const char* A; const char* Bt; size_t tstep; const float* rs; const unsigned* cs;
    __device__ __forceinline__ bool next(int i, pg8::Unit& u) const { const long L = (long)i * G + c; if (L >= (long)nM * nN) return false; pg8::tile_map((int)L, nM, nN, u.pm, u.pn); u.e = in_tile_of<SEL>(u.pn); u.h = 0; return true; }
    __device__ __forceinline__ const char* aptr(const pg8::Unit& u) const { return A + (size_t)u.pm * tstep; }
    __device__ __forceinline__ const char* bptr(const pg8::Unit& u) const { return Bt + (size_t)(SEL ? u.pn : u.e) * tstep; }
    __device__ __forceinline__ int ccol(int c0) const { return c0 < 7168 ? c0 : c0 + 8; }
    __device__ __forceinline__ const float* rowscale(const pg8::Unit&) const { return rs; }
    __device__ __forceinline__ const unsigned* colmax(const pg8::Unit&) const { return cs; }
};
struct MapWinG { __device__ __forceinline__ int operator()(int c) const { if (c >= 7176) return c - 7176 + 1024 * N8G; if (c >= 7168) return -1; const int g = c >> 10; int r = 0;
#pragma unroll
        for (int i = 0; i < 7; ++i) r += (i < g) ? (int)((FP8_GROUPS >> i) & 1u) : 0;
        return ((FP8_GROUPS >> g) & 1u) ? r * 1024 + (c & 1023) : -1; } };
struct MapGu { __device__ __forceinline__ int operator()(int c) const { const int bj = c >> 11, j = c & 2047; return ((j >> 7) << 8) + (bj << 7) + (j & 127); } };
__device__ __forceinline__ unsigned pk4_fp8(float a, float b, float c, float d) { int r = __builtin_amdgcn_cvt_pk_fp8_f32(a, b, 0, false); r = __builtin_amdgcn_cvt_pk_fp8_f32(c, d, r, true); return (unsigned)r; }
constexpr float W8_SCALE = 64.f;
__device__ __forceinline__ unsigned pk4_i8(float a, float b, float c, float d) { const int q0 = (int)__builtin_rintf(__builtin_amdgcn_fmed3f(a, -127.f, 127.f)), q1 = (int)__builtin_rintf(__builtin_amdgcn_fmed3f(b, -127.f, 127.f)), q2 = (int)__builtin_rintf(__builtin_amdgcn_fmed3f(c, -127.f, 127.f)), q3 = (int)__builtin_rintf(__builtin_amdgcn_fmed3f(d, -127.f, 127.f)); return (unsigned)(q0 & 255) | ((unsigned)(q1 & 255) << 8) | ((unsigned)(q2 & 255) << 16) | ((unsigned)q3 << 24); }
template <class Map, bool Q8 = false, bool I8 = false>
__device__ __forceinline__ void p0_transpose_item(const float* W, int K, int N, void* WTv, LAS float* scr, int item, int lane, Map map, const unsigned* cmax = nullptr) {
    const int nblk = (N + 31) / 32, kb = item / nblk, nb = item % nblk, k0 = 64 * kb, n0 = 32 * nb;
    const int col = n0 + (lane & 31); const bool okc = col < N;
    float v[32];
#pragma unroll
    for (int i = 0; i < 32; ++i) { const int kk = 2 * i + (lane >> 5); v[i] = okc ? W[(size_t)(k0 + kk) * N + col] : 0.f; }
#pragma unroll
    for (int i = 0; i < 32; ++i) { const int kk = 2 * i + (lane >> 5); scr[kk * 33 + (lane & 31)] = v[i]; }
    LDS_WAIT(); asm volatile("" ::: "memory");
    const int c = lane & 7;
#pragma unroll
    for (int j = 0; j < 4; ++j) { const int n = (lane >> 3) + 8 * j; const LAS float* s = scr + (8 * c) * 33 + n;
        const int dr = (n0 + n < N) ? map(n0 + n) : -1;
        if constexpr (Q8) { u32x2 o;
            if constexpr (I8) { const float inv = 127.f / fmaxf(__uint_as_float(cmax[(n0 + n < N) ? n0 + n : 0]), 1e-30f);
                o.x = pk4_i8(s[0 * 33] * inv, s[1 * 33] * inv, s[2 * 33] * inv, s[3 * 33] * inv); o.y = pk4_i8(s[4 * 33] * inv, s[5 * 33] * inv, s[6 * 33] * inv, s[7 * 33] * inv); }
            else { o.x = pk4_fp8(s[0 * 33] * W8_SCALE, s[1 * 33] * W8_SCALE, s[2 * 33] * W8_SCALE, s[3 * 33] * W8_SCALE); o.y = pk4_fp8(s[4 * 33] * W8_SCALE, s[5 * 33] * W8_SCALE, s[6 * 33] * W8_SCALE, s[7 * 33] * W8_SCALE); }
            if (dr >= 0) *(u32x2*)((unsigned char*)WTv + (size_t)dr * K + k0 + 8 * c) = o; }
        else { u32x4 o; o.x = cvt_pk_bf16(s[0 * 33], s[1 * 33]); o.y = cvt_pk_bf16(s[2 * 33], s[3 * 33]); o.z = cvt_pk_bf16(s[4 * 33], s[5 * 33]); o.w = cvt_pk_bf16(s[6 * 33], s[7 * 33]);
            if (dr >= 0) *(u32x4*)((bf16_t*)WTv + (size_t)dr * K + k0 + 8 * c) = o; } }
    LDS_WAIT(); asm volatile("" ::: "memory");
}
template <class Map>
__device__ __forceinline__ void p0_fp8_load(float (&v)[64], const float* W, int N, int item, int lane) {
    const int nblk = N / 32, kb = item / nblk, nb = item % nblk, k0 = 128 * kb + 64 * (lane >> 5), col = 32 * nb + (lane & 31);
    const float* src = W + (size_t)k0 * N + col;
#pragma unroll
    for (int i = 0; i < 64; ++i) v[i] = __builtin_nontemporal_load(src + (size_t)i * N);
}
template <class Map>
__device__ __forceinline__ void p0_fp8_finish(const float (&v)[64], int K, int N, unsigned char* WT, int item, int lane, Map map) {
    const int nblk = N / 32, kb = item / nblk, nb = item % nblk, k0 = 128 * kb + 64 * (lane >> 5), col = 32 * nb + (lane & 31);
    u32x4 o[4];
#pragma unroll
    for (int q = 0; q < 4; ++q) {
        o[q].x = pk4_fp8(v[16 * q + 0] * W8_SCALE, v[16 * q + 1] * W8_SCALE, v[16 * q + 2] * W8_SCALE, v[16 * q + 3] * W8_SCALE);
        o[q].y = pk4_fp8(v[16 * q + 4] * W8_SCALE, v[16 * q + 5] * W8_SCALE, v[16 * q + 6] * W8_SCALE, v[16 * q + 7] * W8_SCALE);
        o[q].z = pk4_fp8(v[16 * q + 8] * W8_SCALE, v[16 * q + 9] * W8_SCALE, v[16 * q + 10] * W8_SCALE, v[16 * q + 11] * W8_SCALE);
        o[q].w = pk4_fp8(v[16 * q + 12] * W8_SCALE, v[16 * q + 13] * W8_SCALE, v[16 * q + 14] * W8_SCALE, v[16 * q + 15] * W8_SCALE); }
#define XCHG(pa, pb, bit, msk) do { const bool b_ = (lane & (bit)) != 0; u32x4 s_ = b_ ? o[pa] : o[pb]; \
        s_.x = (unsigned)__shfl_xor((int)s_.x, msk); s_.y = (unsigned)__shfl_xor((int)s_.y, msk); s_.z = (unsigned)__shfl_xor((int)s_.z, msk); s_.w = (unsigned)__shfl_xor((int)s_.w, msk); \
        if (b_) o[pa] = s_; else o[pb] = s_; } while (0)
    XCHG(0, 1, 1, 1); XCHG(2, 3, 1, 1); XCHG(0, 2, 2, 2); XCHG(1, 3, 2, 2);
#undef XCHG
    const int j = lane & 3, colb = col - j;
#pragma unroll
    for (int q = 0; q < 4; ++q) *(u32x4*)(WT + (size_t)map(colb + q) * K + k0 + 16 * j) = o[q];
}
constexpr int CW_QH = 128, CW_QC = 192;
__device__ __forceinline__ void p0_weights(const Frame& F0, const P& p) { const Frame F = phase_frame(F0);
    LAS float* scr = (LAS float*)(F.lds + F.wave * 8448);
    const int gw = F.vcu * NWAVES + F.wave, NGW = F.G * NWAVES;
    constexpr int I_IN = (2048 / 64) * ((IN_COLS + 31) / 32), I_UP = (1024 / 64) * (2048 / 32), NB16 = I_IN + 2 * I_UP;
    unsigned char* ws = p.ws;
    (void)scr; (void)gw; (void)NGW; (void)ws; (void)NB16;
}
template <int NCOLS, int KROWS = 2048> __device__ __forceinline__ void p0_colmax_t(const Frame& F0, const float* W, unsigned* CMAX) { const Frame F = phase_frame(F0);
    const int gw = F.vcu * NWAVES + F.wave, NGW = F.G * NWAVES, lane = F.lane;
    constexpr int NBLK = (NCOLS + 31) / 32, I_IN = (KROWS / 64) * NBLK;
    for (int it = gw; it < I_IN; it += NGW) { const int kb = it / NBLK, nb = it % NBLK, k0 = 64 * kb, col = 32 * nb + (lane & 31); const bool okc = col < NCOLS;
        float m = 0.f;
#pragma unroll
        for (int i = 0; i < 32; ++i) { const int kk = 2 * i + (lane >> 5); m = fmaxf(m, __builtin_fabsf(okc ? W[(size_t)(k0 + kk) * NCOLS + col] : 0.f)); }
        m = fmaxf(m, __shfl_xor(m, 32));
        if (lane < 32 && okc) atomicMax(CMAX + col, __float_as_uint(m)); }
}
__device__ __forceinline__ void p0_colmax(const Frame& F0, const P& p) { p0_colmax_t<IN_COLS>(F0, p.w_in, (unsigned*)(p.ws + WS_CTL) + CW_CMAX); p0_colmax_t<2048>(F0, p.w_out, (unsigned*)(p.ws + WS_CTL) + CW_CMAX2);
    p0_colmax_t<2048, 1024>(F0, p.w_up_hg, (unsigned*)(p.ws + WS_CTL) + CW_CMAXA); p0_colmax_t<2048, 1024>(F0, p.w_up_fox, (unsigned*)(p.ws + WS_CTL) + CW_CMAXB); }
__device__ __forceinline__ void p0_win_i8(const Frame& F0, const P& p) { const Frame F = phase_frame(F0);
    LAS float* scr = (LAS float*)(F.lds + F.wave * 8448);
    const unsigned* CMAX = (const unsigned*)(p.ws + WS_CTL) + CW_CMAX;
    const int gw = F.vcu * NWAVES + F.wave, NGW = F.G * NWAVES;
    constexpr int I_IN = (2048 / 64) * ((IN_COLS + 31) / 32);
    for (int it = gw; it < I_IN; it += NGW) p0_transpose_item<MapWinG, true, true>(p.w_in, 2048, IN_COLS, p.ws + OFF_WIN8_T, scr, it, F.lane, MapWinG{}, CMAX);
    constexpr int I_OUT = (2048 / 64) * (2048 / 32);
    for (int it = gw; it < I_OUT; it += NGW) p0_transpose_item<MapId, true, true>(p.w_out, 2048, 2048, p.ws + OFF_WOUT8_T, scr, it, F.lane, MapId{}, (const unsigned*)(p.ws + WS_CTL) + CW_CMAX2);
    constexpr int I_UP = (1024 / 64) * (2048 / 32);
    for (int it = gw; it < I_UP; it += NGW) { p0_transpose_item<MapId, true, true>(p.w_up_hg, 1024, 2048, p.ws + OFF_WUPA_T, scr, it, F.lane, MapId{}, (const unsigned*)(p.ws + WS_CTL) + CW_CMAXA);
        p0_transpose_item<MapId, true, true>(p.w_up_fox, 1024, 2048, p.ws + OFF_WUPB_T, scr, it, F.lane, MapId{}, (const unsigned*)(p.ws + WS_CTL) + CW_CMAXB); }
}
template <class Map>
__device__ __forceinline__ void p0_quant_strip(const Frame& F, const float* W, const int K, const int N, const int strip, unsigned char* WT, unsigned* CMAX, Map map) {
    LAS bf16_t* img = (LAS bf16_t*)F.lds; LAS float* red = (LAS float*)(F.lds + MISC_OFF + 4096); LAS float* invs = red + 512;
    const int tid = F.tid, lane = F.lane, n0 = 32 * strip;
    { const int c = tid & 31, r = tid >> 5, col = n0 + c; const bool okc = col < N; float m = 0.f;
      for (int kb = 0; kb < K; kb += 512) { float v[32];
#pragma unroll
          for (int j = 0; j < 32; ++j) v[j] = okc ? W[(size_t)(kb + 16 * j + r) * N + col] : 0.f;
#pragma unroll
          for (int j = 0; j < 32; ++j) { m = fmaxf(m, __builtin_fabsf(v[j])); img[(kb + 16 * j + r) * 32 + c] = f2bf(v[j]); } }
      red[r * 32 + c] = m; }
    __syncthreads();
    if (tid < 32) { float mm = 0.f;
#pragma unroll
        for (int q = 0; q < 16; ++q) mm = fmaxf(mm, red[q * 32 + tid]);
        invs[tid] = 127.f / fmaxf(mm, 1e-30f); if (n0 + tid < N) CMAX[n0 + tid] = __float_as_uint(mm); }
    __syncthreads();
    { const int kq = lane & 7, cs = lane >> 3, c = F.wave * 4 + (cs & 3), hf = cs >> 2, col = n0 + c; const int dr = (col < N) ? map(col) : -1; const float inv = invs[c];
      for (int ch = hf; ch < K / 128; ch += 2) { const int k0 = ch * 128 + 16 * kq; float f[16];
#pragma unroll
          for (int e = 0; e < 16; ++e) f[e] = bf2f(img[(k0 + e) * 32 + c]) * inv;
          u32x4 o; o.x = pk4_i8(f[0], f[1], f[2], f[3]); o.y = pk4_i8(f[4], f[5], f[6], f[7]); o.z = pk4_i8(f[8], f[9], f[10], f[11]); o.w = pk4_i8(f[12], f[13], f[14], f[15]);
          if (dr >= 0) *(u32x4*)(WT + (size_t)dr * K + k0) = o; } }
    __syncthreads();
}
__device__ __forceinline__ void p0_quant_weights(const Frame& F0, const P& p) { const Frame F = phase_frame(F0);
    unsigned* ctl = (unsigned*)(p.ws + WS_CTL);
    constexpr int S_IN = (IN_COLS + 31) / 32, S_SQ = 2048 / 32, S_ALL = S_IN + 3 * S_SQ;
    for (int s0 = F.vcu; s0 < S_ALL; s0 += F.G) { int st = s0;
        if (st < S_IN) { p0_quant_strip(F, p.w_in, 2048, IN_COLS, st, p.ws + OFF_WIN8_T, ctl + CW_CMAX, MapWinG{}); continue; } st -= S_IN;
        if (st < S_SQ) { p0_quant_strip(F, p.w_out, 2048, 2048, st, p.ws + OFF_WOUT8_T, ctl + CW_CMAX2, MapId{}); continue; } st -= S_SQ;
        if (st < S_SQ) { p0_quant_strip(F, p.w_up_hg, 1024, 2048, st, p.ws + OFF_WUPA_T, ctl + CW_CMAXA, MapId{}); continue; } st -= S_SQ;
        p0_quant_strip(F, p.w_up_fox, 1024, 2048, st, p.ws + OFF_WUPB_T, ctl + CW_CMAXB, MapId{}); }
}
struct MapGuOrId { int gu; __device__ __forceinline__ int operator()(int c) const { const int bj = c >> 11, j = c & 2047; return gu ? ((j >> 7) << 8) + (bj << 7) + (j & 127) : c; } };
__device__ __forceinline__ void cq_issue(float (&v)[64], const P& p, int c, int wave, int lane) {
    constexpr int I_GU = (2048 / 128) * (4096 / 32), I_DN = (2048 / 128) * (2048 / 32);
    const int r = __builtin_amdgcn_readfirstlane(c * 8 + wave); const bool gu = r < NEXP * I_GU; const int q = gu ? r : r - NEXP * I_GU, per = gu ? I_GU : I_DN, e = q / per, N = gu ? 4096 : 2048;
    const float* W = gu ? p.w_gu + (size_t)e * 2048 * 4096 : p.w_down + (size_t)e * 2048 * 2048;
    p0_fp8_load<MapId>(v, W, N, q - e * per, lane);
}
__device__ __forceinline__ void cq_finish(const float (&v)[64], const P& p, int c, int wave, int lane) {
    constexpr int I_GU = (2048 / 128) * (4096 / 32), I_DN = (2048 / 128) * (2048 / 32);
    const int r = __builtin_amdgcn_readfirstlane(c * 8 + wave); const bool gu = r < NEXP * I_GU; const int q = gu ? r : r - NEXP * I_GU, per = gu ? I_GU : I_DN, e = q / per, N = gu ? 4096 : 2048;
    unsigned char* WT = gu ? p.ws + OFF_WGU_T + (size_t)e * 4096 * 2048 : p.ws + OFF_WDN_T + (size_t)e * 2048 * 2048;
    p0_fp8_finish(v, 2048, N, WT, q - e * per, lane, MapGuOrId{gu ? 1 : 0});
}
__device__ __forceinline__ void convert_queue(const Frame& F0, const P& p) { const Frame F = phase_frame(F0);
    constexpr int I_GU = (2048 / 128) * (4096 / 32), I_DN = (2048 / 128) * (2048 / 32), NCONV = NEXP * (I_GU + I_DN), NCH = NCONV / 8;
    unsigned* qhead = (unsigned*)(p.ws + WS_CTL) + CW_QC; LAS int* slot = (LAS int*)(F.lds + MISC_OFF + 768);
    if (F.tid == 0) { slot[0] = (int)__hip_atomic_fetch_add(qhead, 1u, __ATOMIC_RELAXED, __HIP_MEMORY_SCOPE_AGENT); slot[1] = (int)__hip_atomic_fetch_add(qhead, 1u, __ATOMIC_RELAXED, __HIP_MEMORY_SCOPE_AGENT); }
    __syncthreads();
    int ca = __builtin_amdgcn_readfirstlane(slot[0]), cb = __builtin_amdgcn_readfirstlane(slot[1]);
    float va[64], vb[64];
    if (ca < NCH) {
        cq_issue(va, p, ca, F.wave, F.lane);
        for (;;) {
            if (F.tid == 0) slot[2] = (int)__hip_atomic_fetch_add(qhead, 1u, __ATOMIC_RELAXED, __HIP_MEMORY_SCOPE_AGENT);
            cq_issue(vb, p, cb < NCH ? cb : NCH - 1, F.wave, F.lane);
            cq_finish(va, p, ca, F.wave, F.lane);
            __syncthreads();
            const int cn = __builtin_amdgcn_readfirstlane(slot[2]);
            if (cb >= NCH) break;
            if (F.tid == 0) slot[3] = (int)__hip_atomic_fetch_add(qhead, 1u, __ATOMIC_RELAXED, __HIP_MEMORY_SCOPE_AGENT);
            cq_issue(va, p, cn < NCH ? cn : NCH - 1, F.wave, F.lane);
            cq_finish(vb, p, cb, F.wave, F.lane);
            __syncthreads();
            const int cm = __builtin_amdgcn_readfirstlane(slot[3]);
            if (cn >= NCH) break;
            ca = cn; cb = cm;
        }
    }
    __syncthreads();
}
__device__ __forceinline__ void p0_router_prep(const Frame& F0, const P& p) { const Frame F = phase_frame(F0);
    bf16_t* RWT = (bf16_t*)(p.ws + OFF_RWT);
    for (int i = F.vcu * NWAVES * 64 + F.tid; i < NEXP * D_MODEL; i += F.G * NWAVES * 64) { const int e = i >> 11, k = i & 2047;
        const float w = p.norm2[k] * p.router_w[(size_t)k * NEXP + e]; const bf16_t hi = f2bf(w); RWT[i] = hi; RWT[NEXP * D_MODEL + i] = f2bf(w - bf2f(hi)); }
}
__device__ __forceinline__ void p0_rmsnorm(const Frame& F0, const P& p) { const Frame F = phase_frame(F0);
    LAS float* WF = (LAS float*)F.lds;
    LAS float* FLs = (LAS float*)(F.lds + 65536);
    unsigned char* H8 = p.ws + OFF_H8; float* HSC = (float*)(p.ws + OFF_HSC); float* C = (float*)(p.ws + OFF_C); float* BT = (float*)(p.ws + OFF_BT);
    for (int k = F.tid; k < D_MODEL; k += NWAVES * 64) { const float4* wr = (const float4*)(p.w_in + (size_t)k * IN_COLS + 7168); const float4 w0 = wr[0], w1 = wr[1];
        WF[0 * 2048 + k] = w0.x; WF[1 * 2048 + k] = w0.y; WF[2 * 2048 + k] = w0.z; WF[3 * 2048 + k] = w0.w; WF[4 * 2048 + k] = w1.x; WF[5 * 2048 + k] = w1.y; WF[6 * 2048 + k] = w1.z; WF[7 * 2048 + k] = w1.w; }
    __syncthreads();
    const int lane = F.lane;
    for (int blk = F.vcu; blk < T / 128; blk += F.G) {
        for (int pr = 0; pr < 8; ++pr) {
            const int lt = F.wave * 16 + 2 * pr, ta = blk * 128 + lt;
            const float4* xa = (const float4*)(p.x + (size_t)ta * D_MODEL); const float4* xb = xa + D_MODEL / 4;
            float4 va[8], vb[8]; float sa = 0.f, sb = 0.f;
#pragma unroll
            for (int i = 0; i < 8; ++i) { va[i] = xa[lane + 64 * i]; vb[i] = xb[lane + 64 * i];
                sa += va[i].x * va[i].x + va[i].y * va[i].y + va[i].z * va[i].z + va[i].w * va[i].w; sb += vb[i].x * vb[i].x + vb[i].y * vb[i].y + vb[i].z * vb[i].z + vb[i].w * vb[i].w; }
            const float ra = rsqrtf(wave_sum(sa) * (1.f / D_MODEL) + EPS), rb = rsqrtf(wave_sum(sb) * (1.f / D_MODEL) + EPS);
            float qa_ = 0.f, qb_ = 0.f;
#pragma unroll
            for (int i = 0; i < 8; ++i) { const float4 g = ((const float4*)p.norm1)[lane + 64 * i];
                qa_ = fmaxf(fmaxf(qa_, fmaxf(__builtin_fabsf(va[i].x * g.x), __builtin_fabsf(va[i].y * g.y))), fmaxf(__builtin_fabsf(va[i].z * g.z), __builtin_fabsf(va[i].w * g.w)));
                qb_ = fmaxf(fmaxf(qb_, fmaxf(__builtin_fabsf(vb[i].x * g.x), __builtin_fabsf(vb[i].y * g.y))), fmaxf(__builtin_fabsf(vb[i].z * g.z), __builtin_fabsf(vb[i].w * g.w))); }
            const float ma_ = fmaxf(wave_max(qa_) * ra, 1e-30f), mb_ = fmaxf(wave_max(qb_) * rb, 1e-30f), inva = 127.f / ma_, invb = 127.f / mb_;
            if (lane == 0) { HSC[ta] = ma_ * (1.f / 127.f); HSC[ta + 1] = mb_ * (1.f / 127.f); }
            float aa[8], ab[8];
#pragma unroll
            for (int j = 0; j < 8; ++j) { aa[j] = 0.f; ab[j] = 0.f; }
#pragma unroll
            for (int i = 0; i < 8; ++i) {
                const float4 g = ((const float4*)p.norm1)[lane + 64 * i]; const int k0 = 4 * (lane + 64 * i);
                const float4 ha = make_float4(va[i].x * ra * g.x, va[i].y * ra * g.y, va[i].z * ra * g.z, va[i].w * ra * g.w);
                const float4 hb = make_float4(vb[i].x * rb * g.x, vb[i].y * rb * g.y, vb[i].z * rb * g.z, vb[i].w * rb * g.w);
                *(unsigned*)(H8 + (size_t)ta * D_MODEL + k0) = pk4_i8(ha.x * inva, ha.y * inva, ha.z * inva, ha.w * inva); *(unsigned*)(H8 + (size_t)(ta + 1) * D_MODEL + k0) = pk4_i8(hb.x * invb, hb.y * invb, hb.z * invb, hb.w * invb);
#pragma unroll
                for (int j = 0; j < 8; ++j) { const f32x4 w = *(const LAS f32x4*)(WF + j * 2048 + k0);
                    aa[j] += ha.x * w[0] + ha.y * w[1] + ha.z * w[2] + ha.w * w[3]; ab[j] += hb.x * w[0] + hb.y * w[1] + hb.z * w[2] + hb.w * w[3]; }
            }
#pragma unroll
            for (int j = 0; j < 8; ++j) { aa[j] = wave_sum(aa[j]); ab[j] = wave_sum(ab[j]); }
            float ma = aa[0], mb = ab[0];
#pragma unroll
            for (int j = 1; j < 8; ++j) { ma = (lane == j) ? aa[j] : ma; mb = (lane == j) ? ab[j] : mb; }
            if (lane < 8) { const float fb = p.f_bias[lane]; FLs[lt * 8 + lane] = log_sigmoidf_(ma + fb); FLs[(lt + 1) * 8 + lane] = log_sigmoidf_(mb + fb); }
        }
        __syncthreads();
        if (F.tid < 8) { float c = 0.f; for (int tt = 0; tt < 128; ++tt) { c += FLs[tt * 8 + F.tid]; FLs[tt * 8 + F.tid] = c; } BT[blk * 8 + F.tid] = c; }
        __syncthreads();
        for (int e = F.tid; e < 1024; e += NWAVES * 64) C[(size_t)blk * 1024 + e] = FLs[e];
        __syncthreads();
    }
}
__device__ __forceinline__ void p1_fix_c(const Frame& F0, const P& p) { const Frame F = phase_frame(F0);
    float* C = (float*)(p.ws + OFF_C); const float* BT = (const float*)(p.ws + OFF_BT);
    for (int blk = F.vcu; blk < T / 128; blk += F.G) {
        const int j = F.tid & 7, b0 = (blk / 64) * 64; float off = 0.f;
        for (int w = b0; w < blk; ++w) off += BT[w * 8 + j];
        for (int e = F.tid; e < 1024; e += NWAVES * 64) C[(size_t)blk * 1024 + e] += off;
    }
}
struct EpiIn1 {
    static constexpr bool PERM = true;
    unsigned char* ws; const float* lb_logits; LAS float* NS; const float* fq_norm; const float* fk_norm;
    __device__ __forceinline__ void operator()(const f32x4 (&acc)[2][2][4][2], const pg8::Unit& u, int wr, int wc, int fr, int fq) const {
        const int pn = u.e; int seg, colt;
        if (pn < 28) { seg = pn >> 2; colt = (pn & 3) * 256; } else if (pn < 36) { seg = 7; colt = (pn - 28) * 256; } else { seg = 8; colt = (pn - 36) * 256; }
        const int ldc = seg < 7 ? 1024 : 2048;
        bf16_t* base = (bf16_t*)(ws + (seg < 7 ? OFF_HQ + (size_t)seg * 64 * MiB : OFF_GA + (size_t)(seg - 7) * 128 * MiB));
        const int row0 = u.pm * 256 + wr * 64 + fr, col0 = colt + wc * 32 + 8 * fq;
        const int mode = (seg == 0) ? 0 : (seg == 1) ? 1 : (seg == 3) ? 3 : (seg >= 7) ? 4 : 2;
        if (seg == 4 || seg == 5) {
            const float* gn = (seg == 4) ? fq_norm : fk_norm; const float gs = (seg == 4) ? 0.08838834764831845f : 1.f;
#pragma unroll
            for (int ai = 0; ai < 2; ++ai)
#pragma unroll
                for (int m = 0; m < 4; ++m)
#pragma unroll
                    for (int bj = 0; bj < 2; ++bj) { const f32x4 a = acc[ai][bj][m][0], b = acc[ai][bj][m][1];
                        float q = a[0] * a[0] + a[1] * a[1] + a[2] * a[2] + a[3] * a[3] + b[0] * b[0] + b[1] * b[1] + b[2] * b[2] + b[3] * b[3];
                        q += __shfl_xor(q, 16); q += __shfl_xor(q, 32);
                        if (fq == 0) NS[(ai * 128 + wr * 64 + m * 16 + fr) * 8 + bj * 4 + wc] = q; }
            asm volatile("s_waitcnt lgkmcnt(0)" ::: "memory");
            __builtin_amdgcn_s_barrier();
            const f32x4 g0 = *(const f32x4*)(gn + 32 * wc + 8 * fq) * gs, g1 = *(const f32x4*)(gn + 32 * wc + 8 * fq + 4) * gs;
#pragma unroll
            for (int ai = 0; ai < 2; ++ai)
#pragma unroll
                for (int m = 0; m < 4; ++m) { bf16_t* rowp = base + (size_t)(row0 + ai * 128 + m * 16) * ldc + col0;
#pragma unroll
                    for (int bj = 0; bj < 2; ++bj) { const f32x4 t = *(const LAS f32x4*)(NS + (ai * 128 + wr * 64 + m * 16 + fr) * 8 + bj * 4);
                        const float rs = rsqrtf((t[0] + t[1] + t[2] + t[3]) * (1.f / 128.f) + EPS);
                        const f32x4 v0 = acc[ai][bj][m][0] * rs * g0, v1 = acc[ai][bj][m][1] * rs * g1;
                        u32x4 w; w.x = cvt_pk_bf16(v0[0], v0[1]); w.y = cvt_pk_bf16(v0[2], v0[3]); w.z = cvt_pk_bf16(v1[0], v1[1]); w.w = cvt_pk_bf16(v1[2], v1[3]);
                        *(u32x4*)(rowp + bj * 128) = w; } }
            return;
        }
        f32x4 lbv[2][2];
        if (mode == 1) {
#pragma unroll
            for (int bj = 0; bj < 2; ++bj)
#pragma unroll
                for (int n = 0; n < 2; ++n) { const int cc = col0 + bj * 128 + 4 * n; const f32x4 l0 = *(const f32x4*)(lb_logits + cc), l1 = *(const f32x4*)(lb_logits + 1024 + cc);
#pragma unroll
                    for (int j = 0; j < 4; ++j) lbv[bj][n][j] = __builtin_amdgcn_rcpf(1.f + __expf(l1[j] - l0[j])); }
        }
#pragma unroll
        for (int ai = 0; ai < 2; ++ai)
#pragma unroll
            for (int m = 0; m < 4; ++m) { bf16_t* rowp = base + (size_t)(row0 + ai * 128 + m * 16) * ldc + col0;
#pragma unroll
                for (int bj = 0; bj < 2; ++bj) { f32x4 v[2] = {acc[ai][bj][m][0], acc[ai][bj][m][1]};
#pragma unroll
                    for (int n = 0; n < 2; ++n)
#pragma unroll
                        for (int j = 0; j < 4; ++j) { float x = v[n][j];
                            if (mode == 0) x = x * fast_sigmoid(x) * 0.08838834764831845f;
                            else if (mode == 1) { const float lb = lbv[bj][n][j]; x = __logf(lb + (1.f - lb) * fast_sigmoid(x)); }
                            else if (mode == 3) x = x * fast_sigmoid(x);
                            else if (mode == 4) x = fast_sigmoid(x);
                            v[n][j] = x; }
                    u32x4 w; w.x = cvt_pk_bf16(v[0][0], v[0][1]); w.y = cvt_pk_bf16(v[0][2], v[0][3]); w.z = cvt_pk_bf16(v[1][0], v[1][1]); w.w = cvt_pk_bf16(v[1][2], v[1][3]);
                    *(u32x4*)(rowp + bj * 128) = w; } }
    }
};

template <int HH> struct EpiMergeT {
    static constexpr bool PERM = true;
    unsigned char* ws;
    __device__ __forceinline__ void operator()(const f32x4 (&acc)[2][2][4][2], const pg8::Unit& u, int wr, int wc, int fr, int fq) const {
        const int row0 = u.pm * 256 + wr * 64 + fr, col0 = u.pn * 256 + wc * 32 + 8 * fq;
        const bf16_t* G = (const bf16_t*)(ws + (HH ? OFF_GB : OFF_GA)); bf16_t* TMP = (bf16_t*)(ws + OFF_X1); bf16_t* MRG = (bf16_t*)(ws + OFF_MRG);
#pragma unroll
        for (int ai = 0; ai < 2; ++ai)
#pragma unroll
            for (int m = 0; m < 4; ++m) { const size_t ro = (size_t)(row0 + ai * 128 + m * 16) * D_MODEL + col0;
#pragma unroll
                for (int bj = 0; bj < 2; ++bj) { const u32x4 g = *(const u32x4*)(G + ro + bj * 128);
                    f32x4 v0 = acc[ai][bj][m][0], v1 = acc[ai][bj][m][1];
                    v0[0] *= __uint_as_float(g.x << 16); v0[1] *= __uint_as_float(g.x & 0xffff0000u); v0[2] *= __uint_as_float(g.y << 16); v0[3] *= __uint_as_float(g.y & 0xffff0000u);
                    v1[0] *= __uint_as_float(g.z << 16); v1[1] *= __uint_as_float(g.z & 0xffff0000u); v1[2] *= __uint_as_float(g.w << 16); v1[3] *= __uint_as_float(g.w & 0xffff0000u);
                    if constexpr (HH != 0) { const u32x4 t = *(const u32x4*)(TMP + ro + bj * 128);
                        v0[0] += __uint_as_float(t.x << 16); v0[1] += __uint_as_float(t.x & 0xffff0000u); v0[2] += __uint_as_float(t.y << 16); v0[3] += __uint_as_float(t.y & 0xffff0000u);
                        v1[0] += __uint_as_float(t.z << 16); v1[1] += __uint_as_float(t.z & 0xffff0000u); v1[2] += __uint_as_float(t.w << 16); v1[3] += __uint_as_float(t.w & 0xffff0000u); }
                    u32x4 w; w.x = cvt_pk_bf16(v0[0], v0[1]); w.y = cvt_pk_bf16(v0[2], v0[3]); w.z = cvt_pk_bf16(v1[0], v1[1]); w.w = cvt_pk_bf16(v1[2], v1[3]);
                    *(u32x4*)((HH ? MRG : TMP) + ro + bj * 128) = w;
                    }
                }
    }
};
struct EpiWout1 {
    static constexpr bool PERM = true;
    const float* x; bf16_t* X1;
    __device__ __forceinline__ void operator()(const f32x4 (&acc)[2][2][4][2], const pg8::Unit& u, int wr, int wc, int fr, int fq) const {
        const int row0 = u.pm * 256 + wr * 64 + fr, col0 = u.pn * 256 + wc * 32 + 8 * fq;
#pragma unroll
        for (int ai = 0; ai < 2; ++ai)
#pragma unroll
            for (int m = 0; m < 4; ++m) { const size_t ro = (size_t)(row0 + ai * 128 + m * 16) * D_MODEL + col0;
#pragma unroll
                for (int bj = 0; bj < 2; ++bj) { const f32x4 v0 = *(const f32x4*)(x + ro + bj * 128) + acc[ai][bj][m][0], v1 = *(const f32x4*)(x + ro + bj * 128 + 4) + acc[ai][bj][m][1];
                    u32x4 w; w.x = cvt_pk_bf16(v0[0], v0[1]); w.y = cvt_pk_bf16(v0[2], v0[3]); w.z = cvt_pk_bf16(v1[0], v1[1]); w.w = cvt_pk_bf16(v1[2], v1[3]);
                    *(u32x4*)(X1 + ro + bj * 128) = w; } }
    }
};
struct EpiGU1 {
    static constexpr bool PERM = true;
    const float* b_gu; unsigned char* ACT; const float* ROWRS;
    __device__ __forceinline__ void operator()(const f32x4 (&acc)[2][2][4][2], const pg8::Unit& u, int wr, int wc, int fr, int fq) const {
        const int row0 = u.pm * 256 + wr * 64 + fr, ca = u.pn * 128 + wc * 32 + 8 * fq;
        const float* bg = b_gu + (size_t)u.e * 4096 + ca;
        const f32x4 bg0 = *(const f32x4*)bg, bg1 = *(const f32x4*)(bg + 4), bu0 = *(const f32x4*)(bg + 2048), bu1 = *(const f32x4*)(bg + 2052);
#pragma unroll
        for (int ai = 0; ai < 2; ++ai)
#pragma unroll
            for (int m = 0; m < 4; ++m) {
                const float rs = ROWRS[row0 + ai * 128 + m * 16];
                f32x4 g[2] = {acc[ai][0][m][0] * rs + bg0, acc[ai][0][m][1] * rs + bg1}, up[2] = {acc[ai][1][m][0] * rs + bu0, acc[ai][1][m][1] * rs + bu1}; float o[8];
#pragma unroll
                for (int n = 0; n < 2; ++n)
#pragma unroll
                    for (int j = 0; j < 4; ++j) { const float gg = fminf(g[n][j], 7.f), uu = fminf(fmaxf(up[n][j], -7.f), 7.f); o[n * 4 + j] = (uu + 1.f) * gg * fast_sigmoid(1.702f * gg); }
                u32x2 w; w.x = pk4_fp8(o[0], o[1], o[2], o[3]); w.y = pk4_fp8(o[4], o[5], o[6], o[7]);
                *(u32x2*)(ACT + (size_t)(row0 + ai * 128 + m * 16) * D_MODEL + ca) = w; }
    }
};
constexpr float YR_SCALE = 32.f;
struct EpiDown1 {
    static constexpr bool PERM = true;
    const float* b_down; const float* ROWW; unsigned char* YR;
    __device__ __forceinline__ void operator()(const f32x4 (&acc)[2][2][4][2], const pg8::Unit& u, int wr, int wc, int fr, int fq) const {
        const int row0 = u.pm * 256 + wr * 64 + fr, col0 = u.pn * 256 + wc * 32 + 8 * fq;
        const float* bb = b_down + (size_t)u.e * 2048 + col0;
        f32x4 bv[2][2];
#pragma unroll
        for (int bj = 0; bj < 2; ++bj) { bv[bj][0] = *(const f32x4*)(bb + bj * 128); bv[bj][1] = *(const f32x4*)(bb + bj * 128 + 4); }
#pragma unroll
        for (int ai = 0; ai < 2; ++ai)
#pragma unroll
            for (int m = 0; m < 4; ++m) { const int r = row0 + ai * 128 + m * 16; const float rw = ROWW[r];
#pragma unroll
                for (int bj = 0; bj < 2; ++bj) { f32x4 v0 = (acc[ai][bj][m][0] + bv[bj][0]) * (rw * YR_SCALE), v1 = (acc[ai][bj][m][1] + bv[bj][1]) * (rw * YR_SCALE);
#pragma unroll
                    for (int j = 0; j < 4; ++j) { v0[j] = __builtin_amdgcn_fmed3f(v0[j], -448.f, 448.f); v1[j] = __builtin_amdgcn_fmed3f(v1[j], -448.f, 448.f); }
                    u32x2 w; w.x = pk4_fp8(v0[0], v0[1], v0[2], v0[3]); w.y = pk4_fp8(v1[0], v1[1], v1[2], v1[3]);
                    *(u32x2*)(YR + (size_t)r * D_MODEL + col0 + bj * 128) = w; } }
    }
};
constexpr int TILEE_LDS_OFF = MISC_OFF + 1024;
__device__ __forceinline__ int load_tile_table(const Frame& F0, const P& p) { const Frame F = phase_frame(F0);
    const int* TILEE = (const int*)(p.ws + OFF_TILEE); LAS int* tl = (LAS int*)(F.lds + TILEE_LDS_OFF);
    for (int i = F.tid; i <= NTILES_MAX; i += NWAVES * 64) tl[i] = TILEE[i];
    __syncthreads();
    return tl[NTILES_MAX];
}


typedef short s16x4 __attribute__((ext_vector_type(4)));
__device__ __forceinline__ int img_off(int row, int ch) { return 256 * row + 16 * (ch ^ (((row & 3) << 2) | ((row >> 2) & 3))); }
__device__ __forceinline__ void tr_frag_issue(s16x4& lo, s16x4& hi, LAS unsigned char* img, int r0, int ctile, int lane) {
    const int q = (lane & 15) >> 2, pp = lane & 3;
    lo = __builtin_amdgcn_ds_read_tr16_b64_v4i16((LAS s16x4*)(img + img_off(r0 + q, 2 * ctile + (pp >> 1)) + 8 * (pp & 1)));
    hi = __builtin_amdgcn_ds_read_tr16_b64_v4i16((LAS s16x4*)(img + img_off(r0 + 4 + q, 2 * ctile + (pp >> 1)) + 8 * (pp & 1)));
}
__device__ __forceinline__ bf16x8 frag8(const s16x4& lo, const s16x4& hi) { return (bf16x8){lo[0], lo[1], lo[2], lo[3], hi[0], hi[1], hi[2], hi[3]}; }
__device__ __forceinline__ float clamp80(float x) { return fminf(fmaxf(x, -80.f), 80.f); }
constexpr int HG_V = 0, HG_K = 16384, HG_Q = 32768, HG_QH = 49152, HG_P = 65536, HG_SEG = 73728, HG_RED = 77824;

__device__ __forceinline__ void hgrn_cumsum(const Frame& F, const unsigned (&lf)[8], float (&b0)[8], float (&b1)[8], float& B0, float& B1) {
    LAS float* SEG = (LAS float*)(F.lds + HG_SEG);
    float c0 = 0.f, c1 = 0.f;
#pragma unroll
    for (int r = 0; r < 8; ++r) { c0 += __uint_as_float(lf[r] << 16); c1 += __uint_as_float(lf[r] & 0xffff0000u); b0[r] = c0; b1[r] = c1; }
    *(LAS f32x2*)(SEG + F.wave * 128 + 2 * F.lane) = (f32x2){c0, c1};
    __syncthreads();
    float p0 = 0.f, p1 = 0.f; B0 = 0.f; B1 = 0.f;
#pragma unroll
    for (int j = 0; j < 8; ++j) { const f32x2 s = *(const LAS f32x2*)(SEG + j * 128 + 2 * F.lane); if (j < F.wave) { p0 += s[0]; p1 += s[1]; } B0 += s[0]; B1 += s[1]; }
#pragma unroll
    for (int r = 0; r < 8; ++r) { b0[r] += p0; b1[r] += p1; }
}
__device__ __forceinline__ void hgrn_v_to_lds(const Frame& F, const bf16_t* HV, size_t tok0, int h) {
#pragma unroll
    for (int i = 0; i < 2; ++i) { const int qd = F.tid + 512 * i, row = qd >> 4, ch = qd & 15;
        const u32x4 v = *(const u32x4*)(HV + (tok0 + row) * 1024 + h * 128 + ch * 8);
        *(LAS u32x4*)(F.lds + HG_V + img_off(row, ch)) = v; }
}
__device__ __forceinline__ void p2_hgrn_local(const Frame& F0, const P& p) { const Frame F = phase_frame(F0);
    const bf16_t* LOGF = (const bf16_t*)(p.ws + OFF_LOGF); const bf16_t* HV = (const bf16_t*)(p.ws + OFF_HV);
    bf16_t* SLOC = (bf16_t*)(p.ws + OFF_SLOC); float* DEC = (float*)(p.ws + OFF_DEC);
    const int w = F.wave, lane = F.lane, g = lane >> 4;
    for (int it = F.vcu; it < 4096; it += F.G) {
        const int bh = it >> 7, n = it & 127, b = bh >> 3, h = bh & 7; const size_t tok0 = (size_t)b * SEQ + n * 64;
        const size_t gbase = (tok0 + 8 * w) * 1024 + h * 128 + 2 * lane;
        unsigned lf[8];
#pragma unroll
        for (int r = 0; r < 8; ++r) lf[r] = *(const unsigned*)(LOGF + gbase + (size_t)r * 1024);
        hgrn_v_to_lds(F, HV, tok0, h);
        float b0[8], b1[8], B0, B1;
        hgrn_cumsum(F, lf, b0, b1, B0, B1);
#pragma unroll
        for (int r = 0; r < 8; ++r) { const float l0 = __uint_as_float(lf[r] << 16), l1 = __uint_as_float(lf[r] & 0xffff0000u);
            const float k0 = (1.f - __expf(l0)) * __expf(B0 - b0[r]), k1 = (1.f - __expf(l1)) * __expf(B1 - b1[r]);
            *(LAS unsigned*)(F.lds + HG_K + img_off(8 * w + r, lane >> 2) + (lane & 3) * 4) = cvt_pk_bf16(k0, k1); }
        if (w == 0) *(f32x2*)(DEC + (size_t)it * 128 + 2 * lane) = (f32x2){__expf(B0), __expf(B1)};
        __syncthreads();
        s16x4 al[2], ah[2];
#pragma unroll
        for (int ks = 0; ks < 2; ++ks) tr_frag_issue(al[ks], ah[ks], F.lds + HG_K, 32 * ks + 8 * g, w, lane);
        f32x4 acc[8];
#pragma unroll
        for (int vt = 0; vt < 8; ++vt) {
            s16x4 bl[2], bh2[2];
#pragma unroll
            for (int ks = 0; ks < 2; ++ks) tr_frag_issue(bl[ks], bh2[ks], F.lds + HG_V, 32 * ks + 8 * g, vt, lane);
            acc[vt] = (f32x4){0.f, 0.f, 0.f, 0.f};
#pragma unroll
            for (int ks = 0; ks < 2; ++ks) acc[vt] = __builtin_amdgcn_mfma_f32_16x16x32_bf16(frag8(al[ks], ah[ks]), frag8(bl[ks], bh2[ks]), acc[vt], 0, 0, 0);
        }
#pragma unroll
        for (int vt = 0; vt < 8; ++vt) { u32x2 o; o.x = cvt_pk_bf16(acc[vt][0], acc[vt][1]); o.y = cvt_pk_bf16(acc[vt][2], acc[vt][3]);
            *(u32x2*)(SLOC + (size_t)it * 16384 + (size_t)(16 * vt + (lane & 15)) * 128 + 16 * w + 4 * g) = o; }
        __syncthreads();
    }
}
__device__ __forceinline__ void p3_hgrn_scan(const Frame& F0, const P& p) { const Frame F = phase_frame(F0);
    const bf16_t* SLOC = (const bf16_t*)(p.ws + OFF_SLOC); const float* DEC = (const float*)(p.ws + OFF_DEC); bf16_t* STATE = (bf16_t*)(p.ws + OFF_STATE);
    for (int gid = F.vcu * 512 + F.tid; gid < 32 * 4096; gid += F.G * 512) {
        const int bh = gid >> 12, e = (gid & 4095) * 4, c = e & 127;
        f32x4 st = {0.f, 0.f, 0.f, 0.f};
        for (int n0 = 0; n0 < 128; n0 += 8) {
            u32x2 sl[8]; f32x4 dc[8];
#pragma unroll
            for (int j = 0; j < 8; ++j) { const size_t it = (size_t)bh * 128 + n0 + j; sl[j] = *(const u32x2*)(SLOC + it * 16384 + e); dc[j] = *(const f32x4*)(DEC + it * 128 + c); }
#pragma unroll
            for (int j = 0; j < 8; ++j) { const size_t it = (size_t)bh * 128 + n0 + j;
                u32x2 o; o.x = cvt_pk_bf16(st[0], st[1]); o.y = cvt_pk_bf16(st[2], st[3]); *(u32x2*)(STATE + it * 16384 + e) = o;
                st[0] = dc[j][0] * st[0] + __uint_as_float(sl[j].x << 16); st[1] = dc[j][1] * st[1] + __uint_as_float(sl[j].x & 0xffff0000u);
                st[2] = dc[j][2] * st[2] + __uint_as_float(sl[j].y << 16); st[3] = dc[j][3] * st[3] + __uint_as_float(sl[j].y & 0xffff0000u); }
        }
    }
}
__device__ __forceinline__ void p4_hgrn_out(const Frame& F0, const P& p) { const Frame F = phase_frame(F0);
    const bf16_t* HQ = (const bf16_t*)(p.ws + OFF_HQ); const bf16_t* LOGF = (const bf16_t*)(p.ws + OFF_LOGF); const bf16_t* HV = (const bf16_t*)(p.ws + OFF_HV); const bf16_t* HG = (const bf16_t*)(p.ws + OFF_HG);
    const bf16_t* STATE = (const bf16_t*)(p.ws + OFF_STATE); bf16_t* AOUT = (bf16_t*)(p.ws + OFF_AOUT);
    const int w = F.wave, lane = F.lane, g = lane >> 4, l15 = lane & 15, tt = w & 3, vh = w >> 2;
    LAS float* RED = (LAS float*)(F.lds + HG_RED);
    unsigned* qhead = (unsigned*)(p.ws + WS_CTL) + CW_QH; LAS int* slot = (LAS int*)(F.lds + MISC_OFF + 768);
    if (F.tid == 0) { slot[1] = (int)__hip_atomic_fetch_add(qhead, 1u, __ATOMIC_RELAXED, __HIP_MEMORY_SCOPE_AGENT); slot[2] = (int)__hip_atomic_fetch_add(qhead, 1u, __ATOMIC_RELAXED, __HIP_MEMORY_SCOPE_AGENT); }
    __syncthreads();
    int it = __builtin_amdgcn_readfirstlane(slot[1]), itn = __builtin_amdgcn_readfirstlane(slot[2]), par = 0;
    unsigned lfN[8], qqN[8]; u32x2 hgN[4]; u32x4 vN[2];
#define HGO_PRE(item) do { const int bh_ = (item) >> 7, n_ = (item) & 127, b_ = bh_ >> 3, h_ = bh_ & 7; const size_t tok_ = (size_t)b_ * SEQ + n_ * 64, gb_ = (tok_ + 8 * w) * 1024 + h_ * 128 + 2 * lane; \
        _Pragma("unroll") for (int r = 0; r < 8; ++r) { lfN[r] = *(const unsigned*)(LOGF + gb_ + (size_t)r * 1024); qqN[r] = *(const unsigned*)(HQ + gb_ + (size_t)r * 1024); } \
        _Pragma("unroll") for (int vt = 0; vt < 4; ++vt) hgN[vt] = *(const u32x2*)(HG + (tok_ + 16 * tt + l15) * 1024 + h_ * 128 + 64 * vh + 16 * vt + 4 * g); \
        _Pragma("unroll") for (int i = 0; i < 2; ++i) { const int qd = F.tid + 512 * i, row = qd >> 4, ch = qd & 15; vN[i] = *(const u32x4*)(HV + (tok_ + row) * 1024 + h_ * 128 + ch * 8); } } while (0)
    if (it < 4096) HGO_PRE(it);
    while (it < 4096) {
        if (F.tid == 0) slot[3 + par] = (int)__hip_atomic_fetch_add(qhead, 1u, __ATOMIC_RELAXED, __HIP_MEMORY_SCOPE_AGENT);
        const int bh = it >> 7, n = it & 127, b = bh >> 3, h = bh & 7; const size_t tok0 = (size_t)b * SEQ + n * 64;
        bf16x8 sfr[4][4];
#pragma unroll
        for (int vt = 0; vt < 4; ++vt)
#pragma unroll
            for (int ks = 0; ks < 4; ++ks) sfr[vt][ks] = *(const bf16x8*)(STATE + (size_t)it * 16384 + (size_t)(64 * vh + 16 * vt + l15) * 128 + 32 * ks + 8 * g);
        u32x2 hgv[4]; unsigned lf[8], qq[8];
#pragma unroll
        for (int vt = 0; vt < 4; ++vt) hgv[vt] = hgN[vt];
#pragma unroll
        for (int r = 0; r < 8; ++r) { lf[r] = lfN[r]; qq[r] = qqN[r]; }
#pragma unroll
        for (int i = 0; i < 2; ++i) { const int qd = F.tid + 512 * i, row = qd >> 4, ch = qd & 15; *(LAS u32x4*)(F.lds + HG_V + img_off(row, ch)) = vN[i]; }
        { const int nx = itn < 4096 ? itn : 4095; HGO_PRE(nx); }
        float b0[8], b1[8], B0, B1;
        hgrn_cumsum(F, lf, b0, b1, B0, B1);
        const float r0 = 0.5f * B0, r1 = 0.5f * B1;
#pragma unroll
        for (int r = 0; r < 8; ++r) { const float l0 = __uint_as_float(lf[r] << 16), l1 = __uint_as_float(lf[r] & 0xffff0000u), q0 = __uint_as_float(qq[r] << 16), q1 = __uint_as_float(qq[r] & 0xffff0000u);
            const int off = img_off(8 * w + r, lane >> 2) + (lane & 3) * 4;
            *(LAS unsigned*)(F.lds + HG_Q + off) = cvt_pk_bf16(q0 * __expf(clamp80(b0[r] - r0)), q1 * __expf(clamp80(b1[r] - r1)));
            *(LAS unsigned*)(F.lds + HG_K + off) = cvt_pk_bf16((1.f - __expf(l0)) * __expf(clamp80(r0 - b0[r])), (1.f - __expf(l1)) * __expf(clamp80(r1 - b1[r])));
            *(LAS unsigned*)(F.lds + HG_QH + off) = cvt_pk_bf16(q0 * __expf(b0[r]), q1 * __expf(b1[r])); }
        __syncthreads();
#pragma unroll
        for (int si = 0; si < 2; ++si) { const int st = 2 * vh + si; f32x4 sc = {0.f, 0.f, 0.f, 0.f};
#pragma unroll
            for (int ks = 0; ks < 4; ++ks) { const bf16x8 a = *(const LAS bf16x8*)(F.lds + HG_K + img_off(16 * st + l15, 4 * ks + g)), bq = *(const LAS bf16x8*)(F.lds + HG_Q + img_off(16 * tt + l15, 4 * ks + g));
                sc = __builtin_amdgcn_mfma_f32_16x16x32_bf16(a, bq, sc, 0, 0, 0); }
#pragma unroll
            for (int rg = 0; rg < 4; ++rg) sc[rg] = (16 * st + 4 * g + rg > 16 * tt + l15) ? 0.f : sc[rg];
            const int t = 16 * tt + l15, chunk = 2 * st + (g >> 1);
            u32x2 o; o.x = cvt_pk_bf16(sc[0], sc[1]); o.y = cvt_pk_bf16(sc[2], sc[3]);
            *(LAS u32x2*)(F.lds + HG_P + t * 128 + ((chunk ^ (t & 7)) * 16) + 8 * (g & 1)) = o; }
        __syncthreads();
        bf16x8 pb[2], qb[4];
        { const int t = 16 * tt + l15;
#pragma unroll
          for (int ks = 0; ks < 2; ++ks) pb[ks] = *(const LAS bf16x8*)(F.lds + HG_P + t * 128 + (((4 * ks + g) ^ (t & 7)) * 16));
#pragma unroll
          for (int ks = 0; ks < 4; ++ks) qb[ks] = *(const LAS bf16x8*)(F.lds + HG_QH + img_off(t, 4 * ks + g)); }
        f32x4 oacc[4]; float ssq = 0.f;
#pragma unroll
        for (int vt = 0; vt < 4; ++vt) {
            s16x4 vl[2], vhh[2];
#pragma unroll
            for (int ks = 0; ks < 2; ++ks) tr_frag_issue(vl[ks], vhh[ks], F.lds + HG_V, 32 * ks + 8 * g, 4 * vh + vt, lane);
            f32x4 a = {0.f, 0.f, 0.f, 0.f};
#pragma unroll
            for (int ks = 0; ks < 2; ++ks) a = __builtin_amdgcn_mfma_f32_16x16x32_bf16(frag8(vl[ks], vhh[ks]), pb[ks], a, 0, 0, 0);
#pragma unroll
            for (int ks = 0; ks < 4; ++ks) a = __builtin_amdgcn_mfma_f32_16x16x32_bf16(sfr[vt][ks], qb[ks], a, 0, 0, 0);
            oacc[vt] = a; ssq += a[0] * a[0] + a[1] * a[1] + a[2] * a[2] + a[3] * a[3];
        }
        ssq += __shfl_xor(ssq, 16); ssq += __shfl_xor(ssq, 32);
        if (g == 0) RED[(16 * tt + l15) * 2 + vh] = ssq;
        __syncthreads();
        { const int t = 16 * tt + l15; const float tot = RED[t * 2] + RED[t * 2 + 1], rs = rsqrtf(tot * (1.f / 128.f) + EPS);
#pragma unroll
          for (int vt = 0; vt < 4; ++vt) { const int v0 = 64 * vh + 16 * vt + 4 * g; const f32x4 gn = *(const f32x4*)(p.hg_norm + v0);
              const float y0 = oacc[vt][0] * rs * gn[0] * __uint_as_float(hgv[vt].x << 16), y1 = oacc[vt][1] * rs * gn[1] * __uint_as_float(hgv[vt].x & 0xffff0000u);
              const float y2 = oacc[vt][2] * rs * gn[2] * __uint_as_float(hgv[vt].y << 16), y3 = oacc[vt][3] * rs * gn[3] * __uint_as_float(hgv[vt].y & 0xffff0000u);
              u32x2 o; o.x = cvt_pk_bf16(y0, y1); o.y = cvt_pk_bf16(y2, y3);
              *(u32x2*)(AOUT + (tok0 + t) * 1024 + h * 128 + v0) = o; } }
        __syncthreads();
        it = itn; itn = __builtin_amdgcn_readfirstlane(slot[3 + par]); par ^= 1;
    }
#undef HGO_PRE
}

namespace fox {
constexpr int NW = 8, QBLK = 32, KVBLK = 64, QB = NW * QBLK, D = 128, RS = 1024;
constexpr int SHM_V = KVBLK * D * 2, SHM_K = KVBLK * D * 2;
constexpr int OFF_VL = 0, OFF_KL = 2 * SHM_V, OFF_WS = 2 * SHM_V + 2 * SHM_K, OFF_BIAS = OFF_WS + NW * 64 * 4, OFF_ITEM = OFF_BIAS + 2 * 64 * 4;
constexpr float THR = 8.f;
typedef float f32x16 __attribute__((ext_vector_type(16)));
#define KSWZ(row, colB) ((row) * 256 + ((colB) ^ (((row) & 7) << 4)))
#define SBAR() __builtin_amdgcn_sched_barrier(0)
__device__ __forceinline__ int v_st(int k, int c) { const int kk = (k & ~0xC) | ((k & 4) << 1) | ((k & 8) >> 1); return ((kk >> 3) * 4 + (c >> 5)) * 512 + ((kk & 7) * 32 + (c & 31)) * 2; }
__device__ __forceinline__ int v_rd_base(int lane) { return ((lane & 3) << 3) | (((lane >> 2) & 3) << 6) | (((lane >> 4) & 1) << 5) | (((lane >> 5) & 1) << 8); }
constexpr int v_rd_off(int d0, int ks, int half) { return d0 * 512 + ks * 4096 + half * 2048; }
__device__ __forceinline__ int crow(int r, int hi) { return (r & 3) + 8 * (r >> 2) + 4 * hi; }
__device__ __forceinline__ void mask_tile(f32x16& p0, f32x16& p1, int dq) {
    const float NEG = -__builtin_inff();
#pragma unroll
    for (int r = 0; r < 16; ++r) { const int c = (r & 3) + 8 * (r >> 2); if (dq - c < 0) p0[r] = NEG; if (dq - c - 32 < 0) p1[r] = NEG; }
}
__device__ __forceinline__ void partialSM(f32x16& p0, f32x16& p1, float& m_reg, float& mn, float& alpha) {
    float pmax = p0[0];
#pragma unroll
    for (int r = 1; r < 16; ++r) pmax = fmaxf(pmax, p0[r]);
#pragma unroll
    for (int r = 0; r < 16; ++r) pmax = fmaxf(pmax, p1[r]);
    { auto rr = __builtin_amdgcn_permlane32_swap(__float_as_uint(pmax), __float_as_uint(pmax), false, false); pmax = fmaxf(__uint_as_float(rr[0]), __uint_as_float(rr[1])); }
    constexpr float C2 = 1.4426950408889634f;
    if (__builtin_expect(__all((pmax - m_reg) <= THR), 1)) { mn = m_reg; alpha = 1.f; }
    else { mn = fmaxf(m_reg, pmax); alpha = __builtin_amdgcn_exp2f((m_reg - mn) * C2); m_reg = mn; }
    const float mnL = -mn * C2;
#pragma unroll
    for (int r = 0; r < 16; ++r) p0[r] = fmaf(p0[r], C2, mnL);
#pragma unroll
    for (int r = 0; r < 16; ++r) p1[r] = fmaf(p1[r], C2, mnL);
#pragma unroll
    for (int r = 0; r < 16; ++r) p0[r] = __builtin_amdgcn_exp2f(p0[r]);
}
__device__ __forceinline__ void finishSM(f32x16& p0, f32x16& p1, float alpha, float& l_reg, bf16x8& pa0, bf16x8& pa1, bf16x8& pa2, bf16x8& pa3) {
#pragma unroll
    for (int r = 0; r < 16; ++r) p1[r] = __builtin_amdgcn_exp2f(p1[r]);
    float ps = 0;
#pragma unroll
    for (int r = 0; r < 16; ++r) ps += p0[r];
#pragma unroll
    for (int r = 0; r < 16; ++r) ps += p1[r];
    { auto rr = __builtin_amdgcn_permlane32_swap(__float_as_uint(ps), __float_as_uint(ps), false, false); ps = __uint_as_float(rr[0]) + __uint_as_float(rr[1]); }
    l_reg = l_reg * alpha + ps;
#define PK4(P, B_, OUT) do { unsigned a0 = cvt_pk_bf16(P[B_+0], P[B_+1]), a1 = cvt_pk_bf16(P[B_+2], P[B_+3]); unsigned b0 = cvt_pk_bf16(P[B_+4], P[B_+5]), b1 = cvt_pk_bf16(P[B_+6], P[B_+7]); \
        auto r0 = __builtin_amdgcn_permlane32_swap(a0, b0, false, false); auto r1 = __builtin_amdgcn_permlane32_swap(a1, b1, false, false); \
        u32x4 w = {r0[0], r1[0], r0[1], r1[1]}; OUT = *reinterpret_cast<bf16x8*>(&w); } while (0)
    PK4(p0, 0, pa0); PK4(p0, 8, pa1); PK4(p1, 0, pa2); PK4(p1, 8, pa3);
#undef PK4
}
template <int KB>
__device__ __forceinline__ void qkt(f32x16& p0, f32x16& p1, const LAS char* lds, int r32, int hi, const bf16x8* qr) {
    const LAS float* bb = (const LAS float*)(lds + OFF_BIAS) + KB * 64 + 4 * hi;
#pragma unroll
    for (int j = 0; j < 4; ++j) { const f32x4 a = *(const LAS f32x4*)(bb + 8 * j), b = *(const LAS f32x4*)(bb + 32 + 8 * j);
        p0[4 * j] = a[0]; p0[4 * j + 1] = a[1]; p0[4 * j + 2] = a[2]; p0[4 * j + 3] = a[3]; p1[4 * j] = b[0]; p1[4 * j + 1] = b[1]; p1[4 * j + 2] = b[2]; p1[4 * j + 3] = b[3]; }
    const LAS char* kb[4];
#pragma unroll
    for (int dd = 0; dd < 4; ++dd) kb[dd] = lds + OFF_KL + KB * SHM_K + KSWZ(r32, (dd * 16 + hi * 8) * 2);
#pragma unroll
    for (int d0 = 0; d0 < 8; ++d0) { const LAS char* a = kb[d0 & 3] + (d0 >> 2) * 128;
        const bf16x8 b0 = *reinterpret_cast<const LAS bf16x8*>(a), b1 = *reinterpret_cast<const LAS bf16x8*>(a + 32 * 256);
        p0 = __builtin_amdgcn_mfma_f32_32x32x16_bf16(b0, qr[d0], p0, 0, 0, 0);
        p1 = __builtin_amdgcn_mfma_f32_32x32x16_bf16(b1, qr[d0], p1, 0, 0, 0); }
}
template <int VB>
__device__ __forceinline__ void pv_tile(f32x16* o, const LAS char* vb0, bf16x8 pa0, bf16x8 pa1, bf16x8 pa2, bf16x8 pa3) {
#define TRR(off) __builtin_amdgcn_ds_read_tr16_b64_v4i16((LAS s16x4*)(vb0 + (off)))
#define PV_D0(d0) do { constexpr int b_ = VB * SHM_V + v_rd_off(d0, 0, 0); \
        const s16x4 l0 = TRR(b_), h0 = TRR(b_ + 2048), l1 = TRR(b_ + 4096), h1 = TRR(b_ + 6144), l2 = TRR(b_ + 8192), h2 = TRR(b_ + 10240), l3 = TRR(b_ + 12288), h3 = TRR(b_ + 14336); \
        o[d0] = __builtin_amdgcn_mfma_f32_32x32x16_bf16(pa0, (bf16x8){l0[0], l0[1], l0[2], l0[3], h0[0], h0[1], h0[2], h0[3]}, o[d0], 0, 0, 0); \
        o[d0] = __builtin_amdgcn_mfma_f32_32x32x16_bf16(pa1, (bf16x8){l1[0], l1[1], l1[2], l1[3], h1[0], h1[1], h1[2], h1[3]}, o[d0], 0, 0, 0); \
        o[d0] = __builtin_amdgcn_mfma_f32_32x32x16_bf16(pa2, (bf16x8){l2[0], l2[1], l2[2], l2[3], h2[0], h2[1], h2[2], h2[3]}, o[d0], 0, 0, 0); \
        o[d0] = __builtin_amdgcn_mfma_f32_32x32x16_bf16(pa3, (bf16x8){l3[0], l3[1], l3[2], l3[3], h3[0], h3[1], h3[2], h3[3]}, o[d0], 0, 0, 0); } while (0)
    PV_D0(0); PV_D0(1); PV_D0(2); PV_D0(3);
#undef PV_D0
#undef TRR
}
struct BlockRef { const bf16_t* Q; const bf16_t* K; const bf16_t* V; bf16_t* O; const float* Cp; int P0, jlo; float cref; };
struct Seam { bf16x8 qr[8]; bf16x8 st_v0, st_v1, st_k0, st_k1; float sb0, sb1; };
#define ROW(p, k0, rr) ((p) + (size_t)((k0) + (rr)) * RS + sc)
#define VMW() asm volatile("s_waitcnt vmcnt(0)" ::: "memory")
#define VMWN(n) asm volatile("s_waitcnt vmcnt(%0)" :: "i"(n) : "memory")
#define SLOAD_H(R, k0) do { S.st_v0 = *(const bf16x8*)ROW((R).V, k0, sr); S.st_v1 = *(const bf16x8*)ROW((R).V, k0, 32 + sr); S.st_k0 = *(const bf16x8*)ROW((R).K, k0, sr); S.st_k1 = *(const bf16x8*)ROW((R).K, k0, 32 + sr); \
        S.sb0 = (R).Cp[(size_t)((k0) + sr) * 8]; S.sb1 = (R).Cp[(size_t)((k0) + 32 + sr) * 8]; } while (0)
#define SWRITE_HK(bf, cr) do { *(LAS bf16x8*)(K_lds + (bf) * SHM_K + kws) = S.st_k0; *(LAS bf16x8*)(K_lds + (bf) * SHM_K + kws + 32 * 256) = S.st_k1; \
        if (sc == 0) { BIASL[(bf) * 64 + sr] = (cr) - S.sb0; BIASL[(bf) * 64 + 32 + sr] = (cr) - S.sb1; } } while (0)
#define SWRITE_HV(bf) do { *(LAS bf16x8*)(V_lds + (bf) * SHM_V + vst0) = S.st_v0; *(LAS bf16x8*)(V_lds + (bf) * SHM_V + vst1) = S.st_v1; } while (0)
#define SWRITE_H(bf, cr) do { SWRITE_HV(bf); SWRITE_HK(bf, cr); } while (0)
__device__ __forceinline__ void prime(const BlockRef& cur, LAS char* lds, Seam& S) {
    int tid = threadIdx.x; asm volatile("" : "+v"(tid)); const int wid = __builtin_amdgcn_readfirstlane(tid >> 6), lane = tid & 63, r32 = lane & 31, hi = lane >> 5;
    const int sr = tid >> 4, sc = (tid & 15) * 8, kws = KSWZ(sr, sc * 2); LAS char* K_lds = lds + OFF_KL; LAS float* BIASL = (LAS float*)(lds + OFF_BIAS);
    const int kb0 = cur.jlo * KVBLK;
#pragma unroll
    for (int d0 = 0; d0 < 8; ++d0) S.qr[d0] = *(const bf16x8*)(cur.Q + (size_t)(wid * QBLK + r32) * RS + d0 * 16 + hi * 8);
    SLOAD_H(cur, kb0); VMW(); SWRITE_HK(0, cur.cref);
    __syncthreads();
}
__device__ __forceinline__ void block(const BlockRef& cur, const BlockRef& nxt, LAS char* lds, Seam& S) {
    const int tid = threadIdx.x, wid = __builtin_amdgcn_readfirstlane(tid >> 6), lane = tid & 63, r32 = lane & 31, hi = lane >> 5;
    const int j_lo = cur.jlo, j_hi = (cur.P0 + QB - 1) / KVBLK + 1, NT = j_hi - j_lo;
    const int kbn = nxt.jlo * KVBLK;
    const int qlo = cur.P0 + wid * QBLK, qm = qlo + r32 - 4 * hi;
    LAS char* V_lds = lds + OFF_VL; LAS char* K_lds = lds + OFF_KL; LAS float* BIASL = (LAS float*)(lds + OFF_BIAS);
    LAS float* ws = (LAS float*)(lds + OFF_WS) + wid * 64; LAS float* li_l = ws; LAS float* al_l = ws + 32;
    float m_reg = -1e30f, l_reg = 0; f32x16 o[4] = {};
    const int sr = tid >> 4, sc = (tid & 15) * 8, vst0 = v_st(sr, sc), vst1 = v_st(32 + sr, sc), kws = KSWZ(sr, sc * 2);
    const LAS char* vb0 = V_lds + v_rd_base(lane);
#define RESC(a) do { if (__any((a) < 1.f)) { if (hi == 0) al_l[r32] = (a); asm volatile("s_waitcnt lgkmcnt(0)" ::: "memory"); \
                     for (int d_ = 0; d_ < 4; ++d_) for (int r = 0; r < 16; ++r) o[d_][r] *= al_l[crow(r, hi)]; } } while (0)
#define KBASE(t) ((j_lo + (t)) * KVBLK)
#define MASKT(P0_, P1_, t) do { const int kb_ = KBASE(t); if (kb_ + KVBLK - 1 > qlo) mask_tile(P0_, P1_, qm - kb_); } while (0)
#define SEAM_K0() do { VMWN(8); SWRITE_HK(0, nxt.cref); SBAR(); } while (0)
    f32x16 pA0, pA1, pB0, pB1; float mnA, mnB, alA, alB; bf16x8 pa0, pa1, pa2, pa3;
    SWRITE_HV(0); SBAR();
    if (NT > 1) SLOAD_H(cur, KBASE(1));
    SBAR(); qkt<0>(pA0, pA1, lds, r32, hi, S.qr);
    mask_tile(pA0, pA1, qm - KBASE(0)); partialSM(pA0, pA1, m_reg, mnA, alA);
    if (NT > 1) { VMW(); SWRITE_H(1, cur.cref); }
    __syncthreads();
#define HALF_STEP(PX0, PX1, mnX, alX, PY0, PY1, alY, t, KB, VB, SB) do { \
        SBAR(); qkt<KB>(PX0, PX1, lds, r32, hi, S.qr); \
        finishSM(PY0, PY1, alY, l_reg, pa0, pa1, pa2, pa3); SBAR(); \
        if ((t) + 1 < NT) { SLOAD_H(cur, KBASE((t) + 1)); SBAR(); } \
        pv_tile<VB>(o, vb0, pa0, pa1, pa2, pa3); MASKT(PX0, PX1, (t)); partialSM(PX0, PX1, m_reg, mnX, alX); \
        __syncthreads(); \
        if ((t) + 1 < NT) { VMW(); SWRITE_H(SB, cur.cref); } \
        RESC(alX); __syncthreads(); } while (0)
    for (int t = 1; t + 1 < NT; t += 2) {
        HALF_STEP(pB0, pB1, mnB, alB, pA0, pA1, alA, t, 1, 0, 0);
        HALF_STEP(pA0, pA1, mnA, alA, pB0, pB1, alB, t + 1, 0, 1, 1);
    }
    const bool even = (NT & 1) == 0;
    if (even) { SBAR(); qkt<1>(pB0, pB1, lds, r32, hi, S.qr); SBAR(); }
    SLOAD_H(nxt, kbn); SBAR();
#pragma unroll
    for (int d0 = 0; d0 < 8; ++d0) S.qr[d0] = *(const bf16x8*)(nxt.Q + (size_t)(wid * QBLK + r32) * RS + d0 * 16 + hi * 8);
    SBAR();
    finishSM(pA0, pA1, alA, l_reg, pa0, pa1, pa2, pa3); SBAR();
    pv_tile<0>(o, vb0, pa0, pa1, pa2, pa3);
    if (even) { MASKT(pB0, pB1, NT - 1); partialSM(pB0, pB1, m_reg, mnB, alB); __syncthreads(); RESC(alB);
        finishSM(pB0, pB1, alB, l_reg, pa0, pa1, pa2, pa3); SBAR(); pv_tile<1>(o, vb0, pa0, pa1, pa2, pa3); }
    SBAR(); SEAM_K0();
    if (hi == 0) li_l[r32] = l_reg; asm volatile("s_waitcnt lgkmcnt(0)" ::: "memory");
    const __amdgpu_buffer_rsrc_t orsrc = __builtin_amdgcn_make_buffer_rsrc((void*)(cur.O + (size_t)(wid * QBLK) * RS), 0, QBLK * RS * 2, 0x00020000);
    const int ovoff = (hi * 4 * RS + r32) * 2;
#pragma unroll
    for (int r = 0; r < 16; ++r) { const int orow0 = (r & 3) + 8 * (r >> 2); const float rl = __builtin_amdgcn_rcpf(li_l[orow0 + 4 * hi]);
#pragma unroll
        for (int d0 = 0; d0 < 4; ++d0) { const float v = o[d0][r] * rl; const float vn = __shfl_xor(v, 1);
            if ((r32 & 1) == 0) __builtin_amdgcn_raw_buffer_store_b32(cvt_pk_bf16(v, vn), orsrc, ovoff, orow0 * RS * 2 + d0 * 64, 0); } }
    __syncthreads();
#undef RESC
#undef KBASE
#undef MASKT
#undef SEAM_K0
#undef HALF_STEP
}
#undef ROW
#undef VMW
#undef VMWN
#undef SLOAD_H
#undef SWRITE_HK
#undef SWRITE_HV
#undef SWRITE_H
#undef KSWZ
#undef SBAR
}
constexpr int CW_ATTQ = 64;
__device__ __forceinline__ void p2_jlo(const Frame& F0, const P& p) { const Frame F = phase_frame(F0);
    const float* C = (const float*)(p.ws + OFF_C); int* JLO = (int*)(p.ws + OFF_JLO);
    const int gw = F.vcu * NWAVES + F.wave, NGW = F.G * NWAVES, lane = F.lane;
    const float gq = wave_max(fmaxf(fabsf(p.fq_norm[2 * lane]), fabsf(p.fq_norm[2 * lane + 1]))), gk = wave_max(fmaxf(fabsf(p.fk_norm[2 * lane]), fabsf(p.fk_norm[2 * lane + 1])));
    const float th = -(2.f * 1.02f * gq * gk * 11.3137085f + 104.f);
    for (int e = gw; e < BATCH * HEADS * 32; e += NGW) {
        const int b = e >> 8, h = (e >> 5) & 7, qb = e & 31, P0 = qb * 256;
        const float* Cp = C + (size_t)b * SEQ * 8 + h; const float c0 = Cp[(size_t)P0 * 8];
        int cnt = 0;
#pragma unroll
        for (int i = 0; i < 2; ++i) { const int j = lane + 64 * i, kl = 64 * j + 63; const bool neg = (kl < P0) && (c0 - Cp[(size_t)(kl < SEQ ? kl : 0) * 8] < th); cnt += __popcll(__ballot(neg)); }
        if (lane == 0) JLO[e] = cnt;
    }
}
__device__ __forceinline__ void p4_attention(const Frame& F0, const P& p, int rep) { const Frame F = phase_frame(F0);
    LAS char* lds = (LAS char*)F.lds; LAS int* ITEM = (LAS int*)(lds + fox::OFF_ITEM);
    const bf16_t* FQ = (const bf16_t*)(p.ws + OFF_FQ); const bf16_t* FK = (const bf16_t*)(p.ws + OFF_FK); const bf16_t* FV = (const bf16_t*)(p.ws + OFF_FV); bf16_t* BOUT = (bf16_t*)(p.ws + OFF_BOUT);
    const float* C = (const float*)(p.ws + OFF_C); const int* JLO = (const int*)(p.ws + OFF_JLO);
    unsigned* qhead = (unsigned*)(p.ws + WS_CTL) + CW_ATTQ + 64 * rep;
    constexpr int TOTAL = BATCH * HEADS * 32;
    if (F.tid == 0) { float fb[8]; for (int i = 0; i < 8; ++i) fb[i] = p.f_bias[i];
        for (int r = 0; r < 8; ++r) { int best = 0; for (int i = 1; i < 8; ++i) if (fb[i] > fb[best]) best = i; ITEM[r] = best; fb[best] = -INFINITY; }
        ITEM[8] = (int)__hip_atomic_fetch_add(qhead, 1u, __ATOMIC_RELAXED, __HIP_MEMORY_SCOPE_AGENT); }
    __syncthreads();
    auto mkref = [&](int L) { fox::BlockRef r; const int hr = L >> 7, rr = L & 127, qb = 31 - (rr >> 2), b = rr & 3, h = __builtin_amdgcn_readfirstlane(ITEM[hr]); const size_t t0 = (size_t)b * SEQ;
        r.Q = FQ + (t0 + qb * 256) * 1024 + h * 128; r.K = FK + t0 * 1024 + h * 128; r.V = FV + t0 * 1024 + h * 128; r.O = BOUT + (t0 + qb * 256) * 1024 + h * 128;
        r.Cp = C + t0 * 8 + h; r.P0 = qb * 256; r.jlo = __builtin_amdgcn_readfirstlane(JLO[(b * 8 + h) * 32 + qb]);
        r.cref = __uint_as_float(__builtin_amdgcn_readfirstlane(__float_as_uint(r.Cp[(size_t)(qb * 256 + 255) * 8]))); return r; };
    int L = __builtin_amdgcn_readfirstlane(ITEM[8]);
    if (L >= TOTAL) return;
    if (F.tid == 0) ITEM[9] = (int)__hip_atomic_fetch_add(qhead, 1u, __ATOMIC_RELAXED, __HIP_MEMORY_SCOPE_AGENT);
    __syncthreads();
    int Ln = __builtin_amdgcn_readfirstlane(ITEM[9]);
    fox::BlockRef cur = mkref(L);
    fox::Seam S;
    fox::prime(cur, lds, S);
    for (int it = 0;; ++it) {
        const bool last = Ln >= TOTAL;
        if (!last && F.tid == 0) ITEM[8 + (it & 1)] = (int)__hip_atomic_fetch_add(qhead, 1u, __ATOMIC_RELAXED, __HIP_MEMORY_SCOPE_AGENT);
        const fox::BlockRef nxt = last ? cur : mkref(Ln);
        fox::block(cur, nxt, lds, S);
        if (last) break;
        cur = nxt; L = Ln; Ln = __builtin_amdgcn_readfirstlane(ITEM[8 + (it & 1)]);
    }
}
__device__ __forceinline__ void p2_qknorm(const Frame& F0, const P& p) { const Frame F = phase_frame(F0);
    bf16_t* FQ = (bf16_t*)(p.ws + OFF_FQ); bf16_t* FK = (bf16_t*)(p.ws + OFF_FK);
    const int gw = F.vcu * NWAVES + F.wave, NGW = F.G * NWAVES, lane = F.lane, d0 = (lane & 7) * 16;
    float gq[16], gk[16];
#pragma unroll
    for (int j = 0; j < 16; ++j) { gq[j] = p.fq_norm[d0 + j] * 0.08838834764831845f; gk[j] = p.fk_norm[d0 + j]; }
    for (int t = gw; t < T; t += NGW) {
#pragma unroll
        for (int which = 0; which < 2; ++which) {
            bf16_t* ptr = (which ? FK : FQ) + (size_t)t * 1024 + lane * 16;
            const u32x4 a = *(const u32x4*)ptr, b = *(const u32x4*)(ptr + 8); const unsigned w[8] = {a.x, a.y, a.z, a.w, b.x, b.y, b.z, b.w};
            float v[16]; float ss = 0.f;
#pragma unroll
            for (int j = 0; j < 8; ++j) { v[2 * j] = __uint_as_float(w[j] << 16); v[2 * j + 1] = __uint_as_float(w[j] & 0xffff0000u); ss += v[2 * j] * v[2 * j] + v[2 * j + 1] * v[2 * j + 1]; }
            ss += __shfl_xor(ss, 1); ss += __shfl_xor(ss, 2); ss += __shfl_xor(ss, 4);
            const float rs = rsqrtf(ss * (1.f / 128.f) + EPS);
            unsigned o[8];
#pragma unroll
            for (int j = 0; j < 8; ++j) o[j] = which ? cvt_pk_bf16(v[2 * j] * rs * gk[2 * j], v[2 * j + 1] * rs * gk[2 * j + 1]) : cvt_pk_bf16(v[2 * j] * rs * gq[2 * j], v[2 * j + 1] * rs * gq[2 * j + 1]);
            *(u32x4*)ptr = (u32x4){o[0], o[1], o[2], o[3]}; *(u32x4*)(ptr + 8) = (u32x4){o[4], o[5], o[6], o[7]};
        }
    }
}
__device__ __forceinline__ void p7_router(const Frame& F0, const P& p) { const Frame F = phase_frame(F0);
    LAS int* hist = (LAS int*)(F.lds + MISC_OFF + 512);
    const bf16_t* X1 = (const bf16_t*)(p.ws + OFF_X1B); unsigned char* H2 = p.ws + OFF_H2; const bf16_t* RWT = (const bf16_t*)(p.ws + OFF_RWT); float* RSTD = (float*)(p.ws + OFF_RSTD);
    int* TOPI = (int*)(p.ws + OFF_TOPI); float* GATE = (float*)(p.ws + OFF_GATE); int* CNT = (int*)(p.ws + OFF_CNT);
    const int lane = F.lane, l15 = lane & 15, kg = lane >> 4;
    for (int blk = F.vcu; blk < T / 128; blk += F.G) {
        if (F.tid < NEXP) hist[F.tid] = 0;
        __syncthreads();
        const int tok = blk * 128 + F.wave * 16 + l15;
        const bf16_t* xr = X1 + (size_t)tok * D_MODEL + 8 * kg; unsigned char* hr = H2 + (size_t)tok * D_MODEL + 8 * kg;
        f32x4 acc0 = {0.f, 0.f, 0.f, 0.f}, acc1 = {0.f, 0.f, 0.f, 0.f}; float ss = 0.f;
#pragma unroll 4
        for (int ks = 0; ks < 64; ++ks) {
            const u32x4 xw = *(const u32x4*)(xr + 32 * ks);
            const f32x4 xa = {__uint_as_float(xw.x << 16), __uint_as_float(xw.x & 0xffff0000u), __uint_as_float(xw.y << 16), __uint_as_float(xw.y & 0xffff0000u)}, xb = {__uint_as_float(xw.z << 16), __uint_as_float(xw.z & 0xffff0000u), __uint_as_float(xw.w << 16), __uint_as_float(xw.w & 0xffff0000u)};
            const f32x4 ga = *(const f32x4*)(p.norm2 + 32 * ks + 8 * kg), gb = *(const f32x4*)(p.norm2 + 32 * ks + 8 * kg + 4);
            const bf16x8 bh0 = *(const bf16x8*)(RWT + (size_t)l15 * D_MODEL + 32 * ks + 8 * kg), bh1 = *(const bf16x8*)(RWT + (size_t)(16 + l15) * D_MODEL + 32 * ks + 8 * kg);
            const bf16x8 bl0 = *(const bf16x8*)(RWT + (size_t)(NEXP + l15) * D_MODEL + 32 * ks + 8 * kg), bl1 = *(const bf16x8*)(RWT + (size_t)(NEXP + 16 + l15) * D_MODEL + 32 * ks + 8 * kg);
            ss += xa[0] * xa[0] + xa[1] * xa[1] + xa[2] * xa[2] + xa[3] * xa[3] + xb[0] * xb[0] + xb[1] * xb[1] + xb[2] * xb[2] + xb[3] * xb[3];
            u32x2 h8; h8.x = pk4_fp8(xa[0] * ga[0], xa[1] * ga[1], xa[2] * ga[2], xa[3] * ga[3]); h8.y = pk4_fp8(xb[0] * gb[0], xb[1] * gb[1], xb[2] * gb[2], xb[3] * gb[3]);
            *(u32x2*)(hr + 32 * ks) = h8;
            const bf16x8 ah = __builtin_bit_cast(bf16x8, xw);
            acc0 = __builtin_amdgcn_mfma_f32_16x16x32_bf16(ah, bh0, acc0, 0, 0, 0); acc1 = __builtin_amdgcn_mfma_f32_16x16x32_bf16(ah, bh1, acc1, 0, 0, 0);
            acc0 = __builtin_amdgcn_mfma_f32_16x16x32_bf16(ah, bl0, acc0, 0, 0, 0); acc1 = __builtin_amdgcn_mfma_f32_16x16x32_bf16(ah, bl1, acc1, 0, 0, 0);
        }
        ss += __shfl_xor(ss, 16); ss += __shfl_xor(ss, 32);
        const float rstd = rsqrtf(ss * (1.f / D_MODEL) + EPS);
        if (kg == 0) RSTD[tok] = rstd;
        const float rb0 = p.router_b[l15], rb1 = p.router_b[16 + l15];
        float v0[4], v1[4];
#pragma unroll
        for (int r = 0; r < 4; ++r) { const float rs = __shfl(rstd, 4 * kg + r); v0[r] = acc0[r] * rs + rb0; v1[r] = acc1[r] * rs + rb1; }
        float tv[4][4]; int ti[4][4];
#pragma unroll
        for (int k = 0; k < 4; ++k)
#pragma unroll
            for (int r = 0; r < 4; ++r) {
                float bv = v0[r]; int bi = l15; if (v1[r] > bv) { bv = v1[r]; bi = 16 + l15; }
#pragma unroll
                for (int msk = 1; msk < 16; msk <<= 1) { const float ov = __shfl_xor(bv, msk); const int oi = __shfl_xor(bi, msk); if (ov > bv || (ov == bv && oi < bi)) { bv = ov; bi = oi; } }
                tv[k][r] = bv; ti[k][r] = bi; if (bi == l15) v0[r] = -INFINITY; if (bi == 16 + l15) v1[r] = -INFINITY;
            }
        if (l15 == 0) {
#pragma unroll
            for (int r = 0; r < 4; ++r) { const int t = blk * 128 + F.wave * 16 + 4 * kg + r;
                const float e1 = __expf(tv[1][r] - tv[0][r]), e2 = __expf(tv[2][r] - tv[0][r]), e3 = __expf(tv[3][r] - tv[0][r]), inv = 1.f / (1.f + e1 + e2 + e3);
                *(int4*)(TOPI + (size_t)t * 4) = make_int4(ti[0][r], ti[1][r], ti[2][r], ti[3][r]); *(float4*)(GATE + (size_t)t * 4) = make_float4(inv, e1 * inv, e2 * inv, e3 * inv);
                atomicAdd((int*)&hist[ti[0][r]], 1); atomicAdd((int*)&hist[ti[1][r]], 1); atomicAdd((int*)&hist[ti[2][r]], 1); atomicAdd((int*)&hist[ti[3][r]], 1); }
        }
        __syncthreads();
        if (F.tid < NEXP) CNT[blk * NEXP + F.tid] = hist[F.tid];
        __syncthreads();
    }
}
__device__ __forceinline__ void p8_scatter(const Frame& F0, const P& p) { const Frame F = phase_frame(F0);
    LAS int* base = (LAS int*)(F.lds + 0); LAS int* tot = base + 32; LAS int* segs = base + 64; LAS int* spos = base + 128;
    const int tid = F.tid, lane = F.lane;
    const int* CNT = (const int*)(p.ws + OFF_CNT); const int* TOPI = (const int*)(p.ws + OFF_TOPI); const float* GATE = (const float*)(p.ws + OFF_GATE);
    int* POS = (int*)(p.ws + OFF_POS); float* ROWW = (float*)(p.ws + OFF_ROWW); int* TILEE = (int*)(p.ws + OFF_TILEE);
    int* ROWTOK = (int*)(p.ws + OFF_ROWTOK); float* ROWRS = (float*)(p.ws + OFF_ROWRS); const float* RSTD = (const float*)(p.ws + OFF_RSTD);
    for (int wg = F.vcu; wg < RT_WGS; wg += F.G) {
        { LAS int* redb = base + 1024; LAS int* redt = redb + 512;
          const int e = tid & 31, part = tid >> 5; int before = 0, total = 0;
#pragma unroll
          for (int j = 0; j < 16; ++j) { const int w = part * 16 + j; const int c = CNT[w * NEXP + e]; total += c; before += (w < wg) ? c : 0; }
          redb[tid] = before; redt[tid] = total;
          __syncthreads();
          if (tid < NEXP) { int b2 = 0, t2 = 0;
#pragma unroll
              for (int q = 0; q < 16; ++q) { b2 += redb[q * 32 + tid]; t2 += redt[q * 32 + tid]; }
              base[tid] = b2; tot[tid] = t2; } }
        __syncthreads();
        if (tid == 0) { int s = 0; for (int e = 0; e < NEXP; ++e) { segs[e] = s; s += (tot[e] + 255) & ~255; } segs[NEXP] = s; }
        __syncthreads();
        if (wg == 0) {
            for (int e = 0; e < NEXP; ++e) { const int t0 = segs[e] >> 8, t1 = segs[e + 1] >> 8; for (int tt = t0 + tid; tt < t1; tt += NWAVES * 64) TILEE[tt] = e; }
            if (tid == 0) TILEE[NTILES_MAX] = segs[NEXP] >> 8;
        }
        { LAS int* cw = base + 2048;
          const int f = F.wave * 64 + lane, e = TOPI[(size_t)wg * RT_TOK * 4 + f]; int mycnt = 0, within = 0;
          for (int ex = 0; ex < NEXP; ++ex) { const unsigned long long m = __ballot(e == ex); if (lane == ex) mycnt = __popcll(m); if (e == ex) within = __popcll(m & ((1ull << lane) - 1ull)); }
          if (lane < NEXP) cw[F.wave * NEXP + lane] = mycnt;
          __syncthreads();
          int prev = 0;
          for (int w2 = 0; w2 < F.wave; ++w2) prev += cw[w2 * NEXP + e];
          const int pos = segs[e] + base[e] + prev + within;
          POS[(size_t)wg * RT_TOK * 4 + f] = pos; ROWW[pos] = GATE[(size_t)wg * RT_TOK * 4 + f]; ROWTOK[pos] = wg * RT_TOK + (f >> 2); ROWRS[pos] = RSTD[wg * RT_TOK + (f >> 2)]; }
        __syncthreads();
        if (wg < NEXP) { const int r0 = segs[wg] + tot[wg], r1 = segs[wg + 1]; for (int r = r0 + tid; r < r1; r += NWAVES * 64) { ROWTOK[r] = 0; ROWW[r] = 0.f; ROWRS[r] = 0.f; } }
        __syncthreads();
    }
}
__device__ __forceinline__ void p11_combine(const Frame& F0, const P& p) { const Frame F = phase_frame(F0);
    const bf16_t* X1 = (const bf16_t*)(p.ws + OFF_X1B); const unsigned char* YR = p.ws + OFF_YR; const int* POS = (const int*)(p.ws + OFF_POS);
    const int gw = F.vcu * NWAVES + F.wave, NGW = F.G * NWAVES, lane = F.lane;
    for (int t = gw; t < T; t += NGW) {
        const int4 pos = *(const int4*)(POS + (size_t)t * 4); const int pp[4] = {pos.x, pos.y, pos.z, pos.w};
#pragma unroll
        for (int i = 0; i < 2; ++i) {
            const int c = 16 * (lane + 64 * i);
            const u32x4 xa = *(const u32x4*)(X1 + (size_t)t * D_MODEL + c), xb = *(const u32x4*)(X1 + (size_t)t * D_MODEL + c + 8);
            float s16[16];
#pragma unroll
            for (int j = 0; j < 16; ++j) s16[j] = 0.f;
#pragma unroll
            for (int k = 0; k < 4; ++k) { const u32x4 y = *(const u32x4*)(YR + (size_t)pp[k] * D_MODEL + c); const unsigned yw[4] = {y.x, y.y, y.z, y.w};
#pragma unroll
                for (int d = 0; d < 4; ++d) { const auto lo = __builtin_amdgcn_cvt_pk_f32_fp8((int)yw[d], false), hi = __builtin_amdgcn_cvt_pk_f32_fp8((int)yw[d], true);
                    s16[4 * d + 0] += lo[0]; s16[4 * d + 1] += lo[1]; s16[4 * d + 2] += hi[0]; s16[4 * d + 3] += hi[1]; } }
            const unsigned xw[8] = {xa.x, xa.y, xa.z, xa.w, xb.x, xb.y, xb.z, xb.w};
            constexpr float inv = 1.f / YR_SCALE;
#pragma unroll
            for (int q = 0; q < 4; ++q) { f32x4 o;
                o[0] = __uint_as_float(xw[2 * q] << 16) + s16[4 * q + 0] * inv; o[1] = __uint_as_float(xw[2 * q] & 0xffff0000u) + s16[4 * q + 1] * inv;
                o[2] = __uint_as_float(xw[2 * q + 1] << 16) + s16[4 * q + 2] * inv; o[3] = __uint_as_float(xw[2 * q + 1] & 0xffff0000u) + s16[4 * q + 3] * inv;
                *(f32x4*)(p.out + (size_t)t * D_MODEL + c + 4 * q) = o; }
        }
    }
}

__device__ __forceinline__ void p5_quant(const Frame& F0, const P& p) { const Frame F = phase_frame(F0);
    const int gw = F.vcu * NWAVES + F.wave, NGW = F.G * NWAVES, lane = F.lane;
    for (int e = gw; e < 2 * T; e += NGW) { const int br = e & 1, t = e >> 1;
        const bf16_t* src = (const bf16_t*)(p.ws + (br ? OFF_BOUT : OFF_AOUT)) + (size_t)t * WIDTH + 16 * lane;
        const u32x4 a = *(const u32x4*)src, b = *(const u32x4*)(src + 8); const unsigned w[8] = {a.x, a.y, a.z, a.w, b.x, b.y, b.z, b.w};
        float v[16]; float m = 0.f;
#pragma unroll
        for (int j = 0; j < 8; ++j) { v[2 * j] = __uint_as_float(w[j] << 16); v[2 * j + 1] = __uint_as_float(w[j] & 0xffff0000u); m = fmaxf(m, fmaxf(__builtin_fabsf(v[2 * j]), __builtin_fabsf(v[2 * j + 1]))); }
        const float mx = fmaxf(wave_max(m), 1e-30f), inv = 127.f / mx;
        u32x4 o; o.x = pk4_i8(v[0] * inv, v[1] * inv, v[2] * inv, v[3] * inv); o.y = pk4_i8(v[4] * inv, v[5] * inv, v[6] * inv, v[7] * inv); o.z = pk4_i8(v[8] * inv, v[9] * inv, v[10] * inv, v[11] * inv); o.w = pk4_i8(v[12] * inv, v[13] * inv, v[14] * inv, v[15] * inv);
        *(u32x4*)(p.ws + OFF_H8 + (size_t)br * 32 * MiB + (size_t)t * WIDTH + 16 * lane) = o;
        if (lane == 0) ((float*)(p.ws + (br ? OFF_HSC2 : OFF_HSC)))[t] = mx * (1.f / 127.f);
    }
}
__device__ __forceinline__ void p6_quant(const Frame& F0, const P& p) { const Frame F = phase_frame(F0);
    const bf16_t* MRG = (const bf16_t*)(p.ws + OFF_MRG); unsigned char* Q = p.ws + OFF_H8; float* HSC = (float*)(p.ws + OFF_HSC);
    const int gw = F.vcu * NWAVES + F.wave, NGW = F.G * NWAVES, lane = F.lane;
    for (int t = gw; t < T; t += NGW) {
        const bf16_t* src = MRG + (size_t)t * D_MODEL + 32 * lane; u32x4 in[4]; float m = 0.f;
#pragma unroll
        for (int i = 0; i < 4; ++i) { in[i] = *(const u32x4*)(src + 8 * i); const unsigned w[4] = {in[i].x, in[i].y, in[i].z, in[i].w};
#pragma unroll
            for (int j = 0; j < 4; ++j) m = fmaxf(m, fmaxf(__builtin_fabsf(__uint_as_float(w[j] << 16)), __builtin_fabsf(__uint_as_float(w[j] & 0xffff0000u)))); }
        const float mx = fmaxf(wave_max(m), 1e-30f), inv = 127.f / mx;
        u32x4 o[2];
#pragma unroll
        for (int i = 0; i < 4; ++i) { const unsigned w[4] = {in[i].x, in[i].y, in[i].z, in[i].w};
            const unsigned a = pk4_i8(__uint_as_float(w[0] << 16) * inv, __uint_as_float(w[0] & 0xffff0000u) * inv, __uint_as_float(w[1] << 16) * inv, __uint_as_float(w[1] & 0xffff0000u) * inv);
            const unsigned b = pk4_i8(__uint_as_float(w[2] << 16) * inv, __uint_as_float(w[2] & 0xffff0000u) * inv, __uint_as_float(w[3] << 16) * inv, __uint_as_float(w[3] & 0xffff0000u) * inv);
            if (i & 1) { o[i >> 1].z = a; o[i >> 1].w = b; } else { o[i >> 1].x = a; o[i >> 1].y = b; } }
        *(u32x4*)(Q + (size_t)t * D_MODEL + 32 * lane) = o[0]; *(u32x4*)(Q + (size_t)t * D_MODEL + 32 * lane + 16) = o[1];
        if (lane == 0) HSC[t] = mx * (1.f / 127.f);
    }
}
struct Args { P p; int ph_lo, ph_hi, li, pad; };
__global__ void __launch_bounds__(NWAVES * 64, 2) mk_fwd(Args args) {
    extern __shared__ __attribute__((aligned(16))) unsigned char lds_raw[];
    Frame F; F.lds = (LAS unsigned char*)lds_raw; F.MISC = (volatile LAS unsigned*)(F.lds + MISC_OFF);
    F.tid = threadIdx.x; F.lane = F.tid & 63; F.wave = __builtin_amdgcn_readfirstlane(F.tid >> 6);
    F.G = gridDim.x; { const int bx = blockIdx.x; F.vcu = (F.G % 8 == 0) ? (bx % 8) * (F.G / 8) + bx / 8 : bx; }
    const P& p = args.p;
    for (int u = F.tid; u < (LDS_BYTES - MISC_OFF) / 4; u += NWAVES * 64) ((LAS unsigned*)(F.lds + MISC_OFF))[u] = 0u;
    __syncthreads();
    XcdBarrier bar = xcd_barrier_post((unsigned*)(p.ws + WS_CTL) + CW_BAR + args.li * XCD_BAR_WORDS, F.MISC + 8);
    const int lo = args.ph_lo, hi = args.ph_hi;
#ifndef DUP_MASK
#define DUP_MASK 0
#endif
#define DUP(k) ((DUP_MASK >> (k)) & 1)
#define IN(k) (lo <= (k) && (k) < hi)
#define BOTH(k) (IN(k) && IN((k) + 1))
    if (IN(0)) { for (int rep = 0; rep <= DUP(0); ++rep) { p0_quant_weights(F, p); p0_router_prep(F, p); __syncthreads(); p0_rmsnorm(F, p); __syncthreads(); } if (BOTH(0)) xcd_barrier(bar); }
    if (IN(1)) {
        p1_fix_c(F, p);
        { SchedIn<1> S{T / 256, NF8T, F.G, (int)blockIdx.x, (const char*)(p.ws + OFF_H8), (const char*)(p.ws + OFF_WIN8_T), (size_t)256 * D_MODEL, (const float*)(p.ws + OFF_HSC), (const unsigned*)(p.ws + WS_CTL) + CW_CMAX};
          EpiIn1 E{p.ws, p.lb_logits, (LAS float*)(F.lds + MISC_OFF + 4096), p.fq_norm, p.fk_norm};
          pg8::gemm_phase<EpiIn1, SchedIn<1>, true, false, true>(F.lds, D_MODEL / 2, S, E); }
        if (BOTH(1)) xcd_barrier(bar);
    }
    if (IN(2)) { p2_jlo(F, p); p2_hgrn_local(F, p);     if (BOTH(2)) xcd_barrier(bar); }
    if (IN(3)) { for (int rep = 0; rep <= DUP(3); ++rep) p3_hgrn_scan(F, p); if (BOTH(3)) xcd_barrier(bar); }
    if (IN(4)) { if (((blockIdx.x >> 3) & 3) == 3) convert_queue(F, p); p4_hgrn_out(F, p); __syncthreads(); p4_attention(F, p, 0); __syncthreads(); convert_queue(F, p); if (BOTH(4)) xcd_barrier(bar); }
    if (IN(5)) {
        p5_quant(F, p);
        xcd_barrier(bar);
        int kmerge = WIDTH / 2; asm volatile("" : "+s"(kmerge));
        { SchedI8 S{T / 256, D_MODEL / 256, F.G, (int)blockIdx.x, (const char*)(p.ws + OFF_H8), (const char*)(p.ws + OFF_WUPA_T), (size_t)256 * WIDTH, (const float*)(p.ws + OFF_HSC), (const unsigned*)(p.ws + WS_CTL) + CW_CMAXA};
          EpiMergeT<0> E{p.ws}; pg8::gemm_phase<EpiMergeT<0>, SchedI8, true, false, true>(F.lds, kmerge, S, E); }
        { SchedI8 S{T / 256, D_MODEL / 256, F.G, (int)blockIdx.x, (const char*)(p.ws + OFF_H8 + 32 * MiB), (const char*)(p.ws + OFF_WUPB_T), (size_t)256 * WIDTH, (const float*)(p.ws + OFF_HSC2), (const unsigned*)(p.ws + WS_CTL) + CW_CMAXB};
          EpiMergeT<1> E{p.ws}; pg8::gemm_phase<EpiMergeT<1>, SchedI8, true, false, true>(F.lds, kmerge, S, E); }
        if (BOTH(5)) xcd_barrier(bar);
    }
    if (IN(6)) {
        p6_quant(F, p);
        xcd_barrier(bar);
        SchedI8 S{T / 256, D_MODEL / 256, F.G, (int)blockIdx.x, (const char*)(p.ws + OFF_H8), (const char*)(p.ws + OFF_WOUT8_T), (size_t)256 * D_MODEL, (const float*)(p.ws + OFF_HSC), (const unsigned*)(p.ws + WS_CTL) + CW_CMAX2};
        EpiWout1 E{p.x, (bf16_t*)(p.ws + OFF_X1B)};
        for (int rep = 0; rep <= DUP(6); ++rep) pg8::gemm_phase<EpiWout1, SchedI8, true, false, true>(F.lds, D_MODEL / 2, S, E);
        if (BOTH(6)) xcd_barrier(bar);
    }
    if (IN(7)) { for (int rep = 0; rep <= DUP(7); ++rep) p7_router(F, p); if (BOTH(7)) xcd_barrier(bar); }
    if (IN(8)) { for (int rep = 0; rep <= DUP(8); ++rep) p8_scatter(F, p); if (BOTH(8)) xcd_barrier(bar); }
    if (IN(9)) {
        const int nT = load_tile_table(F, p);
        pg8::SchedMoe S{nT, 4096 / 256, F.G, (int)blockIdx.x, (const char*)(p.ws + OFF_H2), (const char*)(p.ws + OFF_WGU_T), (size_t)256 * D_MODEL, (size_t)4096 * D_MODEL, (const LAS int*)(F.lds + TILEE_LDS_OFF), true};
        EpiGU1 E{p.b_gu, p.ws + OFF_ACT, (const float*)(p.ws + OFF_ROWRS)};
        for (int rep = 0; rep <= DUP(9); ++rep) pg8::gemm_phase<EpiGU1, pg8::SchedMoe, true, true>(F.lds, D_MODEL / 2, S, E, (const int*)(p.ws + OFF_ROWTOK));
        if (BOTH(9)) xcd_barrier(bar);
    }
    if (IN(10)) {
        const int nT = load_tile_table(F, p);
        pg8::SchedMoe S{nT, D_MODEL / 256, F.G, (int)blockIdx.x, (const char*)(p.ws + OFF_ACT), (const char*)(p.ws + OFF_WDN_T), (size_t)256 * D_MODEL, (size_t)D_MODEL * D_MODEL, (const LAS int*)(F.lds + TILEE_LDS_OFF), false};
        EpiDown1 E{p.b_down, (const float*)(p.ws + OFF_ROWW), p.ws + OFF_YR};
        for (int rep = 0; rep <= DUP(10); ++rep) pg8::gemm_phase<EpiDown1, pg8::SchedMoe, true>(F.lds, D_MODEL / 2, S, E);
        if (BOTH(10)) xcd_barrier(bar);
    }
    if (IN(11)) { for (int rep = 0; rep <= DUP(11); ++rep) p11_combine(F, p); }
#undef IN
#undef BOTH
}
extern "C" void kernel_launch(void* const* d_in, const int* in_sizes, int n_in, void* d_out, int out_size, void* d_ws, size_t ws_size, hipStream_t stream) {
    static int grid = 0;
    if (grid == 0) {
        if (n_in != 18 || out_size != T * D_MODEL || ws_size < WS_END3) { fprintf(stderr, "kernel_launch: unexpected shapes (n_in %d out %d ws %zu need %zu)\n", n_in, out_size, ws_size, (size_t)WS_END3); grid = -1; return; }
        int dev = 0, cus = 0, per_cu = 0;
        if (hipGetDevice(&dev) != hipSuccess || hipDeviceGetAttribute(&cus, hipDeviceAttributeMultiprocessorCount, dev) != hipSuccess) { grid = -1; return; }
        if (hipFuncSetAttribute((const void*)mk_fwd, hipFuncAttributeMaxDynamicSharedMemorySize, LDS_BYTES) != hipSuccess) { fprintf(stderr, "kernel_launch: hipFuncSetAttribute failed\n"); grid = -1; return; }
        if (hipOccupancyMaxActiveBlocksPerMultiprocessor(&per_cu, (const void*)mk_fwd, NWAVES * 64, LDS_BYTES) != hipSuccess || per_cu < 1) fprintf(stderr, "kernel_launch: occupancy query says %d\n", per_cu);
        (void)hipGetLastError();
        grid = cus;
    }
    if (grid < 0) return;
    P p{};
    p.x = (const float*)d_in[0]; p.lb_logits = (const float*)d_in[1]; p.norm1 = (const float*)d_in[2]; p.w_in = (const float*)d_in[3]; p.hg_norm = (const float*)d_in[4];
    p.fq_norm = (const float*)d_in[5]; p.fk_norm = (const float*)d_in[6]; p.f_bias = (const float*)d_in[7]; p.w_up_hg = (const float*)d_in[8]; p.w_up_fox = (const float*)d_in[9];
    p.w_out = (const float*)d_in[10]; p.norm2 = (const float*)d_in[11]; p.router_w = (const float*)d_in[12]; p.router_b = (const float*)d_in[13]; p.w_gu = (const float*)d_in[14];
    p.b_gu = (const float*)d_in[15]; p.w_down = (const float*)d_in[16]; p.b_down = (const float*)d_in[17]; p.out = (float*)d_out; p.ws = (unsigned char*)d_ws;
    unsigned char* ws = p.ws;
    (void)hipMemsetAsync(ws + WS_CTL, 0, CTL_ZERO_BYTES, stream);
    Args a{}; a.p = p; a.ph_lo = 0; a.ph_hi = 12; a.li = 0; a.pad = 0;
    hipLaunchKernelGGL(mk_fwd, dim3(grid), dim3(NWAVES * 64), LDS_BYTES, stream, a);
}
```
